# Optimizing an MI355X kernel written in HIP

```python
import jax, jax.numpy as jnp
from jax import lax
import numpy as np

D_MODEL = 2048
BATCH = 8
SEQ = 2048
DEPTH = 2

HEAD_DIM = 64
CONV_CH = D_MODEL // 4
CONV_WIDTH = 31
SWA_Q_HEADS = (3 * D_MODEL // 8) // HEAD_DIM
SWA_KV_HEADS = SWA_Q_HEADS // 3
SWA_WINDOW = 128
SWA_WIDTH = SWA_Q_HEADS * HEAD_DIM
DIFF_HEADS = (3 * D_MODEL // 8) // (2 * HEAD_DIM)
DIFF_WIDTH = DIFF_HEADS * 2 * HEAD_DIM
MIX_WIDTH = CONV_CH + SWA_WIDTH + DIFF_WIDTH
IN_WIDTH = 2 * CONV_CH + SWA_WIDTH + 2 * SWA_KV_HEADS * HEAD_DIM + 3 * DIFF_WIDTH
Q_BLOCK = 128
ROPE_THETA = 10000.0
MAX_POS_OFFSET = 4096
N_GROUPS = 8
EXPERTS_PER_GROUP = 8
N_EXPERTS = N_GROUPS * EXPERTS_PER_GROUP
TOP_K_IN_GROUP = 2
EXPERT_FF = D_MODEL // 4
MOE_BLOCK = 128
RMS_EPS = 1e-6
LN_EPS = 1e-5
NEG_INF = -1e30

kernel_name = 'hybrid_conv_swa_diffattn_hmoe_block'


def rms_norm(x, g, eps=RMS_EPS):
    xf = x.astype(jnp.float32)
    y = xf * lax.rsqrt(jnp.mean(xf * xf, axis=-1, keepdims=True) + eps)
    return (y * g.astype(jnp.float32)).astype(x.dtype)


def layer_norm(x, g, b, eps=LN_EPS):
    xf = x.astype(jnp.float32)
    mu = jnp.mean(xf, axis=-1, keepdims=True)
    var = jnp.mean(jnp.square(xf - mu), axis=-1, keepdims=True)
    y = (xf - mu) * lax.rsqrt(var + eps)
    return (y * g.astype(jnp.float32) + b.astype(jnp.float32)).astype(x.dtype)


def rope_tables(positions, dim):
    inv_freq = ROPE_THETA ** (-jnp.arange(0, dim, 2, dtype=jnp.float32) / dim)
    ang = positions.astype(jnp.float32)[..., None] * inv_freq
    return jnp.cos(ang), jnp.sin(ang)


def apply_rope(x, cos, sin):
    xf = x.astype(jnp.float32)
    x1, x2 = jnp.split(xf, 2, axis=-1)
    c = cos[:, :, None, :]
    s = sin[:, :, None, :]
    return jnp.concatenate([x1 * c - x2 * s, x2 * c + x1 * s], axis=-1).astype(x.dtype)


def conv_module(u, dw_w, dw_b, ln_g, ln_b, pw_w):
    a, gate = jnp.split(u, 2, axis=-1)
    z = a * jax.nn.sigmoid(gate)
    z = lax.conv_general_dilated(
        z, dw_w[:, None, :].astype(z.dtype), window_strides=(1,),
        padding=[(CONV_WIDTH - 1, 0)], dimension_numbers=('NWC', 'WIO', 'NWC'),
        feature_group_count=CONV_CH) + dw_b
    z = jax.nn.silu(layer_norm(z, ln_g, ln_b))
    return z @ pw_w


def swa_attention(q, k, v, sinks):
    B, S, Hq, d = q.shape
    Hkv = k.shape[2]
    G = Hq // Hkv
    W = SWA_WINDOW
    nb = S // W
    qb = q.reshape(B, nb, W, Hkv, G, d)

    def with_prev(t):
        t = t.reshape(B, nb, W, Hkv, d)
        prev = jnp.concatenate([jnp.zeros_like(t[:, :1]), t[:, :-1]], axis=1)
        return jnp.concatenate([prev, t], axis=2)

    kk = with_prev(k)
    vv = with_prev(v)
    s = jnp.einsum('bnqhgd,bnkhd->bnhgqk', qb, kk,
                   preferred_element_type=jnp.float32) * (d ** -0.5)
    qi = jnp.arange(W)[:, None] + W
    kj = jnp.arange(2 * W)[None, :]
    rel = qi - kj
    band = (rel >= 0) & (rel < W)
    has_prev = (jnp.arange(nb) > 0)[:, None, None] | (kj >= W)[None]
    valid = (band[None] & has_prev)[None, :, None, None]
    s = jnp.where(valid, s, NEG_INF)
    sink = sinks.astype(jnp.float32).reshape(1, 1, Hkv, G, 1, 1)
    m = jnp.maximum(jnp.max(s, axis=-1, keepdims=True), sink)
    e = jnp.where(valid, jnp.exp(s - m), 0.0)
    p = e / (jnp.sum(e, axis=-1, keepdims=True) + jnp.exp(sink - m))
    o = jnp.einsum('bnhgqk,bnkhd->bnqhgd', p.astype(v.dtype), vv)
    return o.reshape(B, S, Hq * d)


def diff_attention(q, k, v, lam):
    B, S, H, _, d = q.shape
    nb = S // Q_BLOCK
    qb = q.reshape(B, nb, Q_BLOCK, H, 2, d).swapaxes(0, 1)
    kpos = jnp.arange(S)
    scale = d ** -0.5

    def block(args):
        qi, n = args
        s = jnp.einsum('bqhcd,bkhcd->bhcqk', qi, k,
                       preferred_element_type=jnp.float32) * scale
        qpos = n * Q_BLOCK + jnp.arange(Q_BLOCK)
        causal = kpos[None, :] <= qpos[:, None]
        p = jax.nn.softmax(jnp.where(causal, s, NEG_INF), axis=-1)
        a = p[:, :, 0] - lam * p[:, :, 1]
        return jnp.einsum('bhqk,bkhe->bqhe', a.astype(v.dtype), v)

    o = lax.map(block, (qb, jnp.arange(nb)))
    return o.swapaxes(0, 1).reshape(B, S, H, 2 * d)


def hier_moe(h, wg, bg, we, be, w13, w2):
    B, S, D = h.shape
    T = B * S
    xf = h.reshape(T, D)
    x32 = xf.astype(jnp.float32)
    g_prob = jax.nn.softmax(x32 @ wg.astype(jnp.float32) + bg.astype(jnp.float32), axis=-1)
    g_w, g_idx = lax.top_k(g_prob, 1)
    e_logits = (x32 @ we.astype(jnp.float32) + be.astype(jnp.float32)).reshape(
        T, N_GROUPS, EXPERTS_PER_GROUP)
    e_sel = jnp.take_along_axis(e_logits, g_idx[:, :, None], axis=1)[:, 0]
    e_prob = jax.nn.softmax(e_sel, axis=-1)
    e_w, e_idx = lax.top_k(e_prob, TOP_K_IN_GROUP)
    e_w = e_w / jnp.sum(e_w, axis=-1, keepdims=True)
    gate = (g_w * e_w).astype(h.dtype)
    expert_id = (g_idx * EXPERTS_PER_GROUP + e_idx).astype(jnp.int32)

    A = T * TOP_K_IN_GROUP
    flat_e = expert_id.reshape(-1)
    flat_tok = jnp.repeat(jnp.arange(T, dtype=jnp.int32), TOP_K_IN_GROUP)
    flat_g = gate.reshape(-1)
    order = jnp.argsort(flat_e)
    se = flat_e[order]
    counts = jnp.bincount(flat_e, length=N_EXPERTS).astype(jnp.int32)
    padded = ((counts + MOE_BLOCK - 1) // MOE_BLOCK) * MOE_BLOCK
    pad_end = jnp.cumsum(padded)
    pad_start = pad_end - padded
    cnt_start = jnp.cumsum(counts) - counts
    dest = pad_start[se] + jnp.arange(A, dtype=jnp.int32) - cnt_start[se]
    P = ((A + MOE_BLOCK - 1) // MOE_BLOCK) * MOE_BLOCK + N_EXPERTS * MOE_BLOCK
    nblk = P // MOE_BLOCK
    row_tok = jnp.full((P,), T, jnp.int32).at[dest].set(flat_tok[order])
    row_gate = jnp.zeros((P,), h.dtype).at[dest].set(flat_g[order])
    blk_e = jnp.minimum(
        jnp.searchsorted(pad_end, jnp.arange(nblk, dtype=jnp.int32) * MOE_BLOCK, side='right'),
        N_EXPERTS - 1).astype(jnp.int32)
    x_pad = jnp.concatenate([xf, jnp.zeros((1, D), xf.dtype)], axis=0)
    xs = x_pad[row_tok].reshape(nblk, MOE_BLOCK, D)

    def expert_block(args):
        xb, e = args
        a, b = jnp.split(xb @ w13[e], 2, axis=-1)
        return (jax.nn.silu(a) * b) @ w2[e]

    ys = lax.map(expert_block, (xs, blk_e)).reshape(P, D)
    out = jnp.zeros((T + 1, D), h.dtype).at[row_tok].add(ys * row_gate[:, None])[:T]
    return out.reshape(B, S, D)


def setup_inputs(seed: int = 0) -> dict:
    key = jax.random.key(seed)
    ks = jax.random.split(key, 32)
    f32 = jnp.float32
    L = DEPTH

    def nrm(k, shape, scale):
        return jax.random.normal(k, shape, f32) * scale

    def gain(k, shape):
        return 1.0 + 0.01 * jax.random.normal(k, shape, f32)

    x = nrm(ks[0], (BATCH, SEQ, D_MODEL), 1.0)
    positions = (jnp.arange(SEQ, dtype=jnp.int32)[None, :]
                 + jax.random.randint(ks[1], (BATCH, 1), 0, MAX_POS_OFFSET, dtype=jnp.int32))
    return {
        'x': x,
        'positions': positions,
        'attn_norm_g': gain(ks[2], (L, D_MODEL)),
        'w_in': nrm(ks[3], (L, D_MODEL, IN_WIDTH), D_MODEL ** -0.5),
        'conv_dw_w': nrm(ks[4], (L, CONV_WIDTH, CONV_CH), CONV_WIDTH ** -0.5),
        'conv_dw_b': nrm(ks[5], (L, CONV_CH), 0.02),
        'conv_ln_g': gain(ks[6], (L, CONV_CH)),
        'conv_ln_b': nrm(ks[7], (L, CONV_CH), 0.02),
        'conv_pw_w': nrm(ks[8], (L, CONV_CH, CONV_CH), CONV_CH ** -0.5),
        'conv_out_g': gain(ks[9], (L, CONV_CH)),
        'swa_sinks': nrm(ks[10], (L, SWA_Q_HEADS), 0.5),
        'swa_out_g': gain(ks[11], (L, SWA_WIDTH)),
        'diff_lambda_q1': nrm(ks[12], (L, HEAD_DIM), 0.1),
        'diff_lambda_k1': nrm(ks[13], (L, HEAD_DIM), 0.1),
        'diff_lambda_q2': nrm(ks[14], (L, HEAD_DIM), 0.1),
        'diff_lambda_k2': nrm(ks[15], (L, HEAD_DIM), 0.1),
        'diff_subln_g': gain(ks[16], (L, 2 * HEAD_DIM)),
        'w_out': nrm(ks[17], (L, MIX_WIDTH, D_MODEL), MIX_WIDTH ** -0.5),
        'ffn_norm_g': gain(ks[18], (L, D_MODEL)),
        'router_group_w': nrm(ks[19], (L, D_MODEL, N_GROUPS), D_MODEL ** -0.5),
        'router_group_b': nrm(ks[20], (L, N_GROUPS), 0.01),
        'router_expert_w': nrm(ks[21], (L, D_MODEL, N_EXPERTS), D_MODEL ** -0.5),
        'router_expert_b': nrm(ks[22], (L, N_EXPERTS), 0.01),
        'moe_w13': nrm(ks[23], (L, N_EXPERTS, D_MODEL, 2 * EXPERT_FF), D_MODEL ** -0.5),
        'moe_w2': nrm(ks[24], (L, N_EXPERTS, EXPERT_FF, D_MODEL), EXPERT_FF ** -0.5),
        'final_norm_g': gain(ks[25], (D_MODEL,)),
    }


def reference(x, positions, attn_norm_g, w_in, conv_dw_w, conv_dw_b, conv_ln_g, conv_ln_b,
              conv_pw_w, conv_out_g, swa_sinks, swa_out_g, diff_lambda_q1, diff_lambda_k1,
              diff_lambda_q2, diff_lambda_k2, diff_subln_g, w_out, ffn_norm_g,
              router_group_w, router_group_b, router_expert_w, router_expert_b,
              moe_w13, moe_w2, final_norm_g):
    B, S, _ = x.shape
    cos, sin = rope_tables(positions, HEAD_DIM)
    skv = SWA_KV_HEADS * HEAD_DIM
    offs = [2 * CONV_CH]
    for w in (SWA_WIDTH, skv, skv, DIFF_WIDTH, DIFF_WIDTH):
        offs.append(offs[-1] + w)

    for i in range(DEPTH):
        h = rms_norm(x, attn_norm_g[i])
        proj = h @ w_in[i]
        u_c, q_s, k_s, v_s, q_d, k_d, v_d = jnp.split(proj, offs, axis=-1)

        y_conv = conv_module(u_c, conv_dw_w[i], conv_dw_b[i], conv_ln_g[i], conv_ln_b[i],
                             conv_pw_w[i])

        q_s = apply_rope(q_s.reshape(B, S, SWA_Q_HEADS, HEAD_DIM), cos, sin)
        k_s = apply_rope(k_s.reshape(B, S, SWA_KV_HEADS, HEAD_DIM), cos, sin)
        v_s = v_s.reshape(B, S, SWA_KV_HEADS, HEAD_DIM)
        y_swa = swa_attention(q_s, k_s, v_s, swa_sinks[i])

        lambda_init = 0.8 - 0.6 * float(np.exp(-0.3 * i))
        lam = (jnp.exp(jnp.sum(diff_lambda_q1[i].astype(jnp.float32) * diff_lambda_k1[i].astype(jnp.float32)))
               - jnp.exp(jnp.sum(diff_lambda_q2[i].astype(jnp.float32) * diff_lambda_k2[i].astype(jnp.float32)))
               + lambda_init)
        q_d = apply_rope(q_d.reshape(B, S, 2 * DIFF_HEADS, HEAD_DIM), cos, sin).reshape(
            B, S, DIFF_HEADS, 2, HEAD_DIM)
        k_d = apply_rope(k_d.reshape(B, S, 2 * DIFF_HEADS, HEAD_DIM), cos, sin).reshape(
            B, S, DIFF_HEADS, 2, HEAD_DIM)
        v_d = v_d.reshape(B, S, DIFF_HEADS, 2 * HEAD_DIM)
        o_d = diff_attention(q_d, k_d, v_d, lam)
        y_diff = (rms_norm(o_d, diff_subln_g[i], LN_EPS) * (1.0 - lambda_init)).reshape(
            B, S, DIFF_WIDTH)

        mix = jnp.concatenate([rms_norm(y_conv, conv_out_g[i]),
                               rms_norm(y_swa, swa_out_g[i]),
                               y_diff], axis=-1)
        x = x + mix @ w_out[i]

        h = rms_norm(x, ffn_norm_g[i])
        x = x + hier_moe(h, router_group_w[i], router_group_b[i], router_expert_w[i],
                         router_expert_b[i], moe_w13[i], moe_w2[i])

    return rms_norm(x, final_norm_g)
```

```cpp
#include <hip/hip_runtime.h>
#include <cstdio>
#include <cstdint>
namespace pg8 {
#define PG8_LAS __attribute__((address_space(3)))
typedef unsigned short bf16_t;
typedef short bf16x8 __attribute__((ext_vector_type(8)));
typedef float f32x4 __attribute__((ext_vector_type(4)));
typedef unsigned u32x4 __attribute__((ext_vector_type(4)));
typedef int pg8_i4 __attribute__((ext_vector_type(4)));
typedef int pg8_i8 __attribute__((ext_vector_type(8)));
constexpr int BM = 256, BK = 64, HALF = 128, HTB = HALF * BK * 2  , STAGE_BYTES = 8 * HTB, NXCD = 8, WGM = 8;

__host__ __device__ __forceinline__ int lds_byte(int r, int c) { const int st = (r >> 4) * 2 + (c >> 5), rr = r & 15, cc = c & 31, ob = rr * 64 + cc * 2; return st * 1024 + (ob ^ (((ob >> 9) & 1) << 5)); }
__host__ __device__ __forceinline__ void stage_rc(int b, int& R, int& C) { const int st = b / 1024, sb = b % 1024, swz = sb ^ (((sb >> 9) & 1) << 5); R = (st >> 1) * 16 + swz / 64; C = (st & 1) * 32 + (swz % 64) / 2; }
__host__ __device__ __forceinline__ int perm32(int rho) { const int n = rho >> 4, i = rho & 15; return 8 * (i >> 2) + 4 * n + (i & 3); }

struct Unit { int pm, pn; };
struct Gemm { const bf16_t* A; const bf16_t* Bt; int M, N, K; };

struct StaticOrder {
    int nM, nN, nwg, G, c;
    __host__ __device__ void init(int M, int N, int G_, int c_) { nM = M / BM; nN = N / BM; nwg = nM * nN; G = G_; c = c_; }
    __host__ __device__ bool next(int i, Unit& u) const {
        const long L = (long)i * G + c; if (L >= nwg) return false;
        int wgid = (int)L; { const int q = nwg / NXCD, r = nwg % NXCD, xcd = wgid % NXCD, off = wgid / NXCD; wgid = (xcd < r ? xcd * (q + 1) : r * (q + 1) + (xcd - r) * q) + off; }
        const int nig = WGM * nN, gid = wgid / nig, fm = gid * WGM, gsz = (nM - fm) < WGM ? (nM - fm) : WGM;
        u.pm = fm + ((wgid % nig) % gsz); u.pn = (wgid % nig) / gsz; return true;
    }
    __device__ __forceinline__ void a_ready(const Unit&) const {}
    __device__ __forceinline__ void done(const Unit&) const {}
};

__device__ __forceinline__ unsigned cvt_pk_bf16(float lo, float hi) { unsigned r; asm volatile("v_cvt_pk_bf16_f32 %0, %1, %2" : "=v"(r) : "v"(lo), "v"(hi)); return r; }
typedef float f32x2 __attribute__((ext_vector_type(2)));
__device__ __forceinline__ f32x2 gelu_pk(f32x2 v) {
    const f32x2 av = __builtin_elementwise_abs(v), d = av * 0.2316418882f + 1.0f;
    f32x2 t; t.x = __builtin_amdgcn_rcpf(d.x); t.y = __builtin_amdgcn_rcpf(d.y);
    f32x2 q = t * 0.5307027145f + (-0.7265760135f); q = q * t + 0.7107068705f; q = q * t + (-0.142248368f); q = q * t + 0.127414796f; q = q * t;
    const f32x2 s = (v * v) * (-0.72134752044f);
    f32x2 e; e.x = __builtin_amdgcn_exp2f(s.x); e.y = __builtin_amdgcn_exp2f(s.y);
    const f32x2 m = v * (q * e), r = v - m;
    f32x2 o; o.x = v.x < 0.f ? m.x : r.x; o.y = v.y < 0.f ? m.y : r.y; return o;
}

template <int ACT  > struct EpiBf16 {
    static constexpr bool PERM = true, AFTER_DRAIN = false; static_assert(ACT == 0 || ACT == 1, "EpiBf16: ACT is 0 (none) or 1 (gelu_pk)");
    bf16_t* O; int ldc; const float* bias; int split_cols; size_t split_stride; float scale0;
    __device__ __forceinline__ void operator()(const f32x4 (&acc)[2][2][4][2], const Unit& u, int wr, int wc, int fr, int fq) const {
        const int row0 = u.pm * BM + wr * 64 + fr; int colt = u.pn * BM; bf16_t* base = O;
        float sc = 1.f; if (split_cols) { const int t = colt / split_cols; base += (size_t)t * split_stride; colt -= t * split_cols; if (t == 0) sc = scale0; }
        const int col0 = colt + wc * 32 + 8 * fq, bcol0 = u.pn * BM + wc * 32 + 8 * fq;
        f32x4 bv[2][2];
#pragma unroll
        for (int bj = 0; bj < 2; ++bj)
#pragma unroll
            for (int n = 0; n < 2; ++n) bv[bj][n] = bias ? *(const f32x4*)(bias + bcol0 + bj * HALF + 4 * n) : (f32x4){0.f, 0.f, 0.f, 0.f};
#pragma unroll
        for (int ai = 0; ai < 2; ++ai)
#pragma unroll
            for (int m = 0; m < 4; ++m) { bf16_t* rowp = base + (size_t)(row0 + ai * HALF + m * 16) * ldc + col0;
#pragma unroll
                for (int bj = 0; bj < 2; ++bj) { f32x4 v0 = acc[ai][bj][m][0] + bv[bj][0], v1 = acc[ai][bj][m][1] + bv[bj][1];
                    if (ACT == 1) { f32x2 a = gelu_pk((f32x2){v0[0], v0[1]}), b = gelu_pk((f32x2){v0[2], v0[3]}), c = gelu_pk((f32x2){v1[0], v1[1]}), d = gelu_pk((f32x2){v1[2], v1[3]});
                        v0 = (f32x4){a.x, a.y, b.x, b.y}; v1 = (f32x4){c.x, c.y, d.x, d.y}; }
                    v0 = v0 * sc; v1 = v1 * sc; u32x4 w; w.x = cvt_pk_bf16(v0[0], v0[1]); w.y = cvt_pk_bf16(v0[2], v0[3]); w.z = cvt_pk_bf16(v1[0], v1[1]); w.w = cvt_pk_bf16(v1[2], v1[3]);
                    *(u32x4*)(rowp + bj * HALF) = w; } }
    }
};
struct EpiResF32 {
    static constexpr bool PERM = false, AFTER_DRAIN = false;
    const float* base; float* out; int ldc; float* rowss;
    __device__ __forceinline__ void operator()(const f32x4 (&acc)[2][2][4][2], const Unit& u, int wr, int wc, int fr, int fq) const {
        const int row0 = u.pm * BM + wr * 64 + fr, col0 = u.pn * BM + wc * 32 + 4 * fq;
#pragma unroll
        for (int ai = 0; ai < 2; ++ai)
#pragma unroll
            for (int m = 0; m < 4; ++m) { const size_t off = (size_t)(row0 + ai * HALF + m * 16) * ldc + col0; float ssq = 0.f;
#pragma unroll
                for (int bj = 0; bj < 2; ++bj)
#pragma unroll
                    for (int n = 0; n < 2; ++n) { const f32x4 b = *(const f32x4*)(base + off + bj * HALF + n * 16); const f32x4 o = b + acc[ai][bj][m][n]; *(f32x4*)(out + off + bj * HALF + n * 16) = o;
                        ssq += (o[0] * o[0] + o[1] * o[1]) + (o[2] * o[2] + o[3] * o[3]); }
                ssq += __shfl_xor(ssq, 16); ssq += __shfl_xor(ssq, 32);
                if (fq == 0) rowss[(size_t)(row0 + ai * HALF + m * 16) * 32 + 4 * u.pn + wc] = ssq; }
    }
};
template <bool BASE_F32> struct EpiResBf16 {
    static constexpr bool PERM = true, AFTER_DRAIN = false;
    const void* base; bf16_t* out; int ldc; float* rowss;
    __device__ __forceinline__ void operator()(const f32x4 (&acc)[2][2][4][2], const Unit& u, int wr, int wc, int fr, int fq) const {
        const int row0 = u.pm * BM + wr * 64 + fr, col0 = u.pn * BM + wc * 32 + 8 * fq;
#pragma unroll
        for (int ai = 0; ai < 2; ++ai)
#pragma unroll
            for (int m = 0; m < 4; ++m) { const size_t off = (size_t)(row0 + ai * HALF + m * 16) * ldc + col0; float ssq = 0.f;
#pragma unroll
                for (int bj = 0; bj < 2; ++bj) { f32x4 b0, b1;
                    if (BASE_F32) { b0 = *(const f32x4*)((const float*)base + off + bj * HALF); b1 = *(const f32x4*)((const float*)base + off + bj * HALF + 4); }
                    else { const u32x4 q = *(const u32x4*)((const bf16_t*)base + off + bj * HALF);
                        b0 = (f32x4){__uint_as_float(q.x << 16), __uint_as_float(q.x & 0xffff0000u), __uint_as_float(q.y << 16), __uint_as_float(q.y & 0xffff0000u)};
                        b1 = (f32x4){__uint_as_float(q.z << 16), __uint_as_float(q.z & 0xffff0000u), __uint_as_float(q.w << 16), __uint_as_float(q.w & 0xffff0000u)}; }
                    const f32x4 o0 = b0 + acc[ai][bj][m][0], o1 = b1 + acc[ai][bj][m][1];
                    ssq += ((o0[0] * o0[0] + o0[1] * o0[1]) + (o0[2] * o0[2] + o0[3] * o0[3])) + ((o1[0] * o1[0] + o1[1] * o1[1]) + (o1[2] * o1[2] + o1[3] * o1[3]));
                    u32x4 w; w.x = cvt_pk_bf16(o0[0], o0[1]); w.y = cvt_pk_bf16(o0[2], o0[3]); w.z = cvt_pk_bf16(o1[0], o1[1]); w.w = cvt_pk_bf16(o1[2], o1[3]);
                    *(u32x4*)(out + off + bj * HALF) = w; }
                ssq += __shfl_xor(ssq, 16); ssq += __shfl_xor(ssq, 32);
                if (fq == 0) rowss[(size_t)(row0 + ai * HALF + m * 16) * 32 + 4 * u.pn + wc] = ssq; }
    }
};
__device__ __forceinline__ float silu_f(float a) { return a * __builtin_amdgcn_rcpf(1.0f + __builtin_amdgcn_exp2f(-1.4426950408889634f * a)); }
struct EpiSiluMul {
    static constexpr bool PERM = true, AFTER_DRAIN = false;
    bf16_t* O; int ldc;
    __device__ __forceinline__ void operator()(const f32x4 (&acc)[2][2][4][2], const Unit& u, int wr, int wc, int fr, int fq) const {
        const int row0 = u.pm * BM + wr * 64 + fr, col0 = (u.pn & 3) * HALF + wc * 32 + 8 * fq;
#pragma unroll
        for (int ai = 0; ai < 2; ++ai)
#pragma unroll
            for (int m = 0; m < 4; ++m) { bf16_t* rowp = O + (size_t)(row0 + ai * HALF + m * 16) * ldc + col0;
                const f32x4 a0 = acc[ai][0][m][0], a1 = acc[ai][0][m][1], b0 = acc[ai][1][m][0], b1 = acc[ai][1][m][1];
                u32x4 w; w.x = cvt_pk_bf16(silu_f(a0[0]) * b0[0], silu_f(a0[1]) * b0[1]); w.y = cvt_pk_bf16(silu_f(a0[2]) * b0[2], silu_f(a0[3]) * b0[3]);
                w.z = cvt_pk_bf16(silu_f(a1[0]) * b1[0], silu_f(a1[1]) * b1[1]); w.w = cvt_pk_bf16(silu_f(a1[2]) * b1[2], silu_f(a1[3]) * b1[3]);
                *(u32x4*)rowp = w; }
    }
};
__device__ __forceinline__ unsigned pk4_fp8(float a, float b, float c, float d) {
    a = __builtin_fminf(__builtin_fmaxf(a, -448.f), 448.f); b = __builtin_fminf(__builtin_fmaxf(b, -448.f), 448.f); c = __builtin_fminf(__builtin_fmaxf(c, -448.f), 448.f); d = __builtin_fminf(__builtin_fmaxf(d, -448.f), 448.f);
    int w = 0; w = __builtin_amdgcn_cvt_pk_fp8_f32(a, b, w, false); w = __builtin_amdgcn_cvt_pk_fp8_f32(c, d, w, true); return (unsigned)w; }
struct EpiSiluMul8 {
    static constexpr bool PERM = true, AFTER_DRAIN = false;
    unsigned char* O; int ldc; float inv, osc;
    __device__ __forceinline__ void operator()(const f32x4 (&acc)[2][2][4][2], const Unit& u, int wr, int wc, int fr, int fq) const {
        typedef unsigned u32x2 __attribute__((ext_vector_type(2)));
        const int row0 = u.pm * BM + wr * 64 + fr, col0 = (u.pn & 3) * HALF + wc * 32 + 8 * fq;
#pragma unroll
        for (int ai = 0; ai < 2; ++ai)
#pragma unroll
            for (int m = 0; m < 4; ++m) { unsigned char* rowp = O + (size_t)(row0 + ai * HALF + m * 16) * ldc + col0;
                const f32x4 a0 = acc[ai][0][m][0] * inv, a1 = acc[ai][0][m][1] * inv, b0 = acc[ai][1][m][0] * (inv * osc), b1 = acc[ai][1][m][1] * (inv * osc);
                u32x2 w; w.x = pk4_fp8(silu_f(a0[0]) * b0[0], silu_f(a0[1]) * b0[1], silu_f(a0[2]) * b0[2], silu_f(a0[3]) * b0[3]);
                w.y = pk4_fp8(silu_f(a1[0]) * b1[0], silu_f(a1[1]) * b1[1], silu_f(a1[2]) * b1[2], silu_f(a1[3]) * b1[3]);
                *(u32x2*)rowp = w; }
    }
};
struct EpiScatter {
    static constexpr bool PERM = true, AFTER_DRAIN = false;
    unsigned char* O; int ldc; const int* slot; float sc;
    __device__ __forceinline__ void operator()(const f32x4 (&acc)[2][2][4][2], const Unit& u, int wr, int wc, int fr, int fq) const {
        typedef unsigned u32x2 __attribute__((ext_vector_type(2)));
        const int row0 = u.pm * BM + wr * 64 + fr, col0 = (u.pn & 7) * BM + wc * 32 + 8 * fq;
        int sl[2][4];
#pragma unroll
        for (int ai = 0; ai < 2; ++ai)
#pragma unroll
            for (int m = 0; m < 4; ++m) sl[ai][m] = slot[row0 + ai * HALF + m * 16];
#pragma unroll
        for (int ai = 0; ai < 2; ++ai)
#pragma unroll
            for (int m = 0; m < 4; ++m) { if (sl[ai][m] >= 0) { unsigned char* rowp = O + (size_t)sl[ai][m] * ldc + col0;
#pragma unroll
                for (int bj = 0; bj < 2; ++bj) { const f32x4 v0 = acc[ai][bj][m][0] * sc, v1 = acc[ai][bj][m][1] * sc; u32x2 w; w.x = pk4_fp8(v0[0], v0[1], v0[2], v0[3]); w.y = pk4_fp8(v1[0], v1[1], v1[2], v1[3]);
                    *(u32x2*)(rowp + bj * HALF) = w; } } }
    }
};
struct EpiProj {
    static constexpr bool PERM = true, AFTER_DRAIN = false;
    bf16_t* P; int ldp; bf16_t* Z; const float* rc; const float* rs; float qscale;
    __device__ __forceinline__ void operator()(const f32x4 (&acc)[2][2][4][2], const Unit& u, int wr, int wc, int fr, int fq) const {
        typedef unsigned u32x2 __attribute__((ext_vector_type(2)));
        const int row0 = u.pm * BM + wr * 64 + fr, pn = u.pn;
        if (pn < 4) {
#pragma unroll
            for (int ai = 0; ai < 2; ++ai)
#pragma unroll
                for (int m = 0; m < 4; ++m) { bf16_t* rowp = Z + (size_t)(row0 + ai * HALF + m * 16) * 512 + pn * HALF + wc * 32 + 8 * fq;
                    const f32x4 a0 = acc[ai][0][m][0], a1 = acc[ai][0][m][1], g0 = acc[ai][1][m][0], g1 = acc[ai][1][m][1];
#define PG8_SIG(x) __builtin_amdgcn_rcpf(1.0f + __builtin_amdgcn_exp2f(-1.4426950408889634f * (x)))
                    u32x4 w; w.x = cvt_pk_bf16(a0[0] * PG8_SIG(g0[0]), a0[1] * PG8_SIG(g0[1])); w.y = cvt_pk_bf16(a0[2] * PG8_SIG(g0[2]), a0[3] * PG8_SIG(g0[3]));
                    w.z = cvt_pk_bf16(a1[0] * PG8_SIG(g1[0]), a1[1] * PG8_SIG(g1[1])); w.w = cvt_pk_bf16(a1[2] * PG8_SIG(g1[2]), a1[3] * PG8_SIG(g1[3]));
#undef PG8_SIG
                    *(u32x4*)rowp = w; }
        } else if (pn == 8 || pn >= 15) {
            const int col0 = pn * BM + wc * 32 + 8 * fq;
#pragma unroll
            for (int ai = 0; ai < 2; ++ai)
#pragma unroll
                for (int m = 0; m < 4; ++m) { bf16_t* rowp = P + (size_t)(row0 + ai * HALF + m * 16) * ldp + col0;
#pragma unroll
                    for (int bj = 0; bj < 2; ++bj) { const f32x4 v0 = acc[ai][bj][m][0], v1 = acc[ai][bj][m][1]; u32x4 w; w.x = cvt_pk_bf16(v0[0], v0[1]); w.y = cvt_pk_bf16(v0[2], v0[3]); w.z = cvt_pk_bf16(v1[0], v1[1]); w.w = cvt_pk_bf16(v1[2], v1[3]);
                        *(u32x4*)(rowp + bj * HALF) = w; } }
        } else {
            const float sc = (pn <= 6 || (pn >= 9 && pn <= 11)) ? qscale : 1.0f;
            const int f = 16 * (wc & 1) + 4 * fq, col0 = pn * BM + 64 * (wc >> 1) + f;
#pragma unroll
            for (int ai = 0; ai < 2; ++ai)
#pragma unroll
                for (int m = 0; m < 4; ++m) { const int row = row0 + ai * HALF + m * 16;
                    const f32x4 c4 = *(const f32x4*)(rc + (size_t)row * 32 + f) * sc, s4 = *(const f32x4*)(rs + (size_t)row * 32 + f) * sc;
                    bf16_t* rowp = P + (size_t)row * ldp + col0;
#pragma unroll
                    for (int bj = 0; bj < 2; ++bj) { const f32x4 x1 = acc[ai][bj][m][0], x2 = acc[ai][bj][m][1]; const f32x4 o1 = x1 * c4 - x2 * s4, o2 = x2 * c4 + x1 * s4;
                        u32x2 w1, w2; w1.x = cvt_pk_bf16(o1[0], o1[1]); w1.y = cvt_pk_bf16(o1[2], o1[3]); w2.x = cvt_pk_bf16(o2[0], o2[1]); w2.y = cvt_pk_bf16(o2[2], o2[3]);
                        *(u32x2*)(rowp + bj * HALF) = w1; *(u32x2*)(rowp + bj * HALF + 32) = w2; } }
        }
    }
};
struct GroupedOrder {
    const PG8_LAS int* tab; int ntiles, NC, G, c;
    __device__ __forceinline__ bool next(int i, Unit& u) const {
        const int L = i * G + c; if (L >= ntiles * NC) return false;
        const int rt = L / NC, j = L - rt * NC; u.pm = rt; u.pn = tab[rt] * NC + j; return true;
    }
    __device__ __forceinline__ void a_ready(const Unit&) const {}
    __device__ __forceinline__ void done(const Unit&) const {}
};
template <class Epi, class Sched, bool ALIGN_EPI = false, bool SP2 = false, bool GATHER = false, bool FP8 = false>
__device__ __forceinline__ void gemm_phase(PG8_LAS unsigned char* lds, const Gemm g, const Sched& S, const Epi& E, int tid_in  , const PG8_LAS unsigned* gofs = nullptr) {
    static_assert(!GATHER || SP2, "GATHER is wired into the SP2 loop only");
    int tid_ = tid_in; asm volatile("" : "+v"(tid_));
    const int tid = tid_, wid = __builtin_amdgcn_readfirstlane(tid >> 6), lane = tid & 63, wr = wid >> 2, wc = wid & 3, fr = lane & 15, fq = lane >> 4;
    int K_ = g.K; asm volatile("" : "+s"(K_));
    const int K = K_, nt = K / BK;
    unsigned voffA[2], voffB[2];
#pragma unroll
    for (int i = 0; i < 2; ++i) { int R, C; stage_rc(tid * 16 + i * 8192, R, C); const int Rb = Epi::PERM ? ((R & ~31) + perm32(R & 31)) : R;
        voffA[i] = (unsigned)(R * K + C) * 2u; voffB[i] = (unsigned)(Rb * K + C) * 2u; }
    int gL[2], gC[2];
#pragma unroll
    for (int i = 0; i < 2; ++i) { int R, C; stage_rc(tid * 16 + i * 8192, R, C); gL[i] = R; gC[i] = C * 2; }
    const size_t kstep = (size_t)(BK * 2);
    const size_t hstep = (size_t)HALF * K * 2;
    const size_t tstep = 2 * hstep;
    const unsigned ldsw = (unsigned)wid * 1024u;
    const int aoff = lds_byte(wr * 64 + fr, fq * 8), boff = lds_byte(wc * 32 + fr, fq * 8);
#define PG8_SA(b, h) (((b) * 2 + (h)) * HTB)
#define PG8_SB(b, h) ((4 + (b) * 2 + (h)) * HTB)
#define PG8_STAGE(bufoff, gbase, voff) do { _Pragma("unroll") for (int _i = 0; _i < 2; ++_i) \
        __builtin_amdgcn_global_load_lds((const unsigned*)((const char*)(gbase) + (voff)[_i]), (PG8_LAS unsigned*)(lds + (bufoff) + ldsw + _i * 8192), 16, 0, 0); } while (0)
#define PG8_STAGE_A(bufoff, ptr, h, nx) do { if constexpr (GATHER) { const int ub_ = ((nx) ? gnext : ui) * 256 + (h) * 128; unsigned vv_[2]; _Pragma("unroll") for (int _j = 0; _j < 2; ++_j) vv_[_j] = gofs[ub_ + gL[_j]] + (unsigned)gC[_j]; PG8_STAGE(bufoff, ptr, vv_); } \
        else { PG8_STAGE(bufoff, (ptr) + (size_t)(h) * hstep, voffA); } } while (0)
#define PG8_LDA(dst, b, h) do { _Pragma("unroll") for (int m = 0; m < 4; ++m) _Pragma("unroll") for (int k = 0; k < 2; ++k) dst[m][k] = *(const PG8_LAS bf16x8*)(lds + PG8_SA(b, h) + aoff + m * 2048 + k * 1024); } while (0)
#define PG8_LDB(dst, b, h) do { _Pragma("unroll") for (int n = 0; n < 2; ++n) _Pragma("unroll") for (int k = 0; k < 2; ++k) dst[n][k] = *(const PG8_LAS bf16x8*)(lds + PG8_SB(b, h) + boff + n * 2048 + k * 1024); } while (0)
#define PG8_CAT(x0, x1) __builtin_shufflevector(__builtin_bit_cast(pg8_i4, x0), __builtin_bit_cast(pg8_i4, x1), 0, 1, 2, 3, 4, 5, 6, 7)
#define PG8_MMA(ai, bj, At, Bt) do { __builtin_amdgcn_s_setprio(1); if constexpr (FP8) { _Pragma("unroll") for (int m = 0; m < 4; ++m) _Pragma("unroll") for (int n = 0; n < 2; ++n) \
        { const pg8_i8 b8_ = PG8_CAT(Bt[n][0], Bt[n][1]), a8_ = PG8_CAT(At[m][0], At[m][1]); asm volatile("v_mfma_f32_16x16x128_f8f6f4 %0, %1, %2, %0" : "+v"(acc[ai][bj][m][n]) : "v"(b8_), "v"(a8_)); } } \
        else { _Pragma("unroll") for (int m = 0; m < 4; ++m) _Pragma("unroll") for (int n = 0; n < 2; ++n) _Pragma("unroll") for (int k = 0; k < 2; ++k) \
        acc[ai][bj][m][n] = __builtin_amdgcn_mfma_f32_16x16x32_bf16(Bt[n][k], At[m][k], acc[ai][bj][m][n], 0, 0, 0); } __builtin_amdgcn_s_setprio(0); } while (0)
#define PG8_WAIT_V(n) asm volatile("s_waitcnt vmcnt(" #n ")" ::: "memory")
#define PG8_WAIT_L(n) asm volatile("s_waitcnt lgkmcnt(" #n ")" ::: "memory")
#define PG8_BAR __builtin_amdgcn_s_barrier()
#define PG8_SCHED __builtin_amdgcn_sched_barrier(0)
    Unit cur, nxt; int ui = 0;
    if (!S.next(0, cur)) return;
    f32x4 acc[2][2][4][2];
#pragma unroll
    for (int a = 0; a < 2; ++a)
#pragma unroll
        for (int b = 0; b < 2; ++b)
#pragma unroll
            for (int m = 0; m < 4; ++m)
#pragma unroll
                for (int n = 0; n < 2; ++n) acc[a][b][m][n] = (f32x4){0.f, 0.f, 0.f, 0.f};
    bf16x8 At[4][2], B0[2][2], B1[2][2];
    const char* cA = GATHER ? (const char*)g.A : (const char*)g.A + (size_t)cur.pm * tstep; int gnext = 0;
    const char* cB = (const char*)g.Bt + (size_t)cur.pn * tstep;
    S.a_ready(cur);
    if constexpr (SP2) {
        PG8_STAGE(PG8_SB(0, 0), cB, voffB); PG8_STAGE(PG8_SB(0, 1), cB + hstep, voffB); PG8_STAGE_A(PG8_SA(0, 0), cA, 0, false); PG8_STAGE_A(PG8_SA(0, 1), cA, 1, false);
        if (wr == 1) PG8_BAR;
        PG8_WAIT_V(2); PG8_BAR;
        PG8_STAGE(PG8_SB(1, 0), cB + kstep, voffB); PG8_STAGE_A(PG8_SA(1, 0), cA + kstep, 0, false); PG8_STAGE(PG8_SB(1, 1), cB + hstep + kstep, voffB);
        PG8_WAIT_V(6); PG8_BAR;
    } else {
        PG8_STAGE(PG8_SB(0, 0), cB, voffB); PG8_STAGE(PG8_SA(0, 0), cA, voffA); PG8_STAGE(PG8_SB(0, 1), cB + hstep, voffB); PG8_STAGE(PG8_SA(0, 1), cA + hstep, voffA);
        if (wr == 1) PG8_BAR;
        PG8_WAIT_V(4); PG8_BAR;
        PG8_STAGE(PG8_SB(1, 0), cB + kstep, voffB); PG8_STAGE(PG8_SA(1, 0), cA + kstep, voffA); PG8_STAGE(PG8_SB(1, 1), cB + hstep + kstep, voffB);
        PG8_WAIT_V(6); PG8_BAR;
    }
    for (;;) {
        const bool has_next = S.next(ui + 1, nxt);
        const char* nA = (has_next && !GATHER) ? (const char*)g.A + (size_t)nxt.pm * tstep : cA;
        gnext = has_next ? ui + 1 : ui;
        const char* nB = has_next ? (const char*)g.Bt + (size_t)nxt.pn * tstep : cB;
        for (int t = 0; t < nt; t += 2) {
            const bool last = (t == nt - 2);
            const char* a1 = cA + (size_t)(t + 1) * kstep;
            const char* a2 = last ? nA : cA + (size_t)(t + 2) * kstep; const char* b2 = last ? nB : cB + (size_t)(t + 2) * kstep;
            const char* a3 = a2 + kstep; const char* b3 = b2 + kstep;
            if (last && has_next) S.a_ready(nxt);
            if constexpr (SP2) {
            PG8_LDB(B0, 0, 0); PG8_LDB(B1, 0, 1); PG8_SCHED; PG8_LDA(At, 0, 0); PG8_STAGE_A(PG8_SA(1, 1), a1, 1, false);
            PG8_WAIT_V(8); PG8_WAIT_L(0); PG8_BAR; PG8_MMA(0, 0, At, B0); PG8_MMA(0, 1, At, B1); PG8_BAR; PG8_SCHED;
            PG8_LDA(At, 0, 1); PG8_STAGE(PG8_SB(0, 0), b2, voffB); PG8_STAGE(PG8_SB(0, 1), b2 + hstep, voffB); PG8_STAGE_A(PG8_SA(0, 0), a2, 0, last);
            PG8_WAIT_V(8); PG8_WAIT_L(0); PG8_BAR; PG8_MMA(1, 0, At, B0); PG8_MMA(1, 1, At, B1); PG8_BAR; PG8_SCHED;
            PG8_LDB(B0, 1, 0); PG8_LDB(B1, 1, 1); PG8_SCHED; PG8_LDA(At, 1, 0); PG8_STAGE_A(PG8_SA(0, 1), a2, 1, last);
            PG8_WAIT_V(8); PG8_WAIT_L(0); PG8_BAR; PG8_MMA(0, 0, At, B0); PG8_MMA(0, 1, At, B1); PG8_BAR; PG8_SCHED;
            PG8_LDA(At, 1, 1); PG8_STAGE(PG8_SB(1, 0), b3, voffB); PG8_STAGE(PG8_SB(1, 1), b3 + hstep, voffB); PG8_STAGE_A(PG8_SA(1, 0), a3, 0, last);
            PG8_WAIT_V(8); PG8_WAIT_L(0); PG8_BAR; PG8_MMA(1, 0, At, B0); PG8_MMA(1, 1, At, B1); PG8_BAR; PG8_SCHED;
            } else {
            PG8_LDB(B0, 0, 0); PG8_SCHED; PG8_LDA(At, 0, 0); PG8_STAGE(PG8_SA(1, 1), a1 + hstep, voffA);
            PG8_WAIT_L(8); PG8_BAR; PG8_WAIT_L(0); PG8_MMA(0, 0, At, B0); PG8_BAR; PG8_SCHED;
            PG8_LDB(B1, 0, 1); PG8_STAGE(PG8_SB(0, 0), b2, voffB);
            PG8_BAR; PG8_WAIT_L(0); PG8_MMA(0, 1, At, B1); PG8_BAR;
            PG8_LDA(At, 0, 1); PG8_STAGE(PG8_SA(0, 0), a2, voffA);
            PG8_BAR; PG8_WAIT_L(0); PG8_MMA(1, 0, At, B0); PG8_BAR; PG8_SCHED;
            PG8_STAGE(PG8_SB(0, 1), b2 + hstep, voffB);
            PG8_WAIT_V(6); PG8_BAR; PG8_MMA(1, 1, At, B1); PG8_BAR;
            PG8_LDB(B0, 1, 0); PG8_SCHED; PG8_LDA(At, 1, 0); PG8_STAGE(PG8_SA(0, 1), a2 + hstep, voffA);
            PG8_WAIT_L(8); PG8_BAR; PG8_WAIT_L(0); PG8_MMA(0, 0, At, B0); PG8_BAR; PG8_SCHED;
            PG8_LDB(B1, 1, 1); PG8_STAGE(PG8_SB(1, 0), b3, voffB);
            PG8_BAR; PG8_WAIT_L(0); PG8_MMA(0, 1, At, B1); PG8_BAR;
            PG8_LDA(At, 1, 1); PG8_STAGE(PG8_SA(1, 0), a3, voffA);
            PG8_BAR; PG8_WAIT_L(0); PG8_MMA(1, 0, At, B0); PG8_BAR; PG8_SCHED;
            PG8_STAGE(PG8_SB(1, 1), b3 + hstep, voffB);
            PG8_WAIT_V(6); PG8_BAR; PG8_MMA(1, 1, At, B1); PG8_BAR;
            }
        }
        if constexpr (FP8) asm volatile("s_nop 15\n\ts_nop 15" ::: "memory");
        if constexpr (ALIGN_EPI) { if (wr == 0) PG8_BAR; }
        if constexpr (!Epi::AFTER_DRAIN) { E(acc, cur, wr, wc, fr, fq); S.done(cur); }
        if (!has_next) break;
#pragma unroll
        for (int a = 0; a < 2; ++a)
#pragma unroll
            for (int b = 0; b < 2; ++b)
#pragma unroll
                for (int m = 0; m < 4; ++m)
#pragma unroll
                    for (int n = 0; n < 2; ++n) acc[a][b][m][n] = (f32x4){0.f, 0.f, 0.f, 0.f};
        cur = nxt; cA = nA; cB = nB; ++ui;
        if constexpr (ALIGN_EPI) { if (wr == 1) PG8_BAR; }
    }
    PG8_WAIT_V(0);
    if constexpr (!ALIGN_EPI) { if (wr == 0) PG8_BAR; }
    PG8_BAR;
    if constexpr (Epi::AFTER_DRAIN) { E.fused(acc, cur, wr, wc, fr, fq, lds, wid, lane); S.done(cur); }
#undef PG8_SA
#undef PG8_STAGE_A
#undef PG8_SB
#undef PG8_STAGE
#undef PG8_LDA
#undef PG8_LDB
#undef PG8_MMA
#undef PG8_CAT
#undef PG8_WAIT_V
#undef PG8_WAIT_L
#undef PG8_BAR
#undef PG8_SCHED
}
}
#include <hip/hip_bf16.h>
#include <cmath>
namespace attn_body {
using bf16=__hip_bfloat16;
using bf16x8=__attribute__((ext_vector_type(8)))short;
using s16x4=__attribute__((ext_vector_type(4)))short;
using f32x16=__attribute__((ext_vector_type(16)))float;
using u32x4=__attribute__((ext_vector_type(4)))unsigned;
constexpr int SEQ=2048,D=64,PQ=4608,PO=1536;
constexpr int NW=8,QBLK=32,QB=QBLK*NW,KVBLK=64,NQB=SEQ/QB;
constexpr int ATTN_UNIT_ROWS=QB;
__device__ __forceinline__ int crow(int r,int hi){return (r&3)+8*(r>>2)+4*hi;}
#define SBAR() __builtin_amdgcn_sched_barrier(0)
__device__ __forceinline__ void cmask(f32x16&p0,f32x16&p1,int jb,int qrel,int hi){
  const float NEG=-INFINITY; int kb=64*jb+4*hi;
  #pragma unroll
  for(int r=0;r<16;++r){int kv=kb+(r&3)+8*(r>>2); if(kv>qrel)p0[r]=NEG; if(kv+32>qrel)p1[r]=NEG;}
}

constexpr int NSLOT=3, SLOTB=8192;
constexpr int LDS_K=0, LDS_V=NSLOT*SLOTB, LDS_WS=2*NSLOT*SLOTB, LDS_OST=LDS_WS+NW*64*4, LDS_BYTES=LDS_OST+NW*4096;
constexpr float C2=0.125f*1.4426950408889634f;
__device__ __forceinline__ void glds16(const void*gsrc,unsigned lds_dst){unsigned keep;
  asm volatile("s_mov_b32 %0, m0\n\ts_mov_b32 m0, %2\n\ts_nop 0\n\tglobal_load_lds_dwordx4 %1, off\n\ts_mov_b32 m0, %0":"=&s"(keep):"v"(gsrc),"s"(lds_dst):"memory");}
__device__ __forceinline__ float max3f(float a,float b,float c){float r;asm("v_max3_f32 %0, %1, %2, %3":"=v"(r):"v"(a),"v"(b),"v"(c));return r;}
__device__ __forceinline__ float max2f(float a,float b){float r;asm("v_max_f32_e32 %0, %1, %2":"=v"(r):"v"(a),"v"(b));return r;}
__device__ __forceinline__ float fadd_s(float a,float b){float r;asm("v_add_f32_e32 %0, %1, %2":"=v"(r):"v"(a),"v"(b));return r;}
__device__ __forceinline__ float fsub_s(float a,float b){float r;asm("v_sub_f32_e32 %0, %1, %2":"=v"(r):"v"(a),"v"(b));return r;}
typedef float f32x2_t __attribute__((ext_vector_type(2))); typedef __bf16 bf16x2_t __attribute__((ext_vector_type(2)));
__device__ __forceinline__ unsigned cvtpk_s(float lo,float hi){f32x2_t v={lo,hi};bf16x2_t b=__builtin_convertvector(v,bf16x2_t);return __builtin_bit_cast(unsigned,b);}
#define WAIT_BAR(N) asm volatile("s_waitcnt vmcnt(" #N ") lgkmcnt(0)\n\ts_barrier":::"memory")

__device__ __forceinline__ void qkt(f32x16&p0,f32x16&p1,const char*Kslot,const bf16x8*qr,const f32x16&negm,int r32,int hi){
  const char*kb=Kslot+hi*1024+r32*16;
  #pragma unroll
  for(int d0=0;d0<4;++d0){
    const bf16x8 b0=*reinterpret_cast<const bf16x8*>(kb+d0*2048);
    const bf16x8 b1=*reinterpret_cast<const bf16x8*>(kb+d0*2048+512);
    if(d0==0){p0=__builtin_amdgcn_mfma_f32_32x32x16_bf16(b0,qr[0],negm,0,0,0);p1=__builtin_amdgcn_mfma_f32_32x32x16_bf16(b1,qr[0],negm,0,0,0);}
    else{p0=__builtin_amdgcn_mfma_f32_32x32x16_bf16(b0,qr[d0],p0,0,0,0);p1=__builtin_amdgcn_mfma_f32_32x32x16_bf16(b1,qr[d0],p1,0,0,0);}}
}
typedef __attribute__((address_space(3))) const char* lds_cptr;
typedef short v4i16_t __attribute__((ext_vector_type(4)));
__device__ __forceinline__ void kload8(bf16x8*kf,lds_cptr kp){
  kf[0]=*(const __attribute__((address_space(3))) bf16x8*)(kp);      kf[1]=*(const __attribute__((address_space(3))) bf16x8*)(kp+512);
  kf[2]=*(const __attribute__((address_space(3))) bf16x8*)(kp+2048); kf[3]=*(const __attribute__((address_space(3))) bf16x8*)(kp+2560);
  kf[4]=*(const __attribute__((address_space(3))) bf16x8*)(kp+4096); kf[5]=*(const __attribute__((address_space(3))) bf16x8*)(kp+4608);
  kf[6]=*(const __attribute__((address_space(3))) bf16x8*)(kp+6144); kf[7]=*(const __attribute__((address_space(3))) bf16x8*)(kp+6656);
}
__device__ __forceinline__ void kload2(bf16x8*kf,lds_cptr kp,int j){ kf[2*j]=*(const __attribute__((address_space(3))) bf16x8*)(kp+j*2048); kf[2*j+1]=*(const __attribute__((address_space(3))) bf16x8*)(kp+j*2048+512); }
__device__ __forceinline__ s16x4 vtr(lds_cptr p){ return __builtin_bit_cast(s16x4,__builtin_amdgcn_ds_read_tr16_b64_v4i16((__attribute__((address_space(3))) v4i16_t*)p)); }
__device__ __forceinline__ float rowmax(const f32x16&p0,const f32x16&p1){
  float a=max3f(p0[0],p0[1],p1[0]),b=max3f(p0[2],p0[3],p1[1]);a=max3f(a,p1[2],p1[3]);
  #pragma unroll
  for(int r=4;r<16;r+=4){a=max3f(a,p0[r],p0[r+1]);b=max3f(b,p0[r+2],p0[r+3]);a=max3f(a,p1[r],p1[r+1]);b=max3f(b,p1[r+2],p1[r+3]);}
  const float m=max2f(a,b);
  auto rr=__builtin_amdgcn_permlane32_swap(__float_as_uint(m),__float_as_uint(m),false,false);
  return max2f(__uint_as_float(rr[0]),__uint_as_float(rr[1]));
}
__device__ __forceinline__ void pv(f32x16*o,int vb,bf16x8 pa0,bf16x8 pa1,bf16x8 pa2,bf16x8 pa3){
  #pragma unroll
  for(int d0=0;d0<2;++d0){s16x4 lo[4],hi[4];
    #pragma unroll
    for(int ks=0;ks<4;++ks){
      asm volatile("ds_read_b64_tr_b16 %0,%1 offset:%c2":"=&v"(lo[ks]):"v"(vb),"i"(d0*4096+ks*1024):"memory");
      asm volatile("ds_read_b64_tr_b16 %0,%1 offset:%c2":"=&v"(hi[ks]):"v"(vb),"i"(d0*4096+ks*1024+512):"memory");}
    asm volatile("s_waitcnt lgkmcnt(0)":::"memory");SBAR();
    #define PK(k) (bf16x8){lo[k][0],lo[k][1],lo[k][2],lo[k][3],hi[k][0],hi[k][1],hi[k][2],hi[k][3]}
    o[d0]=__builtin_amdgcn_mfma_f32_32x32x16_bf16(pa0,PK(0),o[d0],0,0,0);
    o[d0]=__builtin_amdgcn_mfma_f32_32x32x16_bf16(pa1,PK(1),o[d0],0,0,0);
    o[d0]=__builtin_amdgcn_mfma_f32_32x32x16_bf16(pa2,PK(2),o[d0],0,0,0);
    o[d0]=__builtin_amdgcn_mfma_f32_32x32x16_bf16(pa3,PK(3),o[d0],0,0,0);
    #undef PK
  }
}

#ifndef ATTN_STORE16
#define ATTN_STORE16(p,v) (*(u32x4*)(p)=(v))
#endif
template<int THRL> __device__ __forceinline__ void attn_unit(int b,int qb,const bf16*Q,const bf16*__restrict__ K,const bf16*__restrict__ V,bf16*O,char*shm,int tid_in){
  int tid_=tid_in; asm volatile("":"+v"(tid_));
  const int tid=tid_,lane=tid&63,r32=lane&31,hi=lane>>5; const int wid=__builtin_amdgcn_readfirstlane(tid>>6);
  const long rowbase=(long)b*SEQ; const int q0=qb*QB;
  const bf16*Qw=Q+(rowbase+q0+wid*QBLK)*PQ;
  const bf16*Kh=K+rowbase*PQ,*Vh=V+rowbase*PQ;
  const unsigned lds0=(unsigned)(uintptr_t)shm;
  float*wsf=(float*)(shm+LDS_WS)+wid*64;
  const bf16*ksrc=Kh+(long)lane*PQ+wid*8;
  const bf16*vsrc=Vh+(long)(16*(wid&3)+(lane>>2))*PQ+(wid>>2)*32+(lane&3)*8;
  const unsigned kdst=lds0+LDS_K+wid*1024, vdst=lds0+LDS_V+wid*1024;
  #define DMA_K(t,slot) glds16(ksrc+(long)(t)*KVBLK*PQ,(unsigned)__builtin_amdgcn_readfirstlane(kdst+(slot)))
  #define DMA_V(t,slot) glds16(vsrc+(long)(t)*KVBLK*PQ,(unsigned)__builtin_amdgcn_readfirstlane(vdst+(slot)))
  const int vb0=(int)(lds0+LDS_V)+((lane>>4)&1)*32+(lane&3)*8+(4*hi+((lane&15)>>2))*64;
  const char*Kbase=shm+LDS_K; bf16x8 kf[8];
  const lds_cptr shm3=(lds_cptr)shm; const lds_cptr kp0=shm3+LDS_K+hi*1024+r32*16; const lds_cptr vp0=shm3+LDS_V+((lane>>4)&1)*32+(lane&3)*8+(4*hi+((lane&15)>>2))*64;
  const int NT=(q0+QB)/KVBLK;
  DMA_K(0,0);DMA_V(0,0);DMA_K(1,SLOTB);
  bf16x8 qr[4];
  #pragma unroll
  for(int d0=0;d0<4;++d0)qr[d0]=*reinterpret_cast<const bf16x8*>(&Qw[(long)r32*PQ+d0*16+hi*8]);
  float mhat=0.f,l_reg=0.f;f32x16 o[2];o[0]=f32x16{};o[1]=f32x16{};f32x16 negm=f32x16{};asm volatile("":"+v"(negm));
  const int qrel=wid*QBLK+r32;
  #define CMASK(P0,P1,t) do{int jb_=(t)-(NT-4); if(jb_>=0)cmask(P0,P1,jb_,qrel,hi);}while(0)
  bool resc=false;
  #define START(P0,P1) do{ const float rm=rowmax(P0,P1); resc=false; \
    { const float dl=rm; mhat=fadd_s(mhat,dl); \
      _Pragma("unroll") for(int r=0;r<16;++r){P0[r]=fsub_s(P0[r],dl);P1[r]=fsub_s(P1[r],dl);} \
      _Pragma("unroll") for(int r=0;r<16;++r)negm[r]=-mhat; asm volatile("":"+v"(negm)); } \
    _Pragma("unroll") for(int r=0;r<16;++r)P0[r]=__builtin_amdgcn_exp2f(P0[r]); }while(0)
  #define RESC() do{ if(resc){ asm volatile("s_waitcnt lgkmcnt(0)":::"memory"); \
      _Pragma("unroll") for(int d_=0;d_<2;++d_) _Pragma("unroll") for(int r=0;r<16;++r)o[d_][r]*=wsf[crow(r,hi)]; } }while(0)
  f32x16 pA0,pA1,pB0,pB1;
  int sl_prev=0,sl_cur=0,sl_next=SLOTB;
  #define ROT() do{sl_prev=sl_cur;sl_cur=sl_next;sl_next=(sl_next==(NSLOT-1)*SLOTB)?0:sl_next+SLOTB;}while(0)
  DMA_K(2,2*SLOTB);
  WAIT_BAR(3);
  qkt(pA0,pA1,Kbase,qr,negm,r32,hi);asm volatile("s_nop 15\n\ts_nop 7":"+v"(pA0),"+v"(pA1));CMASK(pA0,pA1,0);
  START(pA0,pA1);
  _Pragma("unroll") for(int r=0;r<16;++r)pA1[r]=__builtin_amdgcn_exp2f(pA1[r]);
  WAIT_BAR(0);
  DMA_K(3,0);DMA_V(1,SLOTB);
  ROT();
  kload8(kf,kp0+sl_cur);
  WAIT_BAR(2);
  s16x4 vlo[8],vhi[8]; u32x4 pw0,pw1,pw2,pw3;
  #define PKW(P,B) cvtpk_s(P[B],P[B+1])
  #define PAF(k) __builtin_bit_cast(bf16x8,pw##k)
  #define VFR(i) (bf16x8){vlo[i][0],vlo[i][1],vlo[i][2],vlo[i][3],vhi[i][0],vhi[i][1],vhi[i][2],vhi[i][3]}
  #define PIN(x) asm volatile("":"+v"(x))
  #define MX3(a,b,c) __builtin_fmaxf(__builtin_fmaxf((a),(b)),(c))
  #define GAPA(MF,A0,A1,A2,A3,W0,W1,PW) do{ MF; sacc+=A0; sacc+=A1; sacc+=A2; sacc+=A3; PIN(sacc); W0; W1; PIN(PW); SBAR(); }while(0)
  #define EX(v) __builtin_amdgcn_exp2f(v)
  #define GAPB(MF,X,B) do{ MF; X[B]=EX(X[B]); X[B+1]=EX(X[B+1]); X[B+2]=EX(X[B+2]); X[B+3]=EX(X[B+3]); PIN(X); SBAR(); }while(0)
  #define VRD(i) do{ vlo[i]=vtr(vp_+(((i)>>2)*4096+((i)&3)*1024)); vhi[i]=vtr(vp_+(((i)>>2)*4096+((i)&3)*1024+512)); }while(0)
  #define KRD(G,j) do{ if(G){ kload2(kf,kp0+sl_next,j); SBAR(); } }while(0)
  #define STEP(C0,C1,P0,P1,t,GK,GV,GL) do{ SBAR(); \
    const lds_cptr vp_=vp0+sl_prev; \
    VRD(0); SBAR(); float sacc=(P0[0]+P0[1]); \
    GAPA(C0=__builtin_amdgcn_mfma_f32_32x32x16_bf16(kf[0],qr[0],negm,0,0,0), P0[2],P0[3],P0[4],P0[5],     pw0[0]=PKW(P0,0), pw0[1]=PKW(P0,2), pw0); \
    VRD(4); SBAR(); GAPA(C1=__builtin_amdgcn_mfma_f32_32x32x16_bf16(kf[1],qr[0],negm,0,0,0), P0[6],P0[7],P0[8],P0[9],     pw0[2]=PKW(P0,4), pw0[3]=PKW(P0,6), pw0); \
    VRD(1); SBAR(); GAPA(C0=__builtin_amdgcn_mfma_f32_32x32x16_bf16(kf[2],qr[1],C0,0,0,0),   P0[10],P0[11],P0[12],P0[13], pw1[0]=PKW(P0,8), pw1[1]=PKW(P0,10), pw1); \
    VRD(5); SBAR(); GAPA(C1=__builtin_amdgcn_mfma_f32_32x32x16_bf16(kf[3],qr[1],C1,0,0,0),   P0[14],P0[15],P1[0],P1[1],   pw1[2]=PKW(P0,12),pw1[3]=PKW(P0,14), pw1); \
    VRD(2); SBAR(); GAPA(C0=__builtin_amdgcn_mfma_f32_32x32x16_bf16(kf[4],qr[2],C0,0,0,0),   P1[2],P1[3],P1[4],P1[5],     pw2[0]=PKW(P1,0), pw2[1]=PKW(P1,2), pw2); \
    VRD(6); SBAR(); GAPA(C1=__builtin_amdgcn_mfma_f32_32x32x16_bf16(kf[5],qr[2],C1,0,0,0),   P1[6],P1[7],P1[8],P1[9],     pw2[2]=PKW(P1,4), pw2[3]=PKW(P1,6), pw2); \
    VRD(3); SBAR(); GAPA(C0=__builtin_amdgcn_mfma_f32_32x32x16_bf16(kf[6],qr[3],C0,0,0,0),   P1[10],P1[11],P1[12],P1[13], pw3[0]=PKW(P1,8), pw3[1]=PKW(P1,10), pw3); \
    VRD(7); SBAR(); GAPA(C1=__builtin_amdgcn_mfma_f32_32x32x16_bf16(kf[7],qr[3],C1,0,0,0),   P1[14],P1[15],0.f,0.f,       pw3[2]=PKW(P1,12),pw3[3]=PKW(P1,14), pw3); \
    l_reg+=sacc; \
    if(GK){DMA_K((t)+3,sl_cur);} if(GV){DMA_V((t)+1,sl_next);} \
    CMASK(C0,C1,t); \
    { float a=MX3(C0[0],C0[1],C1[0]),b=MX3(C0[2],C0[3],C1[1]); a=MX3(a,C1[2],C1[3]); \
      _Pragma("unroll") for(int r=4;r<16;r+=4){a=MX3(a,C0[r],C0[r+1]);b=MX3(b,C0[r+2],C0[r+3]);a=MX3(a,C1[r],C1[r+1]);b=MX3(b,C1[r+2],C1[r+3]);} \
      float rm=__builtin_fmaxf(a,b); { auto rr=__builtin_amdgcn_permlane32_swap(__float_as_uint(rm),__float_as_uint(rm),false,false); rm=__builtin_fmaxf(__uint_as_float(rr[0]),__uint_as_float(rr[1])); } \
      resc=false; \
      if(__builtin_expect(__any(rm>(float)THRL),0)){ const float dl=__builtin_fmaxf(rm,0.f); mhat+=dl; \
        _Pragma("unroll") for(int r=0;r<16;++r){C0[r]-=dl;C1[r]-=dl;} \
        _Pragma("unroll") for(int r=0;r<16;++r)negm[r]=-mhat; asm volatile("":"+v"(negm)); \
        const float f=__builtin_amdgcn_exp2f(-dl); l_reg*=f; if(hi==0)wsf[r32]=f; resc=true; } } \
    SBAR(); \
    GAPB(o[0]=__builtin_amdgcn_mfma_f32_32x32x16_bf16(PAF(0),VFR(0),o[0],0,0,0), C0,0); \
    GAPB(o[1]=__builtin_amdgcn_mfma_f32_32x32x16_bf16(PAF(0),VFR(4),o[1],0,0,0), C0,4); \
    KRD(GL,0); GAPB(o[0]=__builtin_amdgcn_mfma_f32_32x32x16_bf16(PAF(1),VFR(1),o[0],0,0,0), C0,8); \
    KRD(GL,1); GAPB(o[1]=__builtin_amdgcn_mfma_f32_32x32x16_bf16(PAF(1),VFR(5),o[1],0,0,0), C0,12); \
    KRD(GL,2); GAPB(o[0]=__builtin_amdgcn_mfma_f32_32x32x16_bf16(PAF(2),VFR(2),o[0],0,0,0), C1,0); \
    KRD(GL,3); GAPB(o[1]=__builtin_amdgcn_mfma_f32_32x32x16_bf16(PAF(2),VFR(6),o[1],0,0,0), C1,4); \
    GAPB(o[0]=__builtin_amdgcn_mfma_f32_32x32x16_bf16(PAF(3),VFR(3),o[0],0,0,0), C1,8); \
    GAPB(o[1]=__builtin_amdgcn_mfma_f32_32x32x16_bf16(PAF(3),VFR(7),o[1],0,0,0), C1,12); \
    }while(0)
  int t=1;
  #undef CMASK
  #define CMASK(P0,P1,t) do{}while(0)
  for(;t+5<NT;t+=2){
    STEP(pB0,pB1,pA0,pA1,t,true,true,true);     WAIT_BAR(2); RESC(); ROT();
    STEP(pA0,pA1,pB0,pB1,t+1,true,true,true);   WAIT_BAR(2); RESC(); ROT();
  }
  #undef CMASK
  #define CMASK(P0,P1,t) do{int jb_=(t)-(NT-4); if(jb_>=0)cmask(P0,P1,jb_,qrel,hi);}while(0)
  #define ENDW(tt) do{ if((tt)+3<NT){WAIT_BAR(2);} else if((tt)+2<NT){WAIT_BAR(1);} else {WAIT_BAR(0);} }while(0)
  for(;t+1<NT;t+=2){
    STEP(pB0,pB1,pA0,pA1,t,(t+3<NT),(t+1<NT),(t+1<NT));       ENDW(t);   RESC(); ROT();
    STEP(pA0,pA1,pB0,pB1,t+1,(t+4<NT),(t+2<NT),(t+2<NT));     ENDW(t+1); RESC(); ROT();
  }
  STEP(pB0,pB1,pA0,pA1,NT-1,false,false,false); RESC();
  { float sacc=pB0[0]+pB0[1]; _Pragma("unroll") for(int r=2;r<16;++r)sacc+=pB0[r]; _Pragma("unroll") for(int r=0;r<16;++r)sacc+=pB1[r]; l_reg+=sacc;
    pw0=(u32x4){PKW(pB0,0),PKW(pB0,2),PKW(pB0,4),PKW(pB0,6)};pw1=(u32x4){PKW(pB0,8),PKW(pB0,10),PKW(pB0,12),PKW(pB0,14)};pw2=(u32x4){PKW(pB1,0),PKW(pB1,2),PKW(pB1,4),PKW(pB1,6)};pw3=(u32x4){PKW(pB1,8),PKW(pB1,10),PKW(pB1,12),PKW(pB1,14)};
    SBAR(); pv(o,vb0+sl_cur,PAF(0),PAF(1),PAF(2),PAF(3)); }
  #undef PKW
  #undef PAF
  #undef VFR
  #undef PIN
  #undef MX3
  #undef GAPA
  #undef GAPB
  #undef EX
  #undef VRD
  #undef KRD
  #undef STEP
  #undef ENDW
  {auto rr=__builtin_amdgcn_permlane32_swap(__float_as_uint(l_reg),__float_as_uint(l_reg),false,false);l_reg=__uint_as_float(rr[0])+__uint_as_float(rr[1]);}
  if(hi==0)wsf[32+r32]=l_reg;asm volatile("s_waitcnt lgkmcnt(0)":::"memory");
  float rli[16];
  #pragma unroll
  for(int r=0;r<16;++r)rli[r]=__builtin_amdgcn_rcpf(wsf[32+crow(r,hi)]);
  bf16*Ow=O+(rowbase+q0+wid*QBLK)*PO;
  { bf16*stg=(bf16*)(shm+LDS_OST)+wid*2048;
    #pragma unroll
    for(int r=0;r<16;++r){const int orow=crow(r,hi);
      #pragma unroll
      for(int d0=0;d0<2;++d0)stg[orow*64+d0*32+r32]=__float2bfloat16(o[d0][r]*rli[r]);}
    asm volatile("s_waitcnt lgkmcnt(0)":::"memory");
    #pragma unroll
    for(int i=0;i<4;++i){const int row=i*8+(lane>>3),ch=lane&7; const u32x4 v=*(const u32x4*)(stg+row*64+ch*8); ATTN_STORE16(Ow+(long)row*PO+ch*8,v);} }
  asm volatile("s_waitcnt lgkmcnt(0)\n\ts_barrier":::"memory");
  #undef DMA_K
  #undef DMA_V
  #undef CMASK
  #undef START
  #undef RESC
  #undef ROT
}
constexpr int ATTN_LDS_BYTES=LDS_BYTES;
#undef SBAR
#undef WAIT_BAR
}
namespace attn_body {
#define SBAR() __builtin_amdgcn_sched_barrier(0)
#define WAIT_BAR(N) asm volatile("s_waitcnt vmcnt(" #N ") lgkmcnt(0)\n\ts_barrier":::"memory")
constexpr int VSLOTB=16384, LDS2_V=NSLOT*SLOTB, LDS2_WS=LDS2_V+NSLOT*VSLOTB, LDS2_OST=LDS2_WS+NW*64*4, LDS2_BYTES=LDS2_OST+NW*4096;
template<int THRL> __device__ __forceinline__ void attn_unit2(int b,int qb,const bf16*Q,const bf16*__restrict__ K,const bf16*__restrict__ V,bf16*O,char*shm,int tid_in){
  int tid_=tid_in; asm volatile("":"+v"(tid_));
  const int tid=tid_,lane=tid&63,r32=lane&31,hi=lane>>5; const int wid=__builtin_amdgcn_readfirstlane(tid>>6);
  const long rowbase=(long)b*SEQ; const int q0=qb*QB;
  const bf16*Qw=Q+(rowbase+q0+wid*QBLK)*PQ;
  const bf16*Kh=K+rowbase*PQ,*Vh=V+rowbase*PQ;
  const unsigned lds0=(unsigned)(uintptr_t)shm;
  float*wsf=(float*)(shm+LDS2_WS)+wid*64;
  const bf16*ksrc=Kh+(long)lane*PQ+wid*8;
  const bf16*vsrc=Vh+(long)(16*(wid&3)+(lane>>2))*PQ+(wid>>2)*32+(lane&3)*8;
  const unsigned kdst=lds0+LDS_K+wid*1024, vdst=lds0+LDS2_V+wid*1024;
  #define DMA_K(t,slot) glds16(ksrc+(long)(t)*KVBLK*PQ,(unsigned)__builtin_amdgcn_readfirstlane(kdst+(slot)))
  #define DMA_V(t,slot) do{ glds16(vsrc+(long)(t)*KVBLK*PQ,(unsigned)__builtin_amdgcn_readfirstlane(vdst+2*(slot))); glds16(vsrc+(long)(t)*KVBLK*PQ+64,(unsigned)__builtin_amdgcn_readfirstlane(vdst+2*(slot)+8192)); }while(0)
  const char*Kbase=shm+LDS_K; bf16x8 kfa[4],kfb[4];
  const lds_cptr shm3=(lds_cptr)shm; const lds_cptr kp0=shm3+LDS_K+hi*1024+r32*16; const lds_cptr vp0=shm3+LDS2_V+((lane>>4)&1)*32+(lane&3)*8+(4*hi+((lane&15)>>2))*64;
  const int NT=(q0+QB)/KVBLK;
  DMA_K(0,0);DMA_V(0,0);DMA_K(1,SLOTB);
  bf16x8 qr[4];
  #pragma unroll
  for(int d0=0;d0<4;++d0)qr[d0]=*reinterpret_cast<const bf16x8*>(&Qw[(long)r32*PQ+d0*16+hi*8]);
  float mhat=0.f,l_reg=0.f;f32x16 o[4];o[0]=f32x16{};o[1]=f32x16{};o[2]=f32x16{};o[3]=f32x16{};const f32x16 zero16=f32x16{};
  const int qrel=wid*QBLK+r32;
  #define CMASK(P0,P1,t) do{int jb_=(t)-(NT-4); if(jb_>=0)cmask(P0,P1,jb_,qrel,hi);}while(0)
  bool resc=false;
  #define RESC() do{ if(resc){ asm volatile("s_waitcnt lgkmcnt(0)":::"memory"); \
      _Pragma("unroll") for(int d_=0;d_<4;++d_) _Pragma("unroll") for(int r=0;r<16;++r)o[d_][r]*=wsf[crow(r,hi)]; } }while(0)
  f32x16 c0,c1;
  u32x4 pa0,pa1,pa2,pa3,pn0,pn1,pn2,pn3;
  int sl_prev=0,sl_cur=0,sl_next=SLOTB;
  #define ROT() do{sl_prev=sl_cur;sl_cur=sl_next;sl_next=(sl_next==(NSLOT-1)*SLOTB)?0:sl_next+SLOTB;}while(0)
  #define PKW(P,B) cvtpk_s(P[B],P[B+1])
  DMA_K(2,2*SLOTB);
  WAIT_BAR(4);
  qkt(c0,c1,Kbase,qr,zero16,r32,hi);asm volatile("s_nop 15\n\ts_nop 7":"+v"(c0),"+v"(c1));CMASK(c0,c1,0);
  { const float rm=rowmax(c0,c1); mhat=rm;
    _Pragma("unroll") for(int r=0;r<16;++r){c0[r]=__builtin_amdgcn_exp2f(c0[r]-rm);c1[r]=__builtin_amdgcn_exp2f(c1[r]-rm);}
    float sacc=c0[0]+c0[1]; _Pragma("unroll") for(int r=2;r<16;++r)sacc+=c0[r]; _Pragma("unroll") for(int r=0;r<16;++r)sacc+=c1[r]; l_reg=sacc;
    pa0=(u32x4){PKW(c0,0),PKW(c0,2),PKW(c0,4),PKW(c0,6)};pa1=(u32x4){PKW(c0,8),PKW(c0,10),PKW(c0,12),PKW(c0,14)};pa2=(u32x4){PKW(c1,0),PKW(c1,2),PKW(c1,4),PKW(c1,6)};pa3=(u32x4){PKW(c1,8),PKW(c1,10),PKW(c1,12),PKW(c1,14)}; }
  WAIT_BAR(0);
  DMA_V(1,SLOTB);
  ROT();
  kfa[0]=*(const __attribute__((address_space(3))) bf16x8*)(kp0+sl_cur);      kfa[1]=*(const __attribute__((address_space(3))) bf16x8*)(kp0+sl_cur+512);
  kfa[2]=*(const __attribute__((address_space(3))) bf16x8*)(kp0+sl_cur+2048); kfa[3]=*(const __attribute__((address_space(3))) bf16x8*)(kp0+sl_cur+2560);
  WAIT_BAR(2);
  s16x4 vlo[8],vhi[8];
  #define VFR(i) (bf16x8){vlo[i][0],vlo[i][1],vlo[i][2],vlo[i][3],vhi[i][0],vhi[i][1],vhi[i][2],vhi[i][3]}
  #define PIN(x) asm volatile("":"+v"(x))
  #define MX3(a,b,c) __builtin_fmaxf(__builtin_fmaxf((a),(b)),(c))
  #define EX(v) __builtin_amdgcn_exp2f(v)
  #define GAPA(MF) do{ MF; SBAR(); }while(0)
  #define GAPB(MF,X,B,i) do{ MF; VRD2(i); X[B]=EX(X[B]); X[B+1]=EX(X[B+1]); X[B+2]=EX(X[B+2]); X[B+3]=EX(X[B+3]); PIN(X); SBAR(); }while(0)
  #define GAPC(MF,A0,A1,A2,A3,W0,W1,PW) do{ MF; sacc+=A0; sacc+=A1; sacc+=A2; sacc+=A3; PIN(sacc); W0; W1; PIN(PW); SBAR(); }while(0)
  #define VRD(i) do{ vlo[i]=vtr(vp_+(((i)>>2)*4096+((i)&3)*1024)); vhi[i]=vtr(vp_+(((i)>>2)*4096+((i)&3)*1024+512)); }while(0)
  #define VRD2(i) do{ vlo[i]=vtr(vp_+(8192+((i)>>2)*4096+((i)&3)*1024)); vhi[i]=vtr(vp_+(8192+((i)>>2)*4096+((i)&3)*1024+512)); }while(0)
  #define KRD(G,j) do{ if(G){ kfa[2*(j)]=*(const __attribute__((address_space(3))) bf16x8*)(kp0+sl_next+(j)*2048); kfa[2*(j)+1]=*(const __attribute__((address_space(3))) bf16x8*)(kp0+sl_next+(j)*2048+512); SBAR(); } }while(0)
  #define MFMA32(a,b,c) __builtin_amdgcn_mfma_f32_32x32x16_bf16(a,b,c,0,0,0)
  #define PF(x) __builtin_bit_cast(bf16x8,x)
  #define STEP(A0,A1,A2,A3,N0,N1,N2,N3,t,GK,GV,GL) do{ SBAR(); \
    if(GK){DMA_K((t)+2,sl_prev);} \
    const lds_cptr vp_=vp0+2*sl_prev; \
    kfb[0]=*(const __attribute__((address_space(3))) bf16x8*)(kp0+sl_cur+4096); kfb[1]=*(const __attribute__((address_space(3))) bf16x8*)(kp0+sl_cur+4608); \
    kfb[2]=*(const __attribute__((address_space(3))) bf16x8*)(kp0+sl_cur+6144); kfb[3]=*(const __attribute__((address_space(3))) bf16x8*)(kp0+sl_cur+6656); SBAR(); \
    VRD(0); SBAR(); GAPA(c0=MFMA32(kfa[0],qr[0],zero16)); \
    VRD(4); SBAR(); GAPA(c1=MFMA32(kfa[1],qr[0],zero16)); \
    VRD(1); SBAR(); GAPA(c0=MFMA32(kfa[2],qr[1],c0)); \
    VRD(5); SBAR(); GAPA(c1=MFMA32(kfa[3],qr[1],c1)); \
    VRD(2); SBAR(); GAPA(c0=MFMA32(kfb[0],qr[2],c0)); \
    VRD(6); SBAR(); GAPA(c1=MFMA32(kfb[1],qr[2],c1)); \
    VRD(3); SBAR(); GAPA(c0=MFMA32(kfb[2],qr[3],c0)); \
    VRD(7); SBAR(); GAPA(c1=MFMA32(kfb[3],qr[3],c1)); \
    if(GV){DMA_V((t)+1,sl_next);} \
    _Pragma("unroll") for(int r=0;r<16;++r){c0[r]-=mhat;c1[r]-=mhat;} \
    CMASK(c0,c1,t); \
    { float a=MX3(c0[0],c0[1],c1[0]),bq=MX3(c0[2],c0[3],c1[1]); a=MX3(a,c1[2],c1[3]); \
      _Pragma("unroll") for(int r=4;r<16;r+=4){a=MX3(a,c0[r],c0[r+1]);bq=MX3(bq,c0[r+2],c0[r+3]);a=MX3(a,c1[r],c1[r+1]);bq=MX3(bq,c1[r+2],c1[r+3]);} \
      float rm=__builtin_fmaxf(a,bq); { auto rr=__builtin_amdgcn_permlane32_swap(__float_as_uint(rm),__float_as_uint(rm),false,false); rm=__builtin_fmaxf(__uint_as_float(rr[0]),__uint_as_float(rr[1])); } \
      resc=false; \
      if(__builtin_expect(__any(rm>(float)THRL),0)){ const float dl=__builtin_fmaxf(rm,0.f); mhat+=dl; \
        _Pragma("unroll") for(int r=0;r<16;++r){c0[r]-=dl;c1[r]-=dl;} \
        const float f=__builtin_amdgcn_exp2f(-dl); l_reg*=f; if(hi==0)wsf[r32]=f; resc=true; } } \
    SBAR(); \
    GAPB(o[0]=MFMA32(PF(A0),VFR(0),o[0]), c0,0, 0); \
    GAPB(o[1]=MFMA32(PF(A0),VFR(4),o[1]), c0,4, 4); \
    KRD(GL,0); GAPB(o[0]=MFMA32(PF(A1),VFR(1),o[0]), c0,8, 1); \
    KRD(GL,1); GAPB(o[1]=MFMA32(PF(A1),VFR(5),o[1]), c0,12, 5); \
    GAPB(o[0]=MFMA32(PF(A2),VFR(2),o[0]), c1,0, 2); \
    GAPB(o[1]=MFMA32(PF(A2),VFR(6),o[1]), c1,4, 6); \
    GAPB(o[0]=MFMA32(PF(A3),VFR(3),o[0]), c1,8, 3); \
    GAPB(o[1]=MFMA32(PF(A3),VFR(7),o[1]), c1,12, 7); \
    float sacc=(c0[0]+c0[1]); \
    GAPC(o[2]=MFMA32(PF(A0),VFR(0),o[2]), c0[2],c0[3],c0[4],c0[5],     N0[0]=PKW(c0,0), N0[1]=PKW(c0,2), N0); \
    GAPC(o[3]=MFMA32(PF(A0),VFR(4),o[3]), c0[6],c0[7],c0[8],c0[9],     N0[2]=PKW(c0,4), N0[3]=PKW(c0,6), N0); \
    GAPC(o[2]=MFMA32(PF(A1),VFR(1),o[2]), c0[10],c0[11],c0[12],c0[13], N1[0]=PKW(c0,8), N1[1]=PKW(c0,10), N1); \
    GAPC(o[3]=MFMA32(PF(A1),VFR(5),o[3]), c0[14],c0[15],c1[0],c1[1],   N1[2]=PKW(c0,12),N1[3]=PKW(c0,14), N1); \
    GAPC(o[2]=MFMA32(PF(A2),VFR(2),o[2]), c1[2],c1[3],c1[4],c1[5],     N2[0]=PKW(c1,0), N2[1]=PKW(c1,2), N2); \
    GAPC(o[3]=MFMA32(PF(A2),VFR(6),o[3]), c1[6],c1[7],c1[8],c1[9],     N2[2]=PKW(c1,4), N2[3]=PKW(c1,6), N2); \
    GAPC(o[2]=MFMA32(PF(A3),VFR(3),o[2]), c1[10],c1[11],c1[12],c1[13], N3[0]=PKW(c1,8), N3[1]=PKW(c1,10), N3); \
    GAPC(o[3]=MFMA32(PF(A3),VFR(7),o[3]), c1[14],c1[15],0.f,0.f,       N3[2]=PKW(c1,12),N3[3]=PKW(c1,14), N3); \
    l_reg+=sacc; \
    }while(0)
  int t=1;
  #undef CMASK
  #define CMASK(P0,P1,t) do{}while(0)
  for(;t+5<NT;t+=2){
    STEP(pa0,pa1,pa2,pa3,pn0,pn1,pn2,pn3,t,true,true,true);     WAIT_BAR(2); RESC(); ROT();
    STEP(pn0,pn1,pn2,pn3,pa0,pa1,pa2,pa3,t+1,true,true,true);   WAIT_BAR(2); RESC(); ROT();
  }
  #undef CMASK
  #define CMASK(P0,P1,t) do{int jb_=(t)-(NT-4); if(jb_>=0)cmask(P0,P1,jb_,qrel,hi);}while(0)
  #define ENDW(tt) do{ if((tt)+2<NT){WAIT_BAR(2);} else {WAIT_BAR(0);} }while(0)
  for(;t+1<NT;t+=2){
    STEP(pa0,pa1,pa2,pa3,pn0,pn1,pn2,pn3,t,(t+2<NT),(t+1<NT),(t+1<NT));       ENDW(t);   RESC(); ROT();
    STEP(pn0,pn1,pn2,pn3,pa0,pa1,pa2,pa3,t+1,(t+3<NT),(t+2<NT),(t+2<NT));     ENDW(t+1); RESC(); ROT();
  }
  STEP(pa0,pa1,pa2,pa3,pn0,pn1,pn2,pn3,NT-1,false,false,false); RESC();
  { SBAR(); int ln2_=tid_in&63; asm volatile("":"+v"(ln2_));
    const int vb0=(int)(lds0+LDS2_V)+((ln2_>>4)&1)*32+(ln2_&3)*8+(4*(ln2_>>5)+((ln2_&15)>>2))*64;
    pv(o,vb0+2*sl_cur,PF(pn0),PF(pn1),PF(pn2),PF(pn3)); pv(o+2,vb0+2*sl_cur+8192,PF(pn0),PF(pn1),PF(pn2),PF(pn3)); }
  #undef PKW
  #undef PF
  #undef MFMA32
  #undef VFR
  #undef PIN
  #undef MX3
  #undef GAPA
  #undef GAPB
  #undef GAPC
  #undef EX
  #undef VRD
  #undef VRD2
  #undef KRD
  #undef STEP
  #undef ENDW
  {auto rr=__builtin_amdgcn_permlane32_swap(__float_as_uint(l_reg),__float_as_uint(l_reg),false,false);l_reg=__uint_as_float(rr[0])+__uint_as_float(rr[1]);}
  int ln3_=tid_in&63; asm volatile("":"+v"(ln3_)); const int e_r32=ln3_&31,e_hi=ln3_>>5;
  float*wsf2=(float*)(shm+LDS2_WS)+wid*64;
  if(e_hi==0)wsf2[32+e_r32]=l_reg;asm volatile("s_waitcnt lgkmcnt(0)":::"memory");
  float rli[16];
  #pragma unroll
  for(int r=0;r<16;++r)rli[r]=__builtin_amdgcn_rcpf(wsf2[32+crow(r,e_hi)]);
  bf16*Ow=O+((long)b*SEQ+qb*QB+wid*QBLK)*PO;
  { bf16*stg=(bf16*)(shm+LDS2_OST)+wid*2048;
    #pragma unroll
    for(int ps=0;ps<2;++ps){
      #pragma unroll
      for(int r=0;r<16;++r){const int orow=crow(r,e_hi);
        #pragma unroll
        for(int d0=0;d0<2;++d0)stg[orow*64+d0*32+e_r32]=__float2bfloat16(o[2*ps+d0][r]*rli[r]);}
      asm volatile("s_waitcnt lgkmcnt(0)":::"memory");
      #pragma unroll
      for(int i=0;i<4;++i){const int row=i*8+(ln3_>>3),ch=ln3_&7; const u32x4 v=*(const u32x4*)(stg+row*64+ch*8); ATTN_STORE16(Ow+(long)row*PO+ps*64+ch*8,v);}
      asm volatile("s_waitcnt lgkmcnt(0)":::"memory"); } }
  asm volatile("s_waitcnt lgkmcnt(0)\n\ts_barrier":::"memory");
  #undef DMA_K
  #undef DMA_V
  #undef CMASK
  #undef RESC
  #undef ROT
}
#undef SBAR
#undef WAIT_BAR
}
#ifndef MK_MULTI
#define MK_MULTI 0
#endif
constexpr int NB = 8, SEQ = 2048, T = NB * SEQ, DM = 2048, INW = 4608, DEPTH = 2;
constexpr int CONV_CH = 512, CONV_W = 31;
constexpr int NEXP = 64, FF = 512;
constexpr int C_QS = 1024, C_KS = 1792, C_VS = 2048, C_QD = 2304, C_KD = 3072, C_VD = 3840;
constexpr int MAXTILES = 192, PROWS = MAXTILES * 256;
constexpr int NPHASE = 1 + 10 * DEPTH;
constexpr int CONV_TAIL = 128 * 12, CONV_OUT = 256 * 5;
constexpr float LOG2E = 1.4426950408889634f;
constexpr float QSCALE = 0.125f * LOG2E;
constexpr float RMS_EPS = 1e-6f, LN_EPS = 1e-5f;
constexpr float SA1 = 8.f, SW1 = 64.f, SA2 = 8.f, SW2 = 32.f, SY = 16.f;

constexpr size_t MiB = 1u << 20;
constexpr size_t WS_CTL = 0, CTL_ZERO_BYTES = 1 * MiB;
constexpr size_t WS_ROPEC = 2 * MiB, WS_ROPES = 4 * MiB;
constexpr size_t WS_RW = 6 * MiB;
constexpr size_t WS_WIN = 8 * MiB;
constexpr size_t WS_WOUT = 44 * MiB;
constexpr size_t WS_PW = 60 * MiB;
constexpr size_t WS_W13 = 64 * MiB;
constexpr size_t WS_W2 = 576 * MiB;
constexpr size_t WS_XN = 832 * MiB;
constexpr size_t WS_PROJ = 896 * MiB;
constexpr size_t WS_ZC = 1040 * MiB;
constexpr size_t WS_YCONV = 1056 * MiB;
constexpr size_t WS_YSWA = 1072 * MiB;
constexpr size_t WS_ODIFF = 1096 * MiB;
constexpr size_t WS_MIX = 1144 * MiB;
constexpr size_t WS_X = 1208 * MiB;
constexpr size_t WS_Z = 1336 * MiB;
constexpr size_t WS_ROWSS = 1368 * MiB;
constexpr size_t WS_ACT = 1528 * MiB;
constexpr size_t WS_YS = 1576 * MiB;
constexpr size_t WS_ROUTE = 1704 * MiB;
constexpr size_t RT_TOKE = 0, RT_TOKP = 128 * 1024, RT_GATE = 256 * 1024, RT_SLOT = 384 * 1024, RT_HIST = 640 * 1024;
constexpr size_t WS_END = 1706 * MiB;
constexpr int CW_ZC = 16384;
constexpr int CW_BAR = 4096;

constexpr int RING_OFF = 0, RING_BYTES = 131072;
constexpr int LCTL_OFF = RING_BYTES;
constexpr int TAB_OFF = LCTL_OFF + 512;
constexpr int TAB_PART = TAB_OFF + 2048;
constexpr int GOFS_OFF = TAB_PART + 4096;
constexpr int LDS_BYTES = 147456;
static_assert(GOFS_OFF + 3072 <= LDS_BYTES, "LDS map");

#define GAS __attribute__((address_space(1)))
#define LAS __attribute__((address_space(3)))
typedef unsigned short bf16;
typedef unsigned v4u __attribute__((ext_vector_type(4)));
typedef unsigned v2u __attribute__((ext_vector_type(2)));
typedef float f32x4 __attribute__((ext_vector_type(4)));
typedef short bf16x8 __attribute__((ext_vector_type(8)));
#define LDS_WAIT() asm volatile("s_waitcnt lgkmcnt(0)" ::: "memory")
#define VM_WAIT() asm volatile("s_waitcnt vmcnt(0)" ::: "memory")
typedef float f32x2_m __attribute__((ext_vector_type(2))); typedef __bf16 bf16x2_m __attribute__((ext_vector_type(2)));
__device__ __forceinline__ unsigned pk2(float lo, float hi) { f32x2_m v = {lo, hi}; bf16x2_m b = __builtin_convertvector(v, bf16x2_m); return __builtin_bit_cast(unsigned, b); }
__device__ __forceinline__ float bflo(unsigned w) { return __uint_as_float(w << 16); }
__device__ __forceinline__ float bfhi(unsigned w) { return __uint_as_float(w & 0xffff0000u); }
__device__ __forceinline__ float wave_sum(float v) {
#pragma unroll
    for (int o = 1; o < 64; o <<= 1) v += __shfl_xor(v, o);
    return v;
}
__device__ __forceinline__ float sigmoid_f(float x) { return __builtin_amdgcn_rcpf(1.0f + __builtin_amdgcn_exp2f(-LOG2E * x)); }

#define XB_TMO      128
#define XB_XCNT(j)  (256  + 64 * (j))
#define XB_XSUB(j)  (1280 + 64 * (j))
#define XB_XGEN(j)  (2304 + 64 * (j))
#define XB_TOP      3328
#define XB_TOPGEN   3392
#define XCD_BAR_WORDS 3456
#define XB_SPIN_CAP (1u << 18)

__device__ __forceinline__ unsigned xb_ld(unsigned* p)              { return __hip_atomic_load(p, __ATOMIC_RELAXED, __HIP_MEMORY_SCOPE_AGENT); }
__device__ __forceinline__ unsigned xb_add(unsigned* p, unsigned v) { return __hip_atomic_fetch_add(p, v, __ATOMIC_RELAXED, __HIP_MEMORY_SCOPE_AGENT); }
__device__ __forceinline__ unsigned xb_xcc_id() { return (unsigned)__builtin_amdgcn_s_getreg((3 << 11) | 20) & 0xFu; }
#define XB_SPIN(cond, bar) do { unsigned _sp = 0; while (cond) { __builtin_amdgcn_s_sleep(1); \
    if ((++_sp & 255u) == 0u) { if (xb_ld(&(bar)[XB_TMO])) break; if (_sp > XB_SPIN_CAP) { atomicAdd(&(bar)[XB_TMO], 1u); break; } } } } while (0)

struct XcdBarrier {
    unsigned* bar; unsigned x;
    volatile LAS unsigned* st;
};

__device__ __forceinline__ XcdBarrier xcd_barrier_post(unsigned* bar, volatile LAS unsigned* st) {
    XcdBarrier b; b.bar = bar; b.x = xb_xcc_id(); b.st = st;
    if (threadIdx.x == 0) (void)xb_add(&bar[XB_XCNT(b.x)], 1u);
    return b;
}
__device__ __forceinline__ void xcd_barrier_complete(unsigned* bar, unsigned x, unsigned& nloc, unsigned& nx) {
    const unsigned G = gridDim.x * gridDim.y * gridDim.z;
    unsigned sum, cnt, mine, sp = 0u;
    for (;;) {
        sum = 0u; cnt = 0u; mine = 0u;
#pragma unroll
        for (unsigned j = 0; j < 16; ++j) { const unsigned c = xb_ld(&bar[XB_XCNT(j)]); sum += c; cnt += (c > 0u) ? 1u : 0u; mine = (j == x) ? c : mine; }
        if (sum == G) break;
        __builtin_amdgcn_s_sleep(1);
        if ((++sp & 255u) == 0u) { if (xb_ld(&bar[XB_TMO])) break; if (sp > XB_SPIN_CAP) { atomicAdd(&bar[XB_TMO], 1u); break; } }
    }
    nloc = mine > 0u ? mine : 1u; nx = cnt > 0u ? cnt : 1u;
}

__device__ __forceinline__ void xcd_barrier(const XcdBarrier& b) {
    asm volatile("s_waitcnt vmcnt(0)" ::: "memory");
    __syncthreads();
    if (threadIdx.x == 0) {
        unsigned* bar = b.bar;
        __builtin_amdgcn_s_waitcnt(0);
        unsigned nloc = b.st[0], nx = b.st[1];
        if (nloc == 0u) { xcd_barrier_complete(bar, b.x, nloc, nx); b.st[0] = nloc; b.st[1] = nx; }
        const unsigned old = xb_add(&bar[XB_XSUB(b.x)], 1u);
        const unsigned gen = old / nloc;
        if (old + 1u == (gen + 1u) * nloc) {
            __builtin_amdgcn_fence(__ATOMIC_RELEASE, "agent");
            asm volatile("s_waitcnt vmcnt(0)" ::: "memory");
            const unsigned og = xb_add(&bar[XB_TOP], 1u);
            const unsigned tg = og / nx;
            if (og + 1u == (tg + 1u) * nx) xb_add(&bar[XB_TOPGEN], 1u);
            else XB_SPIN(xb_ld(&bar[XB_TOPGEN]) == tg, bar);
            __builtin_amdgcn_fence(__ATOMIC_ACQUIRE, "agent");
            xb_add(&bar[XB_XGEN(b.x)], 1u);
            asm volatile("s_waitcnt vmcnt(0)" ::: "memory");
        } else {
            XB_SPIN(xb_ld(&bar[XB_XGEN(b.x)]) == gen, bar);
            __builtin_amdgcn_fence(__ATOMIC_ACQUIRE, "agent");
            asm volatile("s_waitcnt vmcnt(0)" ::: "memory");
        }
    }
    __syncthreads();
}
constexpr int GRID = 256;
struct Ctx { LAS unsigned char* lds; int tid, lane, wave, blk, vcu, gw, gtid; static constexpr int G = GRID, NGW = GRID * 8, NT = GRID * 512; };

__device__ __forceinline__ int win_drow(int col) {
    if (col < 1024) { const int half = col >> 9, r = col & 511; return 256 * (r >> 7) + 128 * half + (r & 127); }
    if ((col >= C_VS && col < C_QD) || col >= C_VD) return col;
    const int d = col & 63; return (col & ~63) + 8 * ((d & 31) >> 2) + 4 * (d >> 5) + (d & 3);
}
__device__ __forceinline__ void sincos_d(double a, float& sn, float& cs) {
    const double q = __builtin_rint(a * 0.63661977236758134308);
    double r = __builtin_fma(-q, 1.57079632679489655800e+00, a); r = __builtin_fma(-q, 6.12323399573676603587e-17, r);
    const double r2 = r * r;
    double s = -7.6471637318198164759e-13; s = s * r2 + 1.6059043836821614599e-10; s = s * r2 - 2.5052108385441718775e-08; s = s * r2 + 2.7557319223985890653e-06; s = s * r2 - 1.9841269841269841270e-04;
    s = s * r2 + 8.3333333333333333333e-03; s = s * r2 - 1.6666666666666666667e-01; s = r + r * r2 * s;
    double c = 4.7794773323873852974e-14; c = c * r2 - 1.1470745597729724714e-11; c = c * r2 + 2.0876756987868098979e-09; c = c * r2 - 2.7557319223985890653e-07; c = c * r2 + 2.4801587301587301587e-05;
    c = c * r2 - 1.3888888888888888889e-03; c = c * r2 + 4.1666666666666666667e-02; c = c * r2 - 0.5; c = 1.0 + r2 * c;
    const int qi = (int)((long long)q & 3);
    const double ss = (qi & 1) ? c : s, cc = (qi & 1) ? s : c;
    sn = (float)((qi & 2) ? -ss : ss); cs = (float)(((qi + 1) & 2) ? -cc : cc);
}
__device__ __forceinline__ unsigned pk4_fp8m(float a, float b, float c, float d) {
    a = __builtin_fminf(__builtin_fmaxf(a, -448.f), 448.f); b = __builtin_fminf(__builtin_fmaxf(b, -448.f), 448.f); c = __builtin_fminf(__builtin_fmaxf(c, -448.f), 448.f); d = __builtin_fminf(__builtin_fmaxf(d, -448.f), 448.f);
    int w = 0; w = __builtin_amdgcn_cvt_pk_fp8_f32(a, b, w, false); w = __builtin_amdgcn_cvt_pk_fp8_f32(c, d, w, true); return (unsigned)w; }
struct P0In { const float *w_in, *w_out, *pw, *w13, *w2, *wg, *we, *ffn_g; const int* pos; };
struct P0Item { const float* src; unsigned char* dst; int N, Kb, n0, drow0, kind; float scale; };
__device__ __forceinline__ P0Item p0_decode(int it, const P0In& I, unsigned char* ws) {
    constexpr int IT_WIN = 32 * 144, IT_WOUT = 32 * 64, IT_PW = 8 * 16, IT_LAYER = IT_WIN + IT_WOUT + IT_PW;
    P0Item t; const int l = it / IT_LAYER; int r = it - l * IT_LAYER; t.scale = 1.0f;
    if (r < IT_WIN) { const int kb = r / 144, nb = r - kb * 144; t.src = I.w_in + (size_t)l * DM * INW + (size_t)(64 * kb) * INW + 32 * nb; t.N = INW; t.dst = ws + WS_WIN + ((size_t)l * INW * DM + 64 * kb) * 2; t.Kb = DM * 2; t.n0 = 32 * nb; t.drow0 = 0; t.kind = 1; return t; }
    r -= IT_WIN;
    if (r < IT_WOUT) { const int kb = r / 64, nb = r & 63; t.src = I.w_out + (size_t)l * DM * DM + (size_t)(64 * kb) * DM + 32 * nb; t.N = DM; t.dst = ws + WS_WOUT + ((size_t)l * DM * DM + 64 * kb) * 2; t.Kb = DM * 2; t.n0 = 32 * nb; t.drow0 = 32 * nb; t.kind = 0; return t; }
    r -= IT_WOUT;
    { const int kb = r / 16, nb = r & 15; t.src = I.pw + (size_t)l * 512 * 512 + (size_t)(64 * kb) * 512 + 32 * nb; t.N = 512; t.dst = ws + WS_PW + ((size_t)l * 512 * 512 + 64 * kb) * 2; t.Kb = 512 * 2; t.n0 = 32 * nb; t.drow0 = 32 * nb; t.kind = 0; return t; }
}
__device__ __forceinline__ void p0_load(const P0Item& t, float (&v)[32], int lane) {
    const float* p = t.src + (size_t)(lane >> 5) * t.N + (lane & 31);
#pragma unroll
    for (int i = 0; i < 32; ++i) v[i] = p[(size_t)(2 * i) * t.N];
}
__device__ __forceinline__ void p0_store(const P0Item& t, const float (&v)[32], LAS float* scr, int lane) {
#pragma unroll
    for (int i = 0; i < 32; ++i) scr[(2 * i + (lane >> 5)) * 33 + (lane & 31)] = v[i] * t.scale;
    LDS_WAIT(); asm volatile("" ::: "memory");
    const int c = lane & 7;
#pragma unroll
    for (int j = 0; j < 4; ++j) { const int n = (lane >> 3) + 8 * j; const LAS float* s = scr + (8 * c) * 33 + n;
        const int row = (t.kind == 1) ? win_drow(t.n0 + n) : t.drow0 + n;
        if (t.kind == 2) { v2u o; o.x = pk4_fp8m(s[0 * 33], s[1 * 33], s[2 * 33], s[3 * 33]); o.y = pk4_fp8m(s[4 * 33], s[5 * 33], s[6 * 33], s[7 * 33]); *(GAS v2u*)(t.dst + (size_t)row * t.Kb + 8 * c) = o; }
        else { v4u o; o.x = pk2(s[0 * 33], s[1 * 33]); o.y = pk2(s[2 * 33], s[3 * 33]); o.z = pk2(s[4 * 33], s[5 * 33]); o.w = pk2(s[6 * 33], s[7 * 33]); *(GAS v4u*)(t.dst + (size_t)row * t.Kb + 16 * c) = o; } }
    LDS_WAIT(); asm volatile("" ::: "memory");
}
struct P0Moe { const float* src; unsigned char* dst; int N, Kb, skip; float scale; };
constexpr int MOE_ITEMS_L = NEXP * 64 + NEXP * 32;
__device__ __forceinline__ P0Moe p0_moe_decode(int it, const P0In& I, unsigned char* ws) {
    P0Moe t; const int l = it / MOE_ITEMS_L; int r = it - l * MOE_ITEMS_L;
    if (r < NEXP * 64) { const int e = r >> 6, q = r & 63, kb = q >> 2, nb = q & 3, drow0 = 512 * (nb & 1) + 128 * (nb >> 1);
        t.src = I.w13 + (size_t)(l * NEXP + e) * DM * 1024 + (size_t)(128 * kb) * 1024 + 256 * nb; t.N = 1024; t.dst = ws + WS_W13 + (size_t)(l * NEXP + e) * 1024 * DM + (size_t)drow0 * DM + 128 * kb; t.Kb = DM; t.skip = 128; t.scale = SW1; return t; }
    r -= NEXP * 64;
    { const int e = r >> 5, q = r & 31, kb = q >> 3, nb = q & 7;
        t.src = I.w2 + (size_t)(l * NEXP + e) * FF * DM + (size_t)(128 * kb) * DM + 256 * nb; t.N = DM; t.dst = ws + WS_W2 + (size_t)(l * NEXP + e) * DM * FF + (size_t)(256 * nb) * FF + 128 * kb; t.Kb = FF; t.skip = 0; t.scale = SW2; return t; }
}
__device__ __forceinline__ void p0_moe_load(const P0Moe& t, f32x4 (&v)[16], int wave, int lane) {
    const float* p = t.src + (size_t)(16 * wave) * t.N + 4 * lane;
#pragma unroll
    for (int r = 0; r < 16; ++r) v[r] = *(const GAS f32x4*)(p + (size_t)r * t.N);
}
__device__ __forceinline__ void p0_moe_store(const P0Moe& t, const f32x4 (&v)[16], LAS unsigned* ob, int tid, int wave, int lane) {
#pragma unroll
    for (int g = 0; g < 4; ++g) { LAS unsigned* o = ob + (4 * lane) * 33 + 4 * wave + g;
        o[0] = pk4_fp8m(v[4 * g].x * t.scale, v[4 * g + 1].x * t.scale, v[4 * g + 2].x * t.scale, v[4 * g + 3].x * t.scale);
        o[33] = pk4_fp8m(v[4 * g].y * t.scale, v[4 * g + 1].y * t.scale, v[4 * g + 2].y * t.scale, v[4 * g + 3].y * t.scale);
        o[66] = pk4_fp8m(v[4 * g].z * t.scale, v[4 * g + 1].z * t.scale, v[4 * g + 2].z * t.scale, v[4 * g + 3].z * t.scale);
        o[99] = pk4_fp8m(v[4 * g].w * t.scale, v[4 * g + 1].w * t.scale, v[4 * g + 2].w * t.scale, v[4 * g + 3].w * t.scale); }
    __syncthreads();
    { const int row = tid >> 1, part = tid & 1; const LAS unsigned* sp = ob + row * 33 + 16 * part;
      v4u o0, o1, o2, o3; o0.x = sp[0]; o0.y = sp[1]; o0.z = sp[2]; o0.w = sp[3]; o1.x = sp[4]; o1.y = sp[5]; o1.z = sp[6]; o1.w = sp[7];
      o2.x = sp[8]; o2.y = sp[9]; o2.z = sp[10]; o2.w = sp[11]; o3.x = sp[12]; o3.y = sp[13]; o3.z = sp[14]; o3.w = sp[15];
      GAS v4u* d = (GAS v4u*)(t.dst + (size_t)(row + (row >= 128 ? t.skip : 0)) * t.Kb + 64 * part); d[0] = o0; d[1] = o1; d[2] = o2; d[3] = o3; }
    __syncthreads();
}
__device__ __forceinline__ void moe_convert(const Ctx& C, const P0In& I, unsigned char* ws, int lo, int hi, int idx, int stride) {
    LAS unsigned* ob = (LAS unsigned*)(C.lds + RING_OFF);
    __syncthreads();
    f32x4 va[16], vb[16]; int it = lo + idx;
#define MC_DEC(i) p0_moe_decode((i) < hi ? (i) : hi - 1, I, ws)
    P0Moe ta = MC_DEC(it), tb = ta;
    p0_moe_load(ta, va, C.wave, C.lane);
#pragma unroll 1
    while (it < hi) {
        tb = MC_DEC(it + stride); p0_moe_load(tb, vb, C.wave, C.lane); p0_moe_store(ta, va, ob, C.tid, C.wave, C.lane);
        if (it + stride >= hi) break;
        ta = MC_DEC(it + 2 * stride); p0_moe_load(ta, va, C.wave, C.lane); p0_moe_store(tb, vb, ob, C.tid, C.wave, C.lane);
        it += 2 * stride; }
#undef MC_DEC
    asm volatile("s_waitcnt vmcnt(0)" ::: "memory");
    __syncthreads();
}
constexpr int WCONV_L = 32 * 144 + 32 * 64 + 8 * 16;
__device__ __forceinline__ void wconv_bf16(const Ctx& C, const P0In& I, unsigned char* ws, int lo, int hi) {
    LAS float* scr = (LAS float*)(C.lds + RING_OFF + C.wave * 16384);
    __syncthreads();
    { float va[32], vb[32]; int it = lo + C.gw; P0Item ta = p0_decode(it < hi ? it : hi - 1, I, ws), tb = ta;
      p0_load(ta, va, C.lane);
#pragma unroll 1
      while (it < hi) {
          const int it1 = it + C.NGW, it2 = it1 + C.NGW;
          tb = p0_decode(it1 < hi ? it1 : hi - 1, I, ws); p0_load(tb, vb, C.lane);
          p0_store(ta, va, scr, C.lane);
          if (it1 >= hi) break;
          ta = p0_decode(it2 < hi ? it2 : hi - 1, I, ws); p0_load(ta, va, C.lane);
          p0_store(tb, vb, scr, C.lane);
          it = it2; } }
    asm volatile("s_waitcnt vmcnt(0)" ::: "memory");
    __syncthreads();
}
__device__ __forceinline__ void p0_prologue(const Ctx& C, const P0In& I, unsigned char* ws) {
    wconv_bf16(C, I, ws, 0, WCONV_L);
    for (int idx = C.gtid; idx < DEPTH * 80 * DM; idx += C.NT) {
        const int l = idx / (80 * DM), rem = idx - l * 80 * DM, k = rem / 80, o = rem - k * 80;
        float v = 0.f;
        if (o < 8) v = I.wg[((size_t)l * DM + k) * 8 + o]; else if (o < 72) v = I.we[((size_t)l * DM + k) * 64 + (o - 8)];
        v *= I.ffn_g[l * DM + k];
        const unsigned h = pk2(v, 0.f) & 0xffffu; const float hf = __uint_as_float(h << 16); const unsigned lo = pk2(v - hf, 0.f) & 0xffffu;
        bf16* rw = (bf16*)(ws + WS_RW) + (size_t)l * 2 * 80 * DM;
        rw[(size_t)o * DM + k] = (bf16)h; rw[(size_t)(80 + o) * DM + k] = (bf16)lo;
    }
    for (int idx = C.gtid; idx < T * 32; idx += C.NT) {
        const int tok = idx >> 5, i = idx & 31;
        const float inv = (float)exp2(-(double)i * (13.287712379549449 / 32.0));
        const float ang = (float)I.pos[tok] * inv;
        float sn, cs; sincos_d((double)ang, sn, cs);
        ((float*)(ws + WS_ROPEC))[idx] = cs; ((float*)(ws + WS_ROPES))[idx] = sn;
    }
}

template <int MODE>
__device__ __forceinline__ void norm_rows(const Ctx& C, const void* src, bf16* xdst, const unsigned char* YS8, const float* gate, const float* gain, bf16* XN, float* outf) {
    for (int m = C.gw; m < T; m += C.NGW) {
        f32x4 v[8];
        if (MODE == 0) { const GAS f32x4* xr = (const GAS f32x4*)((const float*)src + (size_t)m * DM) + C.lane;
#pragma unroll
            for (int j = 0; j < 8; ++j) v[j] = xr[64 * j]; }
        else { const GAS v2u* xr = (const GAS v2u*)((const bf16*)src + (size_t)m * DM) + C.lane;
#pragma unroll
            for (int j = 0; j < 8; ++j) { const v2u q = xr[64 * j]; v[j] = (f32x4){bflo(q.x), bfhi(q.x), bflo(q.y), bfhi(q.y)}; } }
        if (MODE >= 1) {
            const float g0 = gate[2 * m], g1 = gate[2 * m + 1];
            const GAS unsigned* y0 = (const GAS unsigned*)(YS8 + (size_t)(2 * m) * DM) + C.lane; const GAS unsigned* y1 = (const GAS unsigned*)(YS8 + (size_t)(2 * m + 1) * DM) + C.lane;
            const float h0 = g0 * (1.0f / SY), h1 = g1 * (1.0f / SY);
#pragma unroll
            for (int j = 0; j < 8; ++j) { const unsigned a = y0[64 * j], b = y1[64 * j];
                const f32x2_m a01 = __builtin_amdgcn_cvt_pk_f32_fp8((int)a, false), a23 = __builtin_amdgcn_cvt_pk_f32_fp8((int)a, true), b01 = __builtin_amdgcn_cvt_pk_f32_fp8((int)b, false), b23 = __builtin_amdgcn_cvt_pk_f32_fp8((int)b, true);
                v[j].x += h0 * a01.x + h1 * b01.x; v[j].y += h0 * a01.y + h1 * b01.y; v[j].z += h0 * a23.x + h1 * b23.x; v[j].w += h0 * a23.y + h1 * b23.y; }
        }
        float ss = 0.f;
#pragma unroll
        for (int j = 0; j < 8; ++j) ss += (v[j].x * v[j].x + v[j].y * v[j].y) + (v[j].z * v[j].z + v[j].w * v[j].w);
        const float rstd = 1.0f / sqrtf(wave_sum(ss) * (1.0f / DM) + RMS_EPS);
        if (MODE == 1) { GAS v2u* xo = (GAS v2u*)(xdst + (size_t)m * DM) + C.lane;
#pragma unroll
            for (int j = 0; j < 8; ++j) { v2u w; w.x = pk2(v[j].x, v[j].y); w.y = pk2(v[j].z, v[j].w); xo[64 * j] = w; } }
        const GAS f32x4* gg = (const GAS f32x4*)gain + C.lane;
        if (MODE <= 1) { GAS v2u* o = (GAS v2u*)(XN + (size_t)m * DM) + C.lane;
#pragma unroll
            for (int j = 0; j < 8; ++j) { const f32x4 g = gg[64 * j]; v2u w; w.x = pk2(v[j].x * rstd * g.x, v[j].y * rstd * g.y); w.y = pk2(v[j].z * rstd * g.z, v[j].w * rstd * g.w); o[64 * j] = w; } }
        else { GAS f32x4* o = (GAS f32x4*)(outf + (size_t)m * DM) + C.lane;
#pragma unroll
            for (int j = 0; j < 8; ++j) { const f32x4 g = gg[64 * j]; o[64 * j] = v[j] * rstd * g; } }
    }
}

__device__ __forceinline__ void convpre_phase(const Ctx& C, const bf16* Z, const float* dw_w, const float* dw_b, const float* ln_g, const float* ln_b, bf16* ZC) {
    const __amdgpu_buffer_rsrc_t zrs = __builtin_amdgcn_make_buffer_rsrc((void*)ZC, (short)0, T * CONV_CH * 2, 0x00020000);
    LAS float* wl = (LAS float*)(C.lds + RING_OFF);
    LAS bf16* zs = (LAS bf16*)(C.lds + RING_OFF + 63488);
    __syncthreads();
    for (int i = C.tid; i < CONV_W * CONV_CH; i += 512) wl[i] = dw_w[i];
    const int c0 = 8 * C.lane;
    float bias[8], lg[8], lb[8];
#pragma unroll
    for (int i = 0; i < 8; ++i) { bias[i] = dw_b[c0 + i]; lg[i] = ln_g[c0 + i]; lb[i] = ln_b[c0 + i]; }
    for (int item = C.blk; item < T / 32; item += C.G) {
        const int t0 = item * 32, s0 = t0 & (SEQ - 1);
        __syncthreads();
#pragma unroll
        for (int i = 0; i < 8; ++i) { const int task = C.tid + 512 * i, rr = task >> 6, ch = task & 63;
            if (rr < 62) { v4u z = {0u, 0u, 0u, 0u};
                if (s0 - 30 + rr >= 0) z = *(const GAS v4u*)(Z + (size_t)(t0 - 30 + rr) * CONV_CH + 8 * ch);
                *(LAS v4u*)(zs + rr * 512 + 8 * ch) = z; } }
        __syncthreads();
        {
            const int tt = 4 * C.wave;
            float acc[4][8];
#pragma unroll
            for (int q = 0; q < 4; ++q)
#pragma unroll
                for (int i = 0; i < 8; ++i) acc[q][i] = bias[i];
#pragma unroll 2
            for (int j = 0; j < CONV_W; ++j) { const f32x4 w0 = *(const LAS f32x4*)(wl + j * 512 + c0), w1 = *(const LAS f32x4*)(wl + j * 512 + c0 + 4);
#pragma unroll
                for (int q = 0; q < 4; ++q) { const v4u z = *(const LAS v4u*)(zs + (tt + q + j) * 512 + c0);
                    acc[q][0] += w0.x * bflo(z.x); acc[q][1] += w0.y * bfhi(z.x); acc[q][2] += w0.z * bflo(z.y); acc[q][3] += w0.w * bfhi(z.y);
                    acc[q][4] += w1.x * bflo(z.z); acc[q][5] += w1.y * bfhi(z.z); acc[q][6] += w1.z * bflo(z.w); acc[q][7] += w1.w * bfhi(z.w); } }
#pragma unroll
            for (int q = 0; q < 4; ++q) {
                float s = 0.f;
#pragma unroll
                for (int i = 0; i < 8; ++i) s += acc[q][i];
                const float mean = wave_sum(s) * (1.0f / CONV_CH); float s2 = 0.f;
#pragma unroll
                for (int i = 0; i < 8; ++i) { acc[q][i] -= mean; s2 += acc[q][i] * acc[q][i]; }
                const float rstd = 1.0f / sqrtf(wave_sum(s2) * (1.0f / CONV_CH) + LN_EPS);
                float y[8];
#pragma unroll
                for (int i = 0; i < 8; ++i) { const float u = acc[q][i] * rstd * lg[i] + lb[i]; y[i] = u * sigmoid_f(u); }
                v4u o; o.x = pk2(y[0], y[1]); o.y = pk2(y[2], y[3]); o.z = pk2(y[4], y[5]); o.w = pk2(y[6], y[7]);
                __builtin_amdgcn_raw_buffer_store_b128(o, zrs, (int)(((size_t)(t0 + tt + q) * CONV_CH + c0) * 2), 0, 16); }
        }
    }
    __syncthreads();
}

#define MFMA16(a, b, c) __builtin_amdgcn_mfma_f32_16x16x32_bf16(a, b, c, 0, 0, 0)
__device__ __forceinline__ void swa_phase(const Ctx& C, const bf16* PROJ, const float* sinks, bf16* YSWA) {
    LAS bf16* vt = (LAS bf16*)(C.lds + RING_OFF);
    const int c16 = C.lane & 15, g4 = C.lane >> 4, w = C.wave;
    for (int u = C.vcu; u < 512; u += C.G) {
        const int n = u & 15, hk = (u >> 4) & 3, b = u >> 6, tb = b * SEQ + 128 * n;
        __syncthreads();
#pragma unroll
        for (int i = 0; i < 2; ++i) { const int task = C.tid + 512 * i, kk = 2 * (task >> 3), c8 = task & 7;
            v4u va = {0u, 0u, 0u, 0u}, vb = {0u, 0u, 0u, 0u};
            if (n > 0 || kk >= 128) { const bf16* vp = PROJ + (size_t)(tb - 128 + kk) * INW + C_VS + 64 * hk + 8 * c8; va = *(const GAS v4u*)vp; vb = *(const GAS v4u*)(vp + INW); }
            LAS unsigned* dst = (LAS unsigned*)(vt + (8 * c8) * 264 + kk);
            dst[0] = (va.x & 0xffffu) | (vb.x << 16); dst[132] = (va.x >> 16) | (vb.x & 0xffff0000u); dst[2 * 132] = (va.y & 0xffffu) | (vb.y << 16); dst[3 * 132] = (va.y >> 16) | (vb.y & 0xffff0000u);
            dst[4 * 132] = (va.z & 0xffffu) | (vb.z << 16); dst[5 * 132] = (va.z >> 16) | (vb.z & 0xffff0000u); dst[6 * 132] = (va.w & 0xffffu) | (vb.w << 16); dst[7 * 132] = (va.w >> 16) | (vb.w & 0xffff0000u); }
        bf16x8 kf[9][2], qf[3][2];
        { const int q0_ = tb + 16 * w;
#pragma unroll
          for (int j = 0; j < 9; ++j) { const int krow = 16 * w - 128 + 16 * j + c16; int ktok = tb + krow; if (128 * n + krow < 0) ktok = b * SEQ;
              const bf16* kp = PROJ + (size_t)ktok * INW + C_KS + 64 * hk + 8 * g4; kf[j][0] = *(const GAS bf16x8*)kp; kf[j][1] = *(const GAS bf16x8*)(kp + 32); }
#pragma unroll
          for (int g = 0; g < 3; ++g) { const bf16* qp = PROJ + (size_t)(q0_ + c16) * INW + C_QS + 64 * (3 * hk + g) + 8 * g4; qf[g][0] = *(const GAS bf16x8*)qp; qf[g][1] = *(const GAS bf16x8*)(qp + 32); } }
        __syncthreads();
#pragma unroll
        for (int g = 0; g < 3; ++g) {
            const int h = 3 * hk + g; const float sink2 = sinks[h] * LOG2E;
            const int q0 = tb + 16 * w;
            f32x4 s[9];
#pragma unroll
            for (int j = 0; j < 9; ++j) { f32x4 a = {0.f, 0.f, 0.f, 0.f}; a = MFMA16(kf[j][0], qf[g][0], a); a = MFMA16(kf[j][1], qf[g][1], a); s[j] = a; }
            const int qr = 16 * w + c16; float mx = -INFINITY;
#pragma unroll
            for (int j = 0; j < 9; ++j)
#pragma unroll
                for (int r = 0; r < 4; ++r) { const int kr = 16 * w - 128 + 16 * j + 4 * g4 + r, diff = qr - kr; const bool ok = diff >= 0 && diff < 128 && (128 * n + kr) >= 0;
                    s[j][r] = ok ? s[j][r] : -INFINITY; mx = fmaxf(mx, s[j][r]); }
            mx = fmaxf(mx, __shfl_xor(mx, 16)); mx = fmaxf(mx, __shfl_xor(mx, 32)); mx = fmaxf(mx, sink2);
            float sum = 0.f;
#pragma unroll
            for (int j = 0; j < 9; ++j)
#pragma unroll
                for (int r = 0; r < 4; ++r) { const float e = __builtin_amdgcn_exp2f(s[j][r] - mx); s[j][r] = e; sum += e; }
            sum += __shfl_xor(sum, 16); sum += __shfl_xor(sum, 32); sum += __builtin_amdgcn_exp2f(sink2 - mx);
            const float inv = 1.0f / sum;
            unsigned pw[10][2];
#pragma unroll
            for (int j = 0; j < 9; ++j) { pw[j][0] = pk2(s[j][0] * inv, s[j][1] * inv); pw[j][1] = pk2(s[j][2] * inv, s[j][3] * inv); }
            pw[9][0] = 0u; pw[9][1] = 0u;
            f32x4 o[4];
#pragma unroll
            for (int dt = 0; dt < 4; ++dt) o[dt] = (f32x4){0.f, 0.f, 0.f, 0.f};
#pragma unroll
            for (int sI = 0; sI < 5; ++sI) {
                const v4u pb = {pw[2 * sI][0], pw[2 * sI][1], pw[2 * sI + 1][0], pw[2 * sI + 1][1]};
                const int kkA = 16 * w + 32 * sI + 4 * g4; int kkB = kkA + 16; if (kkB > 252) kkB = 252;
#pragma unroll
                for (int dt = 0; dt < 4; ++dt) { const LAS bf16* vp = vt + (16 * dt + c16) * 264;
                    const v2u va = *(const LAS v2u*)(vp + kkA), vb = *(const LAS v2u*)(vp + kkB);
                    const v4u av = {va.x, va.y, vb.x, vb.y};
                    o[dt] = MFMA16(__builtin_bit_cast(bf16x8, av), __builtin_bit_cast(bf16x8, pb), o[dt]); }
            }
            bf16* op = YSWA + (size_t)(q0 + c16) * 768 + 64 * h + 4 * g4;
#pragma unroll
            for (int dt = 0; dt < 4; ++dt) { v2u wv; wv.x = pk2(o[dt][0], o[dt][1]); wv.y = pk2(o[dt][2], o[dt][3]); *(GAS v2u*)(op + 16 * dt) = wv; }
        }
    }
    __syncthreads();
}

__device__ __forceinline__ void mix_phase(const Ctx& C, const bf16* YCONV, const bf16* YSWA, const bf16* ODIFF, const float* conv_g, const float* swa_g, const float* lq1, const float* lk1, const float* lq2, const float* lk2,
                                          const float* sub_g, float lambda_init, bf16* MIX) {
    const float lam = __expf(wave_sum(lq1[C.lane] * lk1[C.lane])) - __expf(wave_sum(lq2[C.lane] * lk2[C.lane])) + lambda_init;
    const float osc = 1.0f - lambda_init;
    const int l = C.lane;
    for (int m = C.gw; m < T; m += C.NGW) {
        { const v4u y = *(const GAS v4u*)(YCONV + (size_t)m * 512 + 8 * l);
          float f[8] = {bflo(y.x), bfhi(y.x), bflo(y.y), bfhi(y.y), bflo(y.z), bfhi(y.z), bflo(y.w), bfhi(y.w)}; float ss = 0.f;
#pragma unroll
          for (int i = 0; i < 8; ++i) ss += f[i] * f[i];
          const float r = 1.0f / sqrtf(wave_sum(ss) * (1.0f / 512.0f) + RMS_EPS);
          const f32x4 g0 = *(const GAS f32x4*)(conv_g + 8 * l), g1 = *(const GAS f32x4*)(conv_g + 8 * l + 4);
          v4u o; o.x = pk2(f[0] * r * g0.x, f[1] * r * g0.y); o.y = pk2(f[2] * r * g0.z, f[3] * r * g0.w); o.z = pk2(f[4] * r * g1.x, f[5] * r * g1.y); o.w = pk2(f[6] * r * g1.z, f[7] * r * g1.w);
          *(GAS v4u*)(MIX + (size_t)m * DM + 8 * l) = o; }
        { const v4u y = *(const GAS v4u*)(YSWA + (size_t)m * 768 + 8 * l); const v2u y2 = *(const GAS v2u*)(YSWA + (size_t)m * 768 + 512 + 4 * l);
          float f[12] = {bflo(y.x), bfhi(y.x), bflo(y.y), bfhi(y.y), bflo(y.z), bfhi(y.z), bflo(y.w), bfhi(y.w), bflo(y2.x), bfhi(y2.x), bflo(y2.y), bfhi(y2.y)}; float ss = 0.f;
#pragma unroll
          for (int i = 0; i < 12; ++i) ss += f[i] * f[i];
          const float r = 1.0f / sqrtf(wave_sum(ss) * (1.0f / 768.0f) + RMS_EPS);
          const f32x4 g0 = *(const GAS f32x4*)(swa_g + 8 * l), g1 = *(const GAS f32x4*)(swa_g + 8 * l + 4), g2 = *(const GAS f32x4*)(swa_g + 512 + 4 * l);
          v4u o; o.x = pk2(f[0] * r * g0.x, f[1] * r * g0.y); o.y = pk2(f[2] * r * g0.z, f[3] * r * g0.w); o.z = pk2(f[4] * r * g1.x, f[5] * r * g1.y); o.w = pk2(f[6] * r * g1.z, f[7] * r * g1.w);
          v2u o2; o2.x = pk2(f[8] * r * g2.x, f[9] * r * g2.y); o2.y = pk2(f[10] * r * g2.z, f[11] * r * g2.w);
          *(GAS v4u*)(MIX + (size_t)m * DM + 512 + 8 * l) = o; *(GAS v2u*)(MIX + (size_t)m * DM + 1024 + 4 * l) = o2; }
        { const int vh = l >> 5, dd = 2 * (l & 31); const float gA = sub_g[2 * l], gB = sub_g[2 * l + 1];
#pragma unroll
          for (int h = 0; h < 6; ++h) { const bf16* ob = ODIFF + (size_t)m * 1536 + 64 * (4 * h + vh) + dd;
              const unsigned a = *(const GAS unsigned*)ob, bq = *(const GAS unsigned*)(ob + 128);
              const float v0 = bflo(a) - lam * bflo(bq), v1 = bfhi(a) - lam * bfhi(bq);
              const float r = 1.0f / sqrtf(wave_sum(v0 * v0 + v1 * v1) * (1.0f / 128.0f) + LN_EPS);
              *(GAS unsigned*)(MIX + (size_t)m * DM + 1280 + 128 * h + 2 * l) = pk2(v0 * r * gA * osc, v1 * r * gB * osc); } }
    }
}

__device__ __forceinline__ void router_phase(const Ctx& C, const bf16* X, const float* rowss, const bf16* RW, const float* gain, const float* bg, const float* be, unsigned char* XN8, unsigned char* rt) {
    int* tok_e = (int*)(rt + RT_TOKE); int* tok_p = (int*)(rt + RT_TOKP); float* tok_g = (float*)(rt + RT_GATE); int* row_slot = (int*)(rt + RT_SLOT); int* hist = (int*)(rt + RT_HIST);
    LAS int* lh = (LAS int*)(C.lds + RING_OFF);
    LAS float* lg = (LAS float*)(C.lds + RING_OFF + 1024) + C.wave * 640;
    for (int i = C.gtid; i < PROWS; i += C.NT) row_slot[i] = -1;
    __syncthreads();
    if (C.tid < 64) lh[C.tid] = 0;
    __syncthreads();
    const int r0 = C.blk * 64 + C.wave * 8, c16 = C.lane & 15, g4 = C.lane >> 4;
    float rstd_l;
    { const GAS f32x4* pp = (const GAS f32x4*)(rowss + (size_t)(r0 + (C.lane >> 3)) * 32) + (C.lane & 7); const f32x4 q = pp[0]; float ssr = (q.x + q.y) + (q.z + q.w);
      ssr += __shfl_xor(ssr, 1); ssr += __shfl_xor(ssr, 2); ssr += __shfl_xor(ssr, 4); rstd_l = 1.0f / sqrtf(ssr * (1.0f / DM) + RMS_EPS); }
    const float rstd = __shfl(rstd_l, (c16 & 7) * 8);
    const float hsc = rstd * SA1;
    const bf16* xrow = X + (size_t)(r0 + (c16 & 7)) * DM + 8 * g4;
    LAS float* gl = (LAS float*)(C.lds + RING_OFF + 114688);
    for (int i = C.tid; i < DM; i += 512) gl[i] = gain[i];
    const LAS float* grow = gl + 8 * g4;
    unsigned char* hrow = XN8 + (size_t)(r0 + (c16 & 7)) * DM + 8 * g4;
    LAS bf16* wb = (LAS bf16*)(C.lds + RING_OFF + 24576);
    constexpr int WROW = 136, WBUF = 160 * WROW;
    f32x4 acc[5];
#pragma unroll
    for (int i = 0; i < 5; ++i) acc[i] = (f32x4){0.f, 0.f, 0.f, 0.f};
    v4u wreg[5]; v4u x0[4], x1[4];
#define RT_WLOAD(c) do { _Pragma("unroll") for (int i = 0; i < 5; ++i) { const int task = C.tid + 512 * i, row = task >> 4, seg = task & 15; wreg[i] = *(const GAS v4u*)(RW + (size_t)row * DM + (c) * 128 + seg * 8); } } while (0)
#define RT_WSTORE(c) do { _Pragma("unroll") for (int i = 0; i < 5; ++i) { const int task = C.tid + 512 * i, row = task >> 4, seg = task & 15; *(LAS v4u*)(wb + ((c) & 1) * WBUF + row * WROW + seg * 8) = wreg[i]; } } while (0)
#define RT_XLOAD(XB, c) do { const int cc_ = (c) < 16 ? (c) : 15; _Pragma("unroll") for (int ks = 0; ks < 4; ++ks) XB[ks] = *(const GAS v4u*)(xrow + cc_ * 128 + 32 * ks); } while (0)
#define RT_HLOAD(BF, ks) do { _Pragma("unroll") for (int nt = 0; nt < 5; ++nt) BF[nt] = *(const LAS bf16x8*)(cur + nt * 16 * WROW + 32 * (ks)); } while (0)
#define RT_LLOAD(BF, ks) do { _Pragma("unroll") for (int nt = 0; nt < 5; ++nt) BF[nt] = *(const LAS bf16x8*)(cur + (80 + nt * 16) * WROW + 32 * (ks)); } while (0)
#define RT_KSTEP(c, XB, ks, BH, BL) do { const v4u xq = XB[ks]; const bf16x8 ax = __builtin_bit_cast(bf16x8, xq); \
            _Pragma("unroll") for (int nt = 0; nt < 5; ++nt) acc[nt] = MFMA16(ax, BH[nt], acc[nt]); \
            _Pragma("unroll") for (int nt = 0; nt < 5; ++nt) acc[nt] = MFMA16(ax, BL[nt], acc[nt]); \
            { const f32x4 ga = *(const LAS f32x4*)(grow + (c) * 128 + 32 * (ks)), gb = *(const LAS f32x4*)(grow + (c) * 128 + 32 * (ks) + 4); v2u hw;     \
                hw.x = pk4_fp8m(bflo(xq.x) * hsc * ga.x, bfhi(xq.x) * hsc * ga.y, bflo(xq.y) * hsc * ga.z, bfhi(xq.y) * hsc * ga.w); hw.y = pk4_fp8m(bflo(xq.z) * hsc * gb.x, bfhi(xq.z) * hsc * gb.y, bflo(xq.w) * hsc * gb.z, bfhi(xq.w) * hsc * gb.w); \
                *(GAS v2u*)(hrow + (c) * 128 + 32 * (ks)) = hw; }     } while (0)
#define RT_CHUNK(c, XB) do { const LAS bf16* cur = wb + ((c) & 1) * WBUF + c16 * WROW + 8 * g4; bf16x8 hA[5], hB[5], lF[5]; RT_HLOAD(hA, 0); \
        RT_LLOAD(lF, 0); RT_HLOAD(hB, 1); RT_KSTEP(c, XB, 0, hA, lF); RT_LLOAD(lF, 1); RT_HLOAD(hA, 2); RT_KSTEP(c, XB, 1, hB, lF); \
        RT_LLOAD(lF, 2); RT_HLOAD(hB, 3); RT_KSTEP(c, XB, 2, hA, lF); RT_LLOAD(lF, 3); RT_KSTEP(c, XB, 3, hB, lF); } while (0)
    RT_WLOAD(0); RT_XLOAD(x0, 0); RT_WSTORE(0);
    __syncthreads();
#pragma unroll 1
    for (int c = 0; c < 16; c += 2) {
        RT_WLOAD(c + 1); RT_XLOAD(x1, c + 1); RT_CHUNK(c, x0); RT_WSTORE(c + 1); __syncthreads();
        RT_WLOAD(c + 2 < 16 ? c + 2 : 15); RT_XLOAD(x0, c + 2); RT_CHUNK(c + 1, x1); RT_WSTORE(c + 2); __syncthreads();
    }
#undef RT_WLOAD
#undef RT_WSTORE
#undef RT_XLOAD
#undef RT_CHUNK
#undef RT_KSTEP
#undef RT_HLOAD
#undef RT_LLOAD
    float rs4[4];
#pragma unroll
    for (int r = 0; r < 4; ++r) rs4[r] = __shfl(rstd_l, ((4 * g4 + r) & 7) * 8);
    if (g4 < 2) {
#pragma unroll
        for (int r = 0; r < 4; ++r) { const int row = 4 * g4 + r;
#pragma unroll
            for (int nt = 0; nt < 5; ++nt) { const int o = 16 * nt + c16; if (o < 72) lg[row * 80 + o] = acc[nt][r] * rs4[r] + (o < 8 ? bg[o] : be[o - 8]); } }
    }
    LDS_WAIT(); asm volatile("" ::: "memory");
    if (C.lane < 8) { const LAS float* L = lg + C.lane * 80;
        int gi = 0; float gm = L[0];
#pragma unroll
        for (int j = 1; j < 8; ++j) { const float v = L[j]; if (v > gm) { gm = v; gi = j; } }
        float gs = 0.f;
#pragma unroll
        for (int j = 0; j < 8; ++j) gs += __expf(L[j] - gm);
        const float gw_ = 1.0f / gs;
        const LAS float* E = L + 8 + 8 * gi;
        int j1 = 0; float m1 = E[0];
#pragma unroll
        for (int j = 1; j < 8; ++j) { const float v = E[j]; if (v > m1) { m1 = v; j1 = j; } }
        int j2 = (j1 == 0) ? 1 : 0; float m2 = E[j2];
#pragma unroll
        for (int j = 0; j < 8; ++j) { const float v = E[j]; if (j != j1 && v > m2) { m2 = v; j2 = j; } }
        const float ex = __expf(m2 - m1), w1 = 1.0f / (1.0f + ex), w2 = ex * w1;
        const int e0 = 8 * gi + j1, e1 = 8 * gi + j2, tok = r0 + C.lane;
        const int p0 = atomicAdd((int*)&lh[e0], 1), p1 = atomicAdd((int*)&lh[e1], 1);
        tok_e[2 * tok] = e0; tok_e[2 * tok + 1] = e1; tok_p[2 * tok] = p0; tok_p[2 * tok + 1] = p1; tok_g[2 * tok] = gw_ * w1; tok_g[2 * tok + 1] = gw_ * w2;
    }
    __syncthreads();
    if (C.tid < 64) hist[C.blk * 64 + C.tid] = lh[C.tid];
    __syncthreads();
}

__device__ __forceinline__ void moe_table(const Ctx& C, const int* hist) {
    LAS int* padstart = (LAS int*)(C.lds + TAB_OFF); LAS int* base = padstart + 64; LAS int* tab = padstart + 128; LAS int* ntl = padstart + 320;
    LAS int* part = (LAS int*)(C.lds + TAB_PART);
    __syncthreads();
    { const int e = C.tid & 63, p = C.tid >> 6; int tot = 0, pre = 0;
      for (int b = 32 * p; b < 32 * p + 32; ++b) { const int h = hist[b * 64 + e]; tot += h; pre += (b < C.blk) ? h : 0; }
      part[(p * 64 + e) * 2] = tot; part[(p * 64 + e) * 2 + 1] = pre; }
    __syncthreads();
    if (C.tid < 64) { const int e = C.tid; int cnt = 0, pre = 0;
#pragma unroll
        for (int p = 0; p < 8; ++p) { cnt += part[(p * 64 + e) * 2]; pre += part[(p * 64 + e) * 2 + 1]; }
        const int nt = (cnt + 255) >> 8; int inc = nt;
#pragma unroll
        for (int off = 1; off < 64; off <<= 1) { const int t = __shfl_up(inc, off); if (e >= off) inc += t; }
        const int ts = inc - nt; padstart[e] = 256 * ts; base[e] = pre;
        for (int i = 0; i < nt; ++i) tab[ts + i] = e;
        if (e == 63) ntl[0] = inc; }
    __syncthreads();
}
__device__ __forceinline__ void slot_phase(const Ctx& C, unsigned char* rt) {
    const int* tok_e = (const int*)(rt + RT_TOKE); const int* tok_p = (const int*)(rt + RT_TOKP); int* row_slot = (int*)(rt + RT_SLOT);
    const LAS int* padstart = (const LAS int*)(C.lds + TAB_OFF); const LAS int* base = padstart + 64;
    if (C.tid < 128) { const int slot = 2 * (C.blk * 64) + C.tid; const int e = tok_e[slot]; row_slot[padstart[e] + base[e] + tok_p[slot]] = slot; }
}
__device__ __forceinline__ int att_unit_tab(int i) {
    static constexpr unsigned char T_[96] = {7, 2, 10, 15, 18, 26, 23, 34, 42, 31, 50, 58, 39, 66, 74, 47, 82, 90, 55, 4, 0, 63, 12, 8, 71, 20, 16, 79, 28, 24, 87, 36, 32, 95, 44, 40, 6, 5, 48, 14, 13, 56, 22, 21, 64, 30, 29, 72, 38, 37, 80, 46, 45, 88, 54, 3, 1, 62, 11, 9, 70, 19, 17, 78, 27, 25, 86, 35, 33, 94, 43, 41, 53, 52, 49, 61, 60, 57, 69, 68, 65, 77, 76, 73, 85, 84, 81, 93, 92, 89, 51, 59, 67, 75, 83, 91};
    return T_[i];
}
typedef const void* const __attribute__((address_space(4)))* KARGP;
struct Args { const void* in[26]; float* out; unsigned char* ws; int ph_lo, ph_hi, use_bar, pad; };
__global__ void __launch_bounds__(512, 2) mega_fwd(Args args) {
    extern __shared__ __attribute__((aligned(16))) unsigned char lds_raw[];
    const int wave0 = __builtin_amdgcn_readfirstlane((int)threadIdx.x >> 6), blk0 = blockIdx.x;
    LAS unsigned char* const ldsb = (LAS unsigned char*)lds_raw;
#define MKCTX Ctx C; C.lds = ldsb; C.wave = wave0; asm volatile("v_mbcnt_lo_u32_b32 %0, -1, 0\n\tv_mbcnt_hi_u32_b32 %0, -1, %0" : "=v"(C.lane)); C.tid = wave0 * 64 + C.lane; C.blk = blk0; \
    C.vcu = (blk0 % 8) * (GRID / 8) + blk0 / 8; C.gw = blk0 * 8 + wave0; C.gtid = blk0 * 512 + C.tid
    unsigned char* ws0 = args.ws;
    for (int u = threadIdx.x; u < 128; u += 512) ((LAS unsigned*)(ldsb + LCTL_OFF))[u] = 0u;
    __syncthreads();
    XcdBarrier bar; bar.bar = (unsigned*)(ws0 + WS_CTL) + CW_BAR; bar.x = 0; bar.st = (volatile LAS unsigned*)(ldsb + LCTL_OFF + 64);
    if (args.use_bar) bar = xcd_barrier_post((unsigned*)(ws0 + WS_CTL) + CW_BAR, (volatile LAS unsigned*)(ldsb + LCTL_OFF + 64));
    const int lo = args.ph_lo, hi = args.ph_hi;
#ifndef PH_DIS
#define PH_DIS 0
#endif
#define INR(k) (lo <= (k) && (k) < hi)
#define IN0 (INR(0) && !(PH_DIS & 1))
#define INL(off) (INR(pb + (off)) && !((PH_DIS >> (1 + (off))) & 1))
#ifndef PROBE_DUP
#define PROBE_DUP 0
#endif
#define NREP(bit) (((PROBE_DUP >> (bit)) & 1) ? 2 : 1)
#define LAUNDER MKCTX; asm volatile("" : "+v"(C.tid), "+v"(C.lane), "+v"(C.gtid)); PTRS
#ifndef PROBE_BAR2
#define PROBE_BAR2 0
#endif
#define SEAM(k) do { if (INR(k) && INR((k) + 1)) { xcd_barrier(bar); if (PROBE_BAR2) xcd_barrier(bar); } } while (0)
#define GIN(i) ((const float*)(const GAS float*)ain[i])
#define PTRS GAS unsigned char* wsg_ = (GAS unsigned char*)ws0; asm volatile("" : "+s"(wsg_)); unsigned char* ws = (unsigned char*)wsg_;     \
    KARGP ain = (KARGP)__builtin_amdgcn_kernarg_segment_ptr(); asm volatile("" : "+s"(ain));     \
    const float* x_in = GIN(0); \
    bf16* XN = (bf16*)(ws + WS_XN); bf16* PROJ = (bf16*)(ws + WS_PROJ); bf16* ZC = (bf16*)(ws + WS_ZC); bf16* YCONV = (bf16*)(ws + WS_YCONV); bf16* YSWA = (bf16*)(ws + WS_YSWA); \
    bf16* ODIFF = (bf16*)(ws + WS_ODIFF); bf16* MIX = (bf16*)(ws + WS_MIX); bf16* X = (bf16*)(ws + WS_X); bf16* Zb = (bf16*)(ws + WS_Z); bf16* ACT = (bf16*)(ws + WS_ACT); bf16* YS = (bf16*)(ws + WS_YS); \
    unsigned char* rt = ws + WS_ROUTE; (void)x_in; (void)XN; (void)PROJ; (void)ZC; (void)YCONV; (void)YSWA; (void)ODIFF; (void)MIX; (void)X; (void)Zb; (void)ACT; (void)YS; (void)rt
    if (IN0) for (int rep_ = 0; rep_ < NREP(0); ++rep_) { LAUNDER;
        P0In I{GIN(3), GIN(17), GIN(8), GIN(23), GIN(24), GIN(19), GIN(21), GIN(18), ((const int*)GIN(1))};
        p0_prologue(C, I, ws);
        norm_rows<0>(C, x_in, nullptr, nullptr, nullptr, GIN(2), XN, nullptr);
    }
    SEAM(0);
#pragma unroll 1
    for (int l = 0; l < DEPTH; ++l) {
        const int pb = 1 + 10 * l;
        const float lambda_init = (l == 0) ? 0.2f : 0.35550906759096927f;
        if (INL(0)) for (int rep_ = 0; rep_ < NREP(1); ++rep_) { LAUNDER;
            pg8::Gemm g{XN, (const bf16*)(ws + WS_WIN) + (size_t)l * INW * DM, T, INW, DM}; pg8::StaticOrder S; S.init(T, INW, C.G, C.blk);
            pg8::EpiProj E{PROJ, INW, Zb, (const float*)(ws + WS_ROPEC), (const float*)(ws + WS_ROPES), QSCALE};
            pg8::gemm_phase<pg8::EpiProj, pg8::StaticOrder, true, true>(C.lds + RING_OFF, g, S, E, C.tid);
            if (C.blk >= 128) { P0In I{nullptr, nullptr, nullptr, GIN(23), GIN(24), nullptr, nullptr, nullptr, nullptr};
                constexpr int PER_L = MOE_ITEMS_L;
                moe_convert(C, I, ws, l * PER_L, l * PER_L + CONV_TAIL, C.blk - 128, 128); }
        }
        SEAM(pb + 0);
        if (INL(2)) for (int rep_ = 0; rep_ < NREP(3); ++rep_) { LAUNDER;
            unsigned* zc_cnt = (unsigned*)(ws + WS_CTL) + CW_ZC + 64 * l + 2048 * rep_;
            convpre_phase(C, Zb, GIN(4) + l * CONV_W * CONV_CH, GIN(5) + l * CONV_CH, GIN(6) + l * CONV_CH, GIN(7) + l * CONV_CH, ZC);
            asm volatile("s_waitcnt vmcnt(0)" ::: "memory");
            __syncthreads();
            if (C.tid == 0) __hip_atomic_fetch_add(zc_cnt, 1u, __ATOMIC_RELAXED, __HIP_MEMORY_SCOPE_AGENT);
#ifndef NO_ATT
            for (int rep2_ = 0; rep2_ < NREP(11); ++rep2_)
#pragma unroll 1
            for (int step = 0; step < 6; ++step) {
                const int third = step >> 1;
                if ((step & 1) == (C.vcu & 1)) {
                    P0In I{nullptr, nullptr, nullptr, GIN(23), GIN(24), nullptr, nullptr, nullptr, nullptr};
                    constexpr int PER_L = MOE_ITEMS_L, NIT = PER_L - CONV_TAIL - CONV_OUT, T3 = (NIT / 3 + C.G - 1) / C.G * C.G;
                    const int lo = l * PER_L + CONV_TAIL + third * T3, hi = (third == 2) ? (l + 1) * PER_L - CONV_OUT : lo + T3;
                    moe_convert(C, I, ws, lo, hi, C.blk, C.G);
                } else {
                    { const int xcd = C.vcu >> 5, ci = C.vcu & 31, tv = att_unit_tab(ci * 3 + third), qb = tv & 7, gi = xcd * 12 + (tv >> 3), b = gi / 12, hc = gi - b * 12, h = hc >> 1, c = hc & 1;
                        const attn_body::bf16* Q = (const attn_body::bf16*)PROJ + C_QD + (2 * h + c) * 64; const attn_body::bf16* K = (const attn_body::bf16*)PROJ + C_KD + (2 * h + c) * 64;
                        const attn_body::bf16* V = (const attn_body::bf16*)PROJ + C_VD + 128 * h; attn_body::bf16* O = (attn_body::bf16*)ODIFF + 64 * (4 * h + 2 * c);
                        attn_body::attn_unit2<8>(b, qb, Q, K, V, O, (char*)lds_raw + RING_OFF, C.tid); }
                }
            }
#endif
            __syncthreads();
#ifndef NO_SWA
            for (int rep2_ = 0; rep2_ < NREP(12); ++rep2_)
            swa_phase(C, PROJ, GIN(10) + l * 12, YSWA);
#endif
#ifndef NO_PW
            if (C.tid == 0) { unsigned sp_ = 0;
                while (__hip_atomic_load(zc_cnt, __ATOMIC_RELAXED, __HIP_MEMORY_SCOPE_AGENT) < (unsigned)C.G) { __builtin_amdgcn_s_sleep(2); if (++sp_ > (1u << 22)) break; }
                __builtin_amdgcn_fence(__ATOMIC_ACQUIRE, "agent"); asm volatile("s_waitcnt vmcnt(0)" ::: "memory"); }
            __syncthreads();
            for (int rep2_ = 0; rep2_ < NREP(13); ++rep2_)
            { pg8::Gemm g{ZC, (const bf16*)(ws + WS_PW) + (size_t)l * 512 * 512, T, 512, 512}; pg8::StaticOrder S; S.init(T, 512, C.G, C.blk);
              pg8::EpiBf16<0> E{YCONV, 512, nullptr, 0, 0, 1.f};
              pg8::gemm_phase<pg8::EpiBf16<0>, pg8::StaticOrder, true, true>(C.lds + RING_OFF, g, S, E, C.tid); }
#endif
        }
        SEAM(pb + 2);
        if (INL(3)) for (int rep_ = 0; rep_ < NREP(4); ++rep_) { LAUNDER;
            mix_phase(C, YCONV, YSWA, ODIFF, GIN(9) + l * 512, GIN(11) + l * 768, GIN(12) + l * 64, GIN(13) + l * 64,
                      GIN(14) + l * 64, GIN(15) + l * 64, GIN(16) + l * 128, lambda_init, MIX);
        }
        SEAM(pb + 3);
        if (INL(4)) for (int rep_ = 0; rep_ < ((l == 0) ? NREP(5) : 1); ++rep_) { LAUNDER;
            pg8::Gemm g{MIX, (const bf16*)(ws + WS_WOUT) + (size_t)l * DM * DM, T, DM, DM}; pg8::StaticOrder S; S.init(T, DM, C.G, C.blk);
            P0In Ic{nullptr, nullptr, nullptr, GIN(23), GIN(24), nullptr, nullptr, nullptr, nullptr};
            constexpr int PER_Lc = MOE_ITEMS_L;
            P0In Iw{GIN(3), GIN(17), GIN(8), nullptr, nullptr, nullptr, nullptr, nullptr, nullptr};
            if ((C.vcu & 1) == 0) { moe_convert(C, Ic, ws, (l + 1) * PER_Lc - CONV_OUT, (l + 1) * PER_Lc, C.blk, C.G); if (l + 1 < DEPTH) wconv_bf16(C, Iw, ws, (l + 1) * WCONV_L, (l + 2) * WCONV_L); }
            if (l == 0) { pg8::EpiResBf16<true> E{x_in, X, DM, (float*)(ws + WS_ROWSS)}; pg8::gemm_phase<pg8::EpiResBf16<true>, pg8::StaticOrder, true, true>(C.lds + RING_OFF, g, S, E, C.tid); }
            else { pg8::EpiResBf16<false> E{X, X, DM, (float*)(ws + WS_ROWSS)}; pg8::gemm_phase<pg8::EpiResBf16<false>, pg8::StaticOrder, true, true>(C.lds + RING_OFF, g, S, E, C.tid); }
            if ((C.vcu & 1) != 0) { moe_convert(C, Ic, ws, (l + 1) * PER_Lc - CONV_OUT, (l + 1) * PER_Lc, C.blk, C.G); if (l + 1 < DEPTH) wconv_bf16(C, Iw, ws, (l + 1) * WCONV_L, (l + 2) * WCONV_L); }
        }
        SEAM(pb + 4);
        if (INL(5)) for (int rep_ = 0; rep_ < NREP(6); ++rep_) { LAUNDER;
            router_phase(C, X, (const float*)(ws + WS_ROWSS), (const bf16*)(ws + WS_RW) + (size_t)l * 2 * 80 * DM, GIN(18) + l * DM, GIN(20) + l * 8, GIN(22) + l * 64, (unsigned char*)XN, rt);
        }
        SEAM(pb + 5);
        if (INL(6)) for (int rep_ = 0; rep_ < NREP(7); ++rep_) { LAUNDER; moe_table(C, (const int*)(rt + RT_HIST)); slot_phase(C, rt); }
        SEAM(pb + 6);
        if (INL(7)) for (int rep_ = 0; rep_ < NREP(8); ++rep_) { LAUNDER;
            if (!args.use_bar) moe_table(C, (const int*)(rt + RT_HIST));
            const LAS int* tb = (const LAS int*)(C.lds + TAB_OFF);
            pg8::Gemm g{XN, (const bf16*)(ws + WS_W13 + (size_t)l * NEXP * 1024 * DM), PROWS, NEXP * 1024, DM / 2};
            pg8::GroupedOrder S{tb + 128, tb[320], 4, C.G, C.vcu};
            LAS unsigned* gofs = (LAS unsigned*)(C.lds + GOFS_OFF); const int* row_slot = (const int*)(rt + RT_SLOT);
#pragma unroll 1
            for (int i = 0; i < 3; ++i) { pg8::Unit u; if (!S.next(i, u)) break; if (C.tid < 256) { const int sl = row_slot[u.pm * 256 + C.tid]; gofs[i * 256 + C.tid] = (unsigned)(sl < 0 ? 0 : sl >> 1) * (unsigned)DM; } }
            __syncthreads();
            pg8::EpiSiluMul8 E{(unsigned char*)ACT, FF, 1.0f / (SA1 * SW1), SA2};
            pg8::gemm_phase<pg8::EpiSiluMul8, pg8::GroupedOrder, true, true, true, true>(C.lds + RING_OFF, g, S, E, C.tid, gofs);
        }
        SEAM(pb + 7);
        if (INL(8)) for (int rep_ = 0; rep_ < NREP(9); ++rep_) { LAUNDER;
            if (!args.use_bar) moe_table(C, (const int*)(rt + RT_HIST));
            const LAS int* tb = (const LAS int*)(C.lds + TAB_OFF);
            pg8::Gemm g{ACT, (const bf16*)(ws + WS_W2 + (size_t)l * NEXP * DM * FF), PROWS, NEXP * DM, FF / 2};
            pg8::GroupedOrder S{tb + 128, tb[320], 8, C.G, C.vcu};
            pg8::EpiScatter E{(unsigned char*)YS, DM, (const int*)(rt + RT_SLOT), SY / (SA2 * SW2)};
            pg8::gemm_phase<pg8::EpiScatter, pg8::GroupedOrder, true, true, false, true>(C.lds + RING_OFF, g, S, E, C.tid);
        }
        SEAM(pb + 8);
        if (INL(9)) for (int rep_ = 0; rep_ < ((l + 1 == DEPTH) ? NREP(10) : 1); ++rep_) { LAUNDER;
            if (l + 1 < DEPTH) norm_rows<1>(C, X, X, (const unsigned char*)YS, (const float*)(rt + RT_GATE), GIN(2) + (l + 1) * DM, XN, nullptr);
            else norm_rows<2>(C, X, nullptr, (const unsigned char*)YS, (const float*)(rt + RT_GATE), GIN(25), nullptr, args.out);
        }
        SEAM(pb + 9);
    }
#undef LAUNDER
#undef MKCTX
#undef PTRS
#undef GIN
#undef INR
#undef IN0
#undef INL
#undef SEAM
}

extern "C" void kernel_launch(void* const* d_in, const int* in_sizes, int n_in, void* d_out, int out_size, void* d_ws, size_t ws_size, hipStream_t stream) {
    static int grid = 0;
    if (grid == 0) {
        if (n_in != 26 || in_sizes[0] != T * DM || out_size != T * DM || ws_size < WS_END) { fprintf(stderr, "kernel_launch: unexpected shapes (n_in %d, in0 %d, out %d, ws %zu < %zu); nothing launched\n", n_in, n_in > 0 ? in_sizes[0] : -1, out_size, ws_size, (size_t)WS_END); grid = -1; return; }
        int dev = 0, cus = 0, per_cu = 0;
        if (hipGetDevice(&dev) != hipSuccess || hipDeviceGetAttribute(&cus, hipDeviceAttributeMultiprocessorCount, dev) != hipSuccess) { fprintf(stderr, "kernel_launch: device query failed\n"); grid = -1; return; }
        if (hipFuncSetAttribute((const void*)mega_fwd, hipFuncAttributeMaxDynamicSharedMemorySize, LDS_BYTES) != hipSuccess) { fprintf(stderr, "kernel_launch: hipFuncSetAttribute failed\n"); grid = -1; return; }
        if (hipOccupancyMaxActiveBlocksPerMultiprocessor(&per_cu, (const void*)mega_fwd, 512, LDS_BYTES) != hipSuccess || per_cu < 1) fprintf(stderr, "kernel_launch: note: occupancy query reports %d workgroups per CU\n", per_cu);
        (void)hipGetLastError();
        if (cus != 256) { fprintf(stderr, "kernel_launch: built for a 256-CU device (got %d); nothing launched\n", cus); grid = -1; return; }
        grid = cus;
    }
    if (grid < 0) return;
    if (hipMemsetAsync((char*)d_ws + WS_CTL, 0, CTL_ZERO_BYTES, stream) != hipSuccess) { fprintf(stderr, "kernel_launch: memset failed\n"); return; }
    if (grid != GRID) return;
    Args a{};
    for (int i = 0; i < 26; ++i) a.in[i] = d_in[i];
    a.out = (float*)d_out; a.ws = (unsigned char*)d_ws; a.pad = 0;
#if MK_MULTI
    for (int k = 0; k < NPHASE; ++k) { a.ph_lo = k; a.ph_hi = k + 1; a.use_bar = 0; hipLaunchKernelGGL(mega_fwd, dim3(grid), dim3(512), LDS_BYTES, stream, a); }
#else
    a.ph_lo = 0; a.ph_hi = NPHASE; a.use_bar = 1;
    hipLaunchKernelGGL(mega_fwd, dim3(grid), dim3(512), LDS_BYTES, stream, a);
#endif
    const hipError_t le = hipPeekAtLastError();
    if (le != hipSuccess) fprintf(stderr, "kernel_launch: launch failed: %s\n", hipGetErrorName(le));
}
```

```cpp
#include <hip/hip_runtime.h>
#include <cstdio>
#include <cstdint>
namespace pg8 {
#define PG8_LAS __attribute__((address_space(3)))
typedef unsigned short bf16_t;
typedef short bf16x8 __attribute__((ext_vector_type(8)));
typedef float f32x4 __attribute__((ext_vector_type(4)));
typedef unsigned u32x4 __attribute__((ext_vector_type(4)));
typedef int pg8_i4 __attribute__((ext_vector_type(4)));
#ifndef PG8_WT
#define PG8_WT 0
#endif
#define PG8_RSRC(base) __builtin_amdgcn_make_buffer_rsrc((void*)(base), (short)0, -1, 0x00020000)
#if PG8_WT
#define PG8_ST16(rs, b0, p, v) __builtin_amdgcn_raw_buffer_store_b128(v, rs, (int)((const char*)(p) - (const char*)(b0)), 0, 16)
#define PG8_ST8(rs, b0, p, v) __builtin_amdgcn_raw_buffer_store_b64(v, rs, (int)((const char*)(p) - (const char*)(b0)), 0, 16)
#else
#define PG8_ST16(rs, b0, p, v) (*(u32x4*)(p) = (v))
#define PG8_ST8(rs, b0, p, v) (*(u32x2_g*)(p) = (v))
#endif
typedef unsigned u32x2_g __attribute__((ext_vector_type(2)));
typedef int pg8_i8 __attribute__((ext_vector_type(8)));
constexpr int BM = 256, BK = 64, HALF = 128, HTB = HALF * BK * 2  , STAGE_BYTES = 8 * HTB, NXCD = 8, WGM = 8;

__host__ __device__ __forceinline__ int lds_byte(int r, int c) { const int st = (r >> 4) * 2 + (c >> 5), rr = r & 15, cc = c & 31, ob = rr * 64 + cc * 2; return st * 1024 + (ob ^ (((ob >> 9) & 1) << 5)); }
__host__ __device__ __forceinline__ void stage_rc(int b, int& R, int& C) { const int st = b / 1024, sb = b % 1024, swz = sb ^ (((sb >> 9) & 1) << 5); R = (st >> 1) * 16 + swz / 64; C = (st & 1) * 32 + (swz % 64) / 2; }
__host__ __device__ __forceinline__ int perm32(int rho) { const int n = rho >> 4, i = rho & 15; return 8 * (i >> 2) + 4 * n + (i & 3); }

struct Unit { int pm, pn; };
struct Gemm { const bf16_t* A; const bf16_t* Bt; int M, N, K; };

struct StaticOrder {
    int nM, nN, nwg, G, c;
    __host__ __device__ void init(int M, int N, int G_, int c_) { nM = M / BM; nN = N / BM; nwg = nM * nN; G = G_; c = c_; }
    __host__ __device__ bool next(int i, Unit& u) const {
        const long L = (long)i * G + c; if (L >= nwg) return false;
        int wgid = (int)L; { const int q = nwg / NXCD, r = nwg % NXCD, xcd = wgid % NXCD, off = wgid / NXCD; wgid = (xcd < r ? xcd * (q + 1) : r * (q + 1) + (xcd - r) * q) + off; }
        const int nig = WGM * nN, gid = wgid / nig, fm = gid * WGM, gsz = (nM - fm) < WGM ? (nM - fm) : WGM;
        u.pm = fm + ((wgid % nig) % gsz); u.pn = (wgid % nig) / gsz; return true;
    }
    __device__ __forceinline__ void a_ready(const Unit&) const {}
    __device__ __forceinline__ void done(const Unit&) const {}
};

__device__ __forceinline__ unsigned cvt_pk_bf16(float lo, float hi) { unsigned r; asm volatile("v_cvt_pk_bf16_f32 %0, %1, %2" : "=v"(r) : "v"(lo), "v"(hi)); return r; }
typedef float f32x2 __attribute__((ext_vector_type(2)));
__device__ __forceinline__ f32x2 gelu_pk(f32x2 v) {
    const f32x2 av = __builtin_elementwise_abs(v), d = av * 0.2316418882f + 1.0f;
    f32x2 t; t.x = __builtin_amdgcn_rcpf(d.x); t.y = __builtin_amdgcn_rcpf(d.y);
    f32x2 q = t * 0.5307027145f + (-0.7265760135f); q = q * t + 0.7107068705f; q = q * t + (-0.142248368f); q = q * t + 0.127414796f; q = q * t;
    const f32x2 s = (v * v) * (-0.72134752044f);
    f32x2 e; e.x = __builtin_amdgcn_exp2f(s.x); e.y = __builtin_amdgcn_exp2f(s.y);
    const f32x2 m = v * (q * e), r = v - m;
    f32x2 o; o.x = v.x < 0.f ? m.x : r.x; o.y = v.y < 0.f ? m.y : r.y; return o;
}

template <int ACT  > struct EpiBf16 {
    static constexpr bool PERM = true, AFTER_DRAIN = false; static_assert(ACT == 0 || ACT == 1, "EpiBf16: ACT is 0 (none) or 1 (gelu_pk)");
    bf16_t* O; int ldc; const float* bias; int split_cols; size_t split_stride; float scale0;
    __device__ __forceinline__ void operator()(const f32x4 (&acc)[2][2][4][2], const Unit& u, int wr, int wc, int fr, int fq) const {
        const int row0 = u.pm * BM + wr * 64 + fr; int colt = u.pn * BM; bf16_t* base = O;
        float sc = 1.f; if (split_cols) { const int t = colt / split_cols; base += (size_t)t * split_stride; colt -= t * split_cols; if (t == 0) sc = scale0; }
        const int col0 = colt + wc * 32 + 8 * fq, bcol0 = u.pn * BM + wc * 32 + 8 * fq; const __amdgpu_buffer_rsrc_t rs_ = PG8_RSRC(base);
        f32x4 bv[2][2];
#pragma unroll
        for (int bj = 0; bj < 2; ++bj)
#pragma unroll
            for (int n = 0; n < 2; ++n) bv[bj][n] = bias ? *(const f32x4*)(bias + bcol0 + bj * HALF + 4 * n) : (f32x4){0.f, 0.f, 0.f, 0.f};
#pragma unroll
        for (int ai = 0; ai < 2; ++ai)
#pragma unroll
            for (int m = 0; m < 4; ++m) { bf16_t* rowp = base + (size_t)(row0 + ai * HALF + m * 16) * ldc + col0;
#pragma unroll
                for (int bj = 0; bj < 2; ++bj) { f32x4 v0 = acc[ai][bj][m][0] + bv[bj][0], v1 = acc[ai][bj][m][1] + bv[bj][1];
                    if (ACT == 1) { f32x2 a = gelu_pk((f32x2){v0[0], v0[1]}), b = gelu_pk((f32x2){v0[2], v0[3]}), c = gelu_pk((f32x2){v1[0], v1[1]}), d = gelu_pk((f32x2){v1[2], v1[3]});
                        v0 = (f32x4){a.x, a.y, b.x, b.y}; v1 = (f32x4){c.x, c.y, d.x, d.y}; }
                    v0 = v0 * sc; v1 = v1 * sc; u32x4 w; w.x = cvt_pk_bf16(v0[0], v0[1]); w.y = cvt_pk_bf16(v0[2], v0[3]); w.z = cvt_pk_bf16(v1[0], v1[1]); w.w = cvt_pk_bf16(v1[2], v1[3]);
                    PG8_ST16(rs_, base, rowp + bj * HALF, w); } }
    }
};
struct EpiResF32 {
    static constexpr bool PERM = false, AFTER_DRAIN = false;
    const float* base; float* out; int ldc; float* rowss;
    __device__ __forceinline__ void operator()(const f32x4 (&acc)[2][2][4][2], const Unit& u, int wr, int wc, int fr, int fq) const {
        const int row0 = u.pm * BM + wr * 64 + fr, col0 = u.pn * BM + wc * 32 + 4 * fq;
#pragma unroll
        for (int ai = 0; ai < 2; ++ai)
#pragma unroll
            for (int m = 0; m < 4; ++m) { const size_t off = (size_t)(row0 + ai * HALF + m * 16) * ldc + col0; float ssq = 0.f;
#pragma unroll
                for (int bj = 0; bj < 2; ++bj)
#pragma unroll
                    for (int n = 0; n < 2; ++n) { const f32x4 b = *(const f32x4*)(base + off + bj * HALF + n * 16); const f32x4 o = b + acc[ai][bj][m][n]; *(f32x4*)(out + off + bj * HALF + n * 16) = o;
                        ssq += (o[0] * o[0] + o[1] * o[1]) + (o[2] * o[2] + o[3] * o[3]); }
                ssq += __shfl_xor(ssq, 16); ssq += __shfl_xor(ssq, 32);
                if (fq == 0) rowss[(size_t)(row0 + ai * HALF + m * 16) * 32 + 4 * u.pn + wc] = ssq; }
    }
};
template <bool BASE_F32> struct EpiResBf16 {
    static constexpr bool PERM = true, AFTER_DRAIN = false;
    const void* base; bf16_t* out; int ldc; float* rowss;
    __device__ __forceinline__ void operator()(const f32x4 (&acc)[2][2][4][2], const Unit& u, int wr, int wc, int fr, int fq) const {
        const int row0 = u.pm * BM + wr * 64 + fr, col0 = u.pn * BM + wc * 32 + 8 * fq; const __amdgpu_buffer_rsrc_t rs_ = PG8_RSRC(out);
#pragma unroll
        for (int ai = 0; ai < 2; ++ai) {
            f32x4 b0[4][2], b1[4][2];
#pragma unroll
            for (int m = 0; m < 4; ++m) { const size_t off = (size_t)(row0 + ai * HALF + m * 16) * ldc + col0;
#pragma unroll
                for (int bj = 0; bj < 2; ++bj) {
                    if (BASE_F32) { b0[m][bj] = *(const f32x4*)((const float*)base + off + bj * HALF); b1[m][bj] = *(const f32x4*)((const float*)base + off + bj * HALF + 4); }
                    else { const u32x4 q = *(const u32x4*)((const bf16_t*)base + off + bj * HALF);
                        b0[m][bj] = (f32x4){__uint_as_float(q.x << 16), __uint_as_float(q.x & 0xffff0000u), __uint_as_float(q.y << 16), __uint_as_float(q.y & 0xffff0000u)};
                        b1[m][bj] = (f32x4){__uint_as_float(q.z << 16), __uint_as_float(q.z & 0xffff0000u), __uint_as_float(q.w << 16), __uint_as_float(q.w & 0xffff0000u)}; } } }
            asm volatile("" ::: "memory");
#pragma unroll
            for (int m = 0; m < 4; ++m) { const size_t off = (size_t)(row0 + ai * HALF + m * 16) * ldc + col0; float ssq = 0.f;
#pragma unroll
                for (int bj = 0; bj < 2; ++bj) {
                    const f32x4 o0 = b0[m][bj] + acc[ai][bj][m][0], o1 = b1[m][bj] + acc[ai][bj][m][1];
                    ssq += ((o0[0] * o0[0] + o0[1] * o0[1]) + (o0[2] * o0[2] + o0[3] * o0[3])) + ((o1[0] * o1[0] + o1[1] * o1[1]) + (o1[2] * o1[2] + o1[3] * o1[3]));
                    u32x4 w; w.x = cvt_pk_bf16(o0[0], o0[1]); w.y = cvt_pk_bf16(o0[2], o0[3]); w.z = cvt_pk_bf16(o1[0], o1[1]); w.w = cvt_pk_bf16(o1[2], o1[3]);
                    PG8_ST16(rs_, out, out + off + bj * HALF, w); }
                ssq += __shfl_xor(ssq, 16); ssq += __shfl_xor(ssq, 32);
                if (fq == 0) rowss[(size_t)(row0 + ai * HALF + m * 16) * 32 + 4 * u.pn + wc] = ssq; }
            asm volatile("" ::: "memory");
        }
    }
};
__device__ __forceinline__ float silu_f(float a) { return a * __builtin_amdgcn_rcpf(1.0f + __builtin_amdgcn_exp2f(-1.4426950408889634f * a)); }
struct EpiSiluMul {
    static constexpr bool PERM = true, AFTER_DRAIN = false;
    bf16_t* O; int ldc;
    __device__ __forceinline__ void operator()(const f32x4 (&acc)[2][2][4][2], const Unit& u, int wr, int wc, int fr, int fq) const {
        const int row0 = u.pm * BM + wr * 64 + fr, col0 = (u.pn & 3) * HALF + wc * 32 + 8 * fq; const __amdgpu_buffer_rsrc_t rs_ = PG8_RSRC(O);
#pragma unroll
        for (int ai = 0; ai < 2; ++ai)
#pragma unroll
            for (int m = 0; m < 4; ++m) { bf16_t* rowp = O + (size_t)(row0 + ai * HALF + m * 16) * ldc + col0;
                const f32x4 a0 = acc[ai][0][m][0], a1 = acc[ai][0][m][1], b0 = acc[ai][1][m][0], b1 = acc[ai][1][m][1];
                u32x4 w; w.x = cvt_pk_bf16(silu_f(a0[0]) * b0[0], silu_f(a0[1]) * b0[1]); w.y = cvt_pk_bf16(silu_f(a0[2]) * b0[2], silu_f(a0[3]) * b0[3]);
                w.z = cvt_pk_bf16(silu_f(a1[0]) * b1[0], silu_f(a1[1]) * b1[1]); w.w = cvt_pk_bf16(silu_f(a1[2]) * b1[2], silu_f(a1[3]) * b1[3]);
                PG8_ST16(rs_, O, rowp, w); }
    }
};
__device__ __forceinline__ unsigned pk4_fp8(float a, float b, float c, float d) {
    a = __builtin_fminf(__builtin_fmaxf(a, -448.f), 448.f); b = __builtin_fminf(__builtin_fmaxf(b, -448.f), 448.f); c = __builtin_fminf(__builtin_fmaxf(c, -448.f), 448.f); d = __builtin_fminf(__builtin_fmaxf(d, -448.f), 448.f);
    int w = 0; w = __builtin_amdgcn_cvt_pk_fp8_f32(a, b, w, false); w = __builtin_amdgcn_cvt_pk_fp8_f32(c, d, w, true); return (unsigned)w; }
struct EpiSiluMul8 {
    static constexpr bool PERM = true, AFTER_DRAIN = false;
    unsigned char* O; int ldc; float inv, osc;
    __device__ __forceinline__ void operator()(const f32x4 (&acc)[2][2][4][2], const Unit& u, int wr, int wc, int fr, int fq) const {
        typedef unsigned u32x2 __attribute__((ext_vector_type(2)));
        const int row0 = u.pm * BM + wr * 64 + fr, col0 = (u.pn & 3) * HALF + wc * 32 + 8 * fq; const __amdgpu_buffer_rsrc_t rs_ = PG8_RSRC(O);
#pragma unroll
        for (int ai = 0; ai < 2; ++ai)
#pragma unroll
            for (int m = 0; m < 4; ++m) { unsigned char* rowp = O + (size_t)(row0 + ai * HALF + m * 16) * ldc + col0;
                const f32x4 a0 = acc[ai][0][m][0] * inv, a1 = acc[ai][0][m][1] * inv, b0 = acc[ai][1][m][0] * (inv * osc), b1 = acc[ai][1][m][1] * (inv * osc);
                u32x2 w; w.x = pk4_fp8(silu_f(a0[0]) * b0[0], silu_f(a0[1]) * b0[1], silu_f(a0[2]) * b0[2], silu_f(a0[3]) * b0[3]);
                w.y = pk4_fp8(silu_f(a1[0]) * b1[0], silu_f(a1[1]) * b1[1], silu_f(a1[2]) * b1[2], silu_f(a1[3]) * b1[3]);
                PG8_ST8(rs_, O, rowp, w); }
    }
};
struct EpiScatter {
    static constexpr bool PERM = true, AFTER_DRAIN = false;
    unsigned char* O; int ldc; const int* slot; float sc;
    __device__ __forceinline__ void operator()(const f32x4 (&acc)[2][2][4][2], const Unit& u, int wr, int wc, int fr, int fq) const {
        typedef unsigned u32x2 __attribute__((ext_vector_type(2)));
        const int row0 = u.pm * BM + wr * 64 + fr, col0 = (u.pn & 7) * BM + wc * 32 + 8 * fq; const __amdgpu_buffer_rsrc_t rs_ = PG8_RSRC(O);
        int sl[2][4];
#pragma unroll
        for (int ai = 0; ai < 2; ++ai)
#pragma unroll
            for (int m = 0; m < 4; ++m) sl[ai][m] = slot[row0 + ai * HALF + m * 16];
#pragma unroll
        for (int ai = 0; ai < 2; ++ai)
#pragma unroll
            for (int m = 0; m < 4; ++m) { if (sl[ai][m] >= 0) { unsigned char* rowp = O + (size_t)sl[ai][m] * ldc + col0;
#pragma unroll
                for (int bj = 0; bj < 2; ++bj) { const f32x4 v0 = acc[ai][bj][m][0] * sc, v1 = acc[ai][bj][m][1] * sc; u32x2 w; w.x = pk4_fp8(v0[0], v0[1], v0[2], v0[3]); w.y = pk4_fp8(v1[0], v1[1], v1[2], v1[3]);
                    PG8_ST8(rs_, O, rowp + bj * HALF, w); } } }
    }
};
struct EpiProj {
    static constexpr bool PERM = true, AFTER_DRAIN = false;
    bf16_t* P; int ldp; bf16_t* Z; const float* rc; const float* rs; float qscale;
    __device__ __forceinline__ void operator()(const f32x4 (&acc)[2][2][4][2], const Unit& u, int wr, int wc, int fr, int fq) const {
        typedef unsigned u32x2 __attribute__((ext_vector_type(2)));
        const int row0 = u.pm * BM + wr * 64 + fr, pn = u.pn; const __amdgpu_buffer_rsrc_t rsz_ = PG8_RSRC(Z), rsp_ = PG8_RSRC(P);
        if (pn < 4) {
#pragma unroll
            for (int ai = 0; ai < 2; ++ai)
#pragma unroll
                for (int m = 0; m < 4; ++m) { bf16_t* rowp = Z + (size_t)(row0 + ai * HALF + m * 16) * 512 + pn * HALF + wc * 32 + 8 * fq;
                    const f32x4 a0 = acc[ai][0][m][0], a1 = acc[ai][0][m][1], g0 = acc[ai][1][m][0], g1 = acc[ai][1][m][1];
#define PG8_SIG(x) __builtin_amdgcn_rcpf(1.0f + __builtin_amdgcn_exp2f(-1.4426950408889634f * (x)))
                    u32x4 w; w.x = cvt_pk_bf16(a0[0] * PG8_SIG(g0[0]), a0[1] * PG8_SIG(g0[1])); w.y = cvt_pk_bf16(a0[2] * PG8_SIG(g0[2]), a0[3] * PG8_SIG(g0[3]));
                    w.z = cvt_pk_bf16(a1[0] * PG8_SIG(g1[0]), a1[1] * PG8_SIG(g1[1])); w.w = cvt_pk_bf16(a1[2] * PG8_SIG(g1[2]), a1[3] * PG8_SIG(g1[3]));
#undef PG8_SIG
                    PG8_ST16(rsz_, Z, rowp, w); }
        } else if (pn == 8 || pn >= 15) {
            const int col0 = pn * BM + wc * 32 + 8 * fq;
#pragma unroll
            for (int ai = 0; ai < 2; ++ai)
#pragma unroll
                for (int m = 0; m < 4; ++m) { bf16_t* rowp = P + (size_t)(row0 + ai * HALF + m * 16) * ldp + col0;
#pragma unroll
                    for (int bj = 0; bj < 2; ++bj) { const f32x4 v0 = acc[ai][bj][m][0], v1 = acc[ai][bj][m][1]; u32x4 w; w.x = cvt_pk_bf16(v0[0], v0[1]); w.y = cvt_pk_bf16(v0[2], v0[3]); w.z = cvt_pk_bf16(v1[0], v1[1]); w.w = cvt_pk_bf16(v1[2], v1[3]);
                        PG8_ST16(rsp_, P, rowp + bj * HALF, w); } }
        } else {
            const float sc = (pn <= 6 || (pn >= 9 && pn <= 11)) ? qscale : 1.0f;
            const int f = 16 * (wc & 1) + 4 * fq, col0 = pn * BM + 64 * (wc >> 1) + f;
#pragma unroll
            for (int ai = 0; ai < 2; ++ai) {
                f32x4 c4[4], s4[4];
#pragma unroll
                for (int m = 0; m < 4; ++m) { const int row = row0 + ai * HALF + m * 16; c4[m] = *(const f32x4*)(rc + (size_t)row * 32 + f); s4[m] = *(const f32x4*)(rs + (size_t)row * 32 + f); }
                asm volatile("" ::: "memory");
#pragma unroll
                for (int m = 0; m < 4; ++m) { const int row = row0 + ai * HALF + m * 16;
                    const f32x4 cc = c4[m] * sc, ss = s4[m] * sc;
                    bf16_t* rowp = P + (size_t)row * ldp + col0;
#pragma unroll
                    for (int bj = 0; bj < 2; ++bj) { const f32x4 x1 = acc[ai][bj][m][0], x2 = acc[ai][bj][m][1]; const f32x4 o1 = x1 * cc - x2 * ss, o2 = x2 * cc + x1 * ss;
                        u32x2 w1, w2; w1.x = cvt_pk_bf16(o1[0], o1[1]); w1.y = cvt_pk_bf16(o1[2], o1[3]); w2.x = cvt_pk_bf16(o2[0], o2[1]); w2.y = cvt_pk_bf16(o2[2], o2[3]);
                        PG8_ST8(rsp_, P, rowp + bj * HALF, w1); PG8_ST8(rsp_, P, rowp + bj * HALF + 32, w2); } }
                asm volatile("" ::: "memory"); }
        }
    }
};
struct GroupedOrder {
    const PG8_LAS int* tab; int ntiles, NC, G, c;
    __device__ __forceinline__ bool next(int i, Unit& u) const {
        const int L = i * G + c; if (L >= ntiles * NC) return false;
        const int rt = L / NC, j = L - rt * NC; u.pm = rt; u.pn = tab[rt] * NC + j; return true;
    }
    __device__ __forceinline__ void a_ready(const Unit&) const {}
    __device__ __forceinline__ void done(const Unit&) const {}
};
template <class Epi, class Sched, bool ALIGN_EPI = false, bool SP2 = false, bool GATHER = false, bool FP8 = false>
__device__ __forceinline__ void gemm_phase(PG8_LAS unsigned char* lds, const Gemm g, const Sched& S, const Epi& E, int tid_in  , const PG8_LAS unsigned* gofs = nullptr) {
    static_assert(!GATHER || SP2, "GATHER is wired into the SP2 loop only");
    int tid_ = tid_in; asm volatile("" : "+v"(tid_));
    const int tid = tid_, wid = __builtin_amdgcn_readfirstlane(tid >> 6), lane = tid & 63, wr = wid >> 2, wc = wid & 3, fr = lane & 15, fq = lane >> 4;
    int K_ = g.K; asm volatile("" : "+s"(K_));
    const int K = K_, nt = K / BK;
    unsigned voffA[2], voffB[2];
#pragma unroll
    for (int i = 0; i < 2; ++i) { int R, C; stage_rc(tid * 16 + i * 8192, R, C); const int Rb = Epi::PERM ? ((R & ~31) + perm32(R & 31)) : R;
        voffA[i] = (unsigned)(R * K + C) * 2u; voffB[i] = (unsigned)(Rb * K + C) * 2u; }
    int gL[2], gC[2];
#pragma unroll
    for (int i = 0; i < 2; ++i) { int R, C; stage_rc(tid * 16 + i * 8192, R, C); gL[i] = R; gC[i] = C * 2; }
    const size_t kstep = (size_t)(BK * 2);
    const size_t hstep = (size_t)HALF * K * 2;
    const size_t tstep = 2 * hstep;
    const unsigned ldsw = (unsigned)wid * 1024u;
    const int aoff = lds_byte(wr * 64 + fr, fq * 8), boff = lds_byte(wc * 32 + fr, fq * 8);
#define PG8_SA(b, h) (((b) * 2 + (h)) * HTB)
#define PG8_SB(b, h) ((4 + (b) * 2 + (h)) * HTB)
#define PG8_STAGE(bufoff, gbase, voff) do { _Pragma("unroll") for (int _i = 0; _i < 2; ++_i) \
        __builtin_amdgcn_global_load_lds((const unsigned*)((const char*)(gbase) + (voff)[_i]), (PG8_LAS unsigned*)(lds + (bufoff) + ldsw + _i * 8192), 16, 0, 0); } while (0)
#define PG8_STAGE_A(bufoff, ptr, h, nx) do { if constexpr (GATHER) { const int ub_ = ((nx) ? gnext : ui) * 256 + (h) * 128; unsigned vv_[2]; _Pragma("unroll") for (int _j = 0; _j < 2; ++_j) vv_[_j] = gofs[ub_ + gL[_j]] + (unsigned)gC[_j]; PG8_STAGE(bufoff, ptr, vv_); } \
        else { PG8_STAGE(bufoff, (ptr) + (size_t)(h) * hstep, voffA); } } while (0)
#define PG8_LDA(dst, b, h) do { _Pragma("unroll") for (int m = 0; m < 4; ++m) _Pragma("unroll") for (int k = 0; k < 2; ++k) dst[m][k] = *(const PG8_LAS bf16x8*)(lds + PG8_SA(b, h) + aoff + m * 2048 + k * 1024); } while (0)
#define PG8_LDB(dst, b, h) do { _Pragma("unroll") for (int n = 0; n < 2; ++n) _Pragma("unroll") for (int k = 0; k < 2; ++k) dst[n][k] = *(const PG8_LAS bf16x8*)(lds + PG8_SB(b, h) + boff + n * 2048 + k * 1024); } while (0)
#define PG8_CAT(x0, x1) __builtin_shufflevector(__builtin_bit_cast(pg8_i4, x0), __builtin_bit_cast(pg8_i4, x1), 0, 1, 2, 3, 4, 5, 6, 7)
#define PG8_MMA(ai, bj, At, Bt) do { __builtin_amdgcn_s_setprio(1); if constexpr (FP8) { _Pragma("unroll") for (int m = 0; m < 4; ++m) _Pragma("unroll") for (int n = 0; n < 2; ++n) \
        { const pg8_i8 b8_ = PG8_CAT(Bt[n][0], Bt[n][1]), a8_ = PG8_CAT(At[m][0], At[m][1]); asm volatile("v_mfma_f32_16x16x128_f8f6f4 %0, %1, %2, %0" : "+v"(acc[ai][bj][m][n]) : "v"(b8_), "v"(a8_)); } } \
        else { _Pragma("unroll") for (int m = 0; m < 4; ++m) _Pragma("unroll") for (int n = 0; n < 2; ++n) _Pragma("unroll") for (int k = 0; k < 2; ++k) \
        acc[ai][bj][m][n] = __builtin_amdgcn_mfma_f32_16x16x32_bf16(Bt[n][k], At[m][k], acc[ai][bj][m][n], 0, 0, 0); } __builtin_amdgcn_s_setprio(0); } while (0)
#define PG8_WAIT_V(n) asm volatile("s_waitcnt vmcnt(" #n ")" ::: "memory")
#define PG8_WAIT_L(n) asm volatile("s_waitcnt lgkmcnt(" #n ")" ::: "memory")
#define PG8_BAR __builtin_amdgcn_s_barrier()
#define PG8_SCHED __builtin_amdgcn_sched_barrier(0)
    Unit cur, nxt; int ui = 0;
    if (!S.next(0, cur)) return;
    f32x4 acc[2][2][4][2];
#pragma unroll
    for (int a = 0; a < 2; ++a)
#pragma unroll
        for (int b = 0; b < 2; ++b)
#pragma unroll
            for (int m = 0; m < 4; ++m)
#pragma unroll
                for (int n = 0; n < 2; ++n) acc[a][b][m][n] = (f32x4){0.f, 0.f, 0.f, 0.f};
    bf16x8 At[4][2], B0[2][2], B1[2][2];
    const char* cA = GATHER ? (const char*)g.A : (const char*)g.A + (size_t)cur.pm * tstep; int gnext = 0;
    const char* cB = (const char*)g.Bt + (size_t)cur.pn * tstep;
    S.a_ready(cur);
    if constexpr (SP2) {
        PG8_STAGE(PG8_SB(0, 0), cB, voffB); PG8_STAGE(PG8_SB(0, 1), cB + hstep, voffB); PG8_STAGE_A(PG8_SA(0, 0), cA, 0, false); PG8_STAGE_A(PG8_SA(0, 1), cA, 1, false);
        if (wr == 1) PG8_BAR;
        PG8_WAIT_V(2); PG8_BAR;
        PG8_STAGE(PG8_SB(1, 0), cB + kstep, voffB); PG8_STAGE_A(PG8_SA(1, 0), cA + kstep, 0, false); PG8_STAGE(PG8_SB(1, 1), cB + hstep + kstep, voffB);
        PG8_WAIT_V(6); PG8_BAR;
    } else {
        PG8_STAGE(PG8_SB(0, 0), cB, voffB); PG8_STAGE(PG8_SA(0, 0), cA, voffA); PG8_STAGE(PG8_SB(0, 1), cB + hstep, voffB); PG8_STAGE(PG8_SA(0, 1), cA + hstep, voffA);
        if (wr == 1) PG8_BAR;
        PG8_WAIT_V(4); PG8_BAR;
        PG8_STAGE(PG8_SB(1, 0), cB + kstep, voffB); PG8_STAGE(PG8_SA(1, 0), cA + kstep, voffA); PG8_STAGE(PG8_SB(1, 1), cB + hstep + kstep, voffB);
        PG8_WAIT_V(6); PG8_BAR;
    }
    for (;;) {
        const bool has_next = S.next(ui + 1, nxt);
        const char* nA = (has_next && !GATHER) ? (const char*)g.A + (size_t)nxt.pm * tstep : cA;
        gnext = has_next ? ui + 1 : ui;
        const char* nB = has_next ? (const char*)g.Bt + (size_t)nxt.pn * tstep : cB;
        for (int t = 0; t < nt; t += 2) {
            const bool last = (t == nt - 2);
            const char* a1 = cA + (size_t)(t + 1) * kstep;
            const char* a2 = last ? nA : cA + (size_t)(t + 2) * kstep; const char* b2 = last ? nB : cB + (size_t)(t + 2) * kstep;
            const char* a3 = a2 + kstep; const char* b3 = b2 + kstep;
            if (last && has_next) S.a_ready(nxt);
            if constexpr (SP2) {
            PG8_LDB(B0, 0, 0); PG8_LDB(B1, 0, 1); PG8_SCHED; PG8_LDA(At, 0, 0); PG8_STAGE_A(PG8_SA(1, 1), a1, 1, false);
            PG8_WAIT_V(8); PG8_WAIT_L(0); PG8_BAR; PG8_MMA(0, 0, At, B0); PG8_MMA(0, 1, At, B1); PG8_BAR; PG8_SCHED;
            PG8_LDA(At, 0, 1); PG8_STAGE(PG8_SB(0, 0), b2, voffB); PG8_STAGE(PG8_SB(0, 1), b2 + hstep, voffB); PG8_STAGE_A(PG8_SA(0, 0), a2, 0, last);
            PG8_WAIT_V(8); PG8_WAIT_L(0); PG8_BAR; PG8_MMA(1, 0, At, B0); PG8_MMA(1, 1, At, B1); PG8_BAR; PG8_SCHED;
            PG8_LDB(B0, 1, 0); PG8_LDB(B1, 1, 1); PG8_SCHED; PG8_LDA(At, 1, 0); PG8_STAGE_A(PG8_SA(0, 1), a2, 1, last);
            PG8_WAIT_V(8); PG8_WAIT_L(0); PG8_BAR; PG8_MMA(0, 0, At, B0); PG8_MMA(0, 1, At, B1); PG8_BAR; PG8_SCHED;
            PG8_LDA(At, 1, 1); PG8_STAGE(PG8_SB(1, 0), b3, voffB); PG8_STAGE(PG8_SB(1, 1), b3 + hstep, voffB); PG8_STAGE_A(PG8_SA(1, 0), a3, 0, last);
            PG8_WAIT_V(8); PG8_WAIT_L(0); PG8_BAR; PG8_MMA(1, 0, At, B0); PG8_MMA(1, 1, At, B1); PG8_BAR; PG8_SCHED;
            } else {
            PG8_LDB(B0, 0, 0); PG8_SCHED; PG8_LDA(At, 0, 0); PG8_STAGE(PG8_SA(1, 1), a1 + hstep, voffA);
            PG8_WAIT_L(8); PG8_BAR; PG8_WAIT_L(0); PG8_MMA(0, 0, At, B0); PG8_BAR; PG8_SCHED;
            PG8_LDB(B1, 0, 1); PG8_STAGE(PG8_SB(0, 0), b2, voffB);
            PG8_BAR; PG8_WAIT_L(0); PG8_MMA(0, 1, At, B1); PG8_BAR;
            PG8_LDA(At, 0, 1); PG8_STAGE(PG8_SA(0, 0), a2, voffA);
            PG8_BAR; PG8_WAIT_L(0); PG8_MMA(1, 0, At, B0); PG8_BAR; PG8_SCHED;
            PG8_STAGE(PG8_SB(0, 1), b2 + hstep, voffB);
            PG8_WAIT_V(6); PG8_BAR; PG8_MMA(1, 1, At, B1); PG8_BAR;
            PG8_LDB(B0, 1, 0); PG8_SCHED; PG8_LDA(At, 1, 0); PG8_STAGE(PG8_SA(0, 1), a2 + hstep, voffA);
            PG8_WAIT_L(8); PG8_BAR; PG8_WAIT_L(0); PG8_MMA(0, 0, At, B0); PG8_BAR; PG8_SCHED;
            PG8_LDB(B1, 1, 1); PG8_STAGE(PG8_SB(1, 0), b3, voffB);
            PG8_BAR; PG8_WAIT_L(0); PG8_MMA(0, 1, At, B1); PG8_BAR;
            PG8_LDA(At, 1, 1); PG8_STAGE(PG8_SA(1, 0), a3, voffA);
            PG8_BAR; PG8_WAIT_L(0); PG8_MMA(1, 0, At, B0); PG8_BAR; PG8_SCHED;
            PG8_STAGE(PG8_SB(1, 1), b3 + hstep, voffB);
            PG8_WAIT_V(6); PG8_BAR; PG8_MMA(1, 1, At, B1); PG8_BAR;
            }
        }
        if constexpr (FP8) asm volatile("s_nop 15\n\ts_nop 15" ::: "memory");
        if constexpr (ALIGN_EPI) { if (wr == 0) PG8_BAR; }
        if constexpr (!Epi::AFTER_DRAIN) { E(acc, cur, wr, wc, fr, fq); S.done(cur); }
        if (!has_next) break;
#pragma unroll
        for (int a = 0; a < 2; ++a)
#pragma unroll
            for (int b = 0; b < 2; ++b)
#pragma unroll
                for (int m = 0; m < 4; ++m)
#pragma unroll
                    for (int n = 0; n < 2; ++n) acc[a][b][m][n] = (f32x4){0.f, 0.f, 0.f, 0.f};
        cur = nxt; cA = nA; cB = nB; ++ui;
        if constexpr (ALIGN_EPI) { if (wr == 1) PG8_BAR; }
    }
    PG8_WAIT_V(0);
    if constexpr (!ALIGN_EPI) { if (wr == 0) PG8_BAR; }
    PG8_BAR;
    if constexpr (Epi::AFTER_DRAIN) { E.fused(acc, cur, wr, wc, fr, fq, lds, wid, lane); S.done(cur); }
#undef PG8_SA
#undef PG8_STAGE_A
#undef PG8_SB
#undef PG8_STAGE
#undef PG8_LDA
#undef PG8_LDB
#undef PG8_MMA
#undef PG8_CAT
#undef PG8_WAIT_V
#undef PG8_WAIT_L
#undef PG8_BAR
#undef PG8_SCHED
}
}
#include <hip/hip_bf16.h>
#include <cmath>
namespace attn_body {
using bf16=__hip_bfloat16;
using bf16x8=__attribute__((ext_vector_type(8)))short;
using s16x4=__attribute__((ext_vector_type(4)))short;
using f32x16=__attribute__((ext_vector_type(16)))float;
using u32x4=__attribute__((ext_vector_type(4)))unsigned;
constexpr int SEQ=2048,D=64,PQ=4608,PO=1536;
constexpr int NW=8,QBLK=32,QB=QBLK*NW,KVBLK=64,NQB=SEQ/QB;
constexpr int ATTN_UNIT_ROWS=QB;
__device__ __forceinline__ int crow(int r,int hi){return (r&3)+8*(r>>2)+4*hi;}
#define SBAR() __builtin_amdgcn_sched_barrier(0)
__device__ __forceinline__ void cmask(f32x16&p0,f32x16&p1,int jb,int qrel,int hi){
  const float NEG=-INFINITY; int kb=64*jb+4*hi;
  #pragma unroll
  for(int r=0;r<16;++r){int kv=kb+(r&3)+8*(r>>2); if(kv>qrel)p0[r]=NEG; if(kv+32>qrel)p1[r]=NEG;}
}

constexpr int NSLOT=3, SLOTB=8192;
constexpr int LDS_K=0, LDS_V=NSLOT*SLOTB, LDS_WS=2*NSLOT*SLOTB, LDS_OST=LDS_WS+NW*64*4, LDS_BYTES=LDS_OST+NW*4096;
constexpr float C2=0.125f*1.4426950408889634f;
__device__ __forceinline__ void glds16(const void*gsrc,unsigned lds_dst){unsigned keep;
  asm volatile("s_mov_b32 %0, m0\n\ts_mov_b32 m0, %2\n\ts_nop 0\n\tglobal_load_lds_dwordx4 %1, off\n\ts_mov_b32 m0, %0":"=&s"(keep):"v"(gsrc),"s"(lds_dst):"memory");}
__device__ __forceinline__ float max3f(float a,float b,float c){float r;asm("v_max3_f32 %0, %1, %2, %3":"=v"(r):"v"(a),"v"(b),"v"(c));return r;}
__device__ __forceinline__ float max2f(float a,float b){float r;asm("v_max_f32_e32 %0, %1, %2":"=v"(r):"v"(a),"v"(b));return r;}
__device__ __forceinline__ float fadd_s(float a,float b){float r;asm("v_add_f32_e32 %0, %1, %2":"=v"(r):"v"(a),"v"(b));return r;}
__device__ __forceinline__ float fsub_s(float a,float b){float r;asm("v_sub_f32_e32 %0, %1, %2":"=v"(r):"v"(a),"v"(b));return r;}
typedef float f32x2_t __attribute__((ext_vector_type(2))); typedef __bf16 bf16x2_t __attribute__((ext_vector_type(2)));
__device__ __forceinline__ unsigned cvtpk_s(float lo,float hi){f32x2_t v={lo,hi};bf16x2_t b=__builtin_convertvector(v,bf16x2_t);return __builtin_bit_cast(unsigned,b);}
#define WAIT_BAR(N) asm volatile("s_waitcnt vmcnt(" #N ") lgkmcnt(0)\n\ts_barrier":::"memory")

__device__ __forceinline__ void qkt(f32x16&p0,f32x16&p1,const char*Kslot,const bf16x8*qr,const f32x16&negm,int r32,int hi){
  const char*kb=Kslot+hi*1024+r32*16;
  #pragma unroll
  for(int d0=0;d0<4;++d0){
    const bf16x8 b0=*reinterpret_cast<const bf16x8*>(kb+d0*2048);
    const bf16x8 b1=*reinterpret_cast<const bf16x8*>(kb+d0*2048+512);
    if(d0==0){p0=__builtin_amdgcn_mfma_f32_32x32x16_bf16(b0,qr[0],negm,0,0,0);p1=__builtin_amdgcn_mfma_f32_32x32x16_bf16(b1,qr[0],negm,0,0,0);}
    else{p0=__builtin_amdgcn_mfma_f32_32x32x16_bf16(b0,qr[d0],p0,0,0,0);p1=__builtin_amdgcn_mfma_f32_32x32x16_bf16(b1,qr[d0],p1,0,0,0);}}
}
typedef __attribute__((address_space(3))) const char* lds_cptr;
typedef short v4i16_t __attribute__((ext_vector_type(4)));
__device__ __forceinline__ void kload8(bf16x8*kf,lds_cptr kp){
  kf[0]=*(const __attribute__((address_space(3))) bf16x8*)(kp);      kf[1]=*(const __attribute__((address_space(3))) bf16x8*)(kp+512);
  kf[2]=*(const __attribute__((address_space(3))) bf16x8*)(kp+2048); kf[3]=*(const __attribute__((address_space(3))) bf16x8*)(kp+2560);
  kf[4]=*(const __attribute__((address_space(3))) bf16x8*)(kp+4096); kf[5]=*(const __attribute__((address_space(3))) bf16x8*)(kp+4608);
  kf[6]=*(const __attribute__((address_space(3))) bf16x8*)(kp+6144); kf[7]=*(const __attribute__((address_space(3))) bf16x8*)(kp+6656);
}
__device__ __forceinline__ void kload2(bf16x8*kf,lds_cptr kp,int j){ kf[2*j]=*(const __attribute__((address_space(3))) bf16x8*)(kp+j*2048); kf[2*j+1]=*(const __attribute__((address_space(3))) bf16x8*)(kp+j*2048+512); }
__device__ __forceinline__ s16x4 vtr(lds_cptr p){ return __builtin_bit_cast(s16x4,__builtin_amdgcn_ds_read_tr16_b64_v4i16((__attribute__((address_space(3))) v4i16_t*)p)); }
__device__ __forceinline__ float rowmax(const f32x16&p0,const f32x16&p1){
  float a=max3f(p0[0],p0[1],p1[0]),b=max3f(p0[2],p0[3],p1[1]);a=max3f(a,p1[2],p1[3]);
  #pragma unroll
  for(int r=4;r<16;r+=4){a=max3f(a,p0[r],p0[r+1]);b=max3f(b,p0[r+2],p0[r+3]);a=max3f(a,p1[r],p1[r+1]);b=max3f(b,p1[r+2],p1[r+3]);}
  const float m=max2f(a,b);
  auto rr=__builtin_amdgcn_permlane32_swap(__float_as_uint(m),__float_as_uint(m),false,false);
  return max2f(__uint_as_float(rr[0]),__uint_as_float(rr[1]));
}
__device__ __forceinline__ void pv(f32x16*o,int vb,bf16x8 pa0,bf16x8 pa1,bf16x8 pa2,bf16x8 pa3){
  #pragma unroll
  for(int d0=0;d0<2;++d0){s16x4 lo[4],hi[4];
    #pragma unroll
    for(int ks=0;ks<4;++ks){
      asm volatile("ds_read_b64_tr_b16 %0,%1 offset:%c2":"=&v"(lo[ks]):"v"(vb),"i"(d0*4096+ks*1024):"memory");
      asm volatile("ds_read_b64_tr_b16 %0,%1 offset:%c2":"=&v"(hi[ks]):"v"(vb),"i"(d0*4096+ks*1024+512):"memory");}
    asm volatile("s_waitcnt lgkmcnt(0)":::"memory");SBAR();
    #define PK(k) (bf16x8){lo[k][0],lo[k][1],lo[k][2],lo[k][3],hi[k][0],hi[k][1],hi[k][2],hi[k][3]}
    o[d0]=__builtin_amdgcn_mfma_f32_32x32x16_bf16(pa0,PK(0),o[d0],0,0,0);
    o[d0]=__builtin_amdgcn_mfma_f32_32x32x16_bf16(pa1,PK(1),o[d0],0,0,0);
    o[d0]=__builtin_amdgcn_mfma_f32_32x32x16_bf16(pa2,PK(2),o[d0],0,0,0);
    o[d0]=__builtin_amdgcn_mfma_f32_32x32x16_bf16(pa3,PK(3),o[d0],0,0,0);
    #undef PK
  }
}

#ifndef ATTN_STORE16
#define ATTN_STORE16(p,v) (*(u32x4*)(p)=(v))
#endif
template<int THRL> __device__ __forceinline__ void attn_unit(int b,int qb,const bf16*Q,const bf16*__restrict__ K,const bf16*__restrict__ V,bf16*O,char*shm,int tid_in){
  int tid_=tid_in; asm volatile("":"+v"(tid_));
  const int tid=tid_,lane=tid&63,r32=lane&31,hi=lane>>5; const int wid=__builtin_amdgcn_readfirstlane(tid>>6);
  const long rowbase=(long)b*SEQ; const int q0=qb*QB;
  const bf16*Qw=Q+(rowbase+q0+wid*QBLK)*PQ;
  const bf16*Kh=K+rowbase*PQ,*Vh=V+rowbase*PQ;
  const unsigned lds0=(unsigned)(uintptr_t)shm;
  float*wsf=(float*)(shm+LDS_WS)+wid*64;
  const bf16*ksrc=Kh+(long)lane*PQ+wid*8;
  const bf16*vsrc=Vh+(long)(16*(wid&3)+(lane>>2))*PQ+(wid>>2)*32+(lane&3)*8;
  const unsigned kdst=lds0+LDS_K+wid*1024, vdst=lds0+LDS_V+wid*1024;
  #define DMA_K(t,slot) glds16(ksrc+(long)(t)*KVBLK*PQ,(unsigned)__builtin_amdgcn_readfirstlane(kdst+(slot)))
  #define DMA_V(t,slot) glds16(vsrc+(long)(t)*KVBLK*PQ,(unsigned)__builtin_amdgcn_readfirstlane(vdst+(slot)))
  const int vb0=(int)(lds0+LDS_V)+((lane>>4)&1)*32+(lane&3)*8+(4*hi+((lane&15)>>2))*64;
  const char*Kbase=shm+LDS_K; bf16x8 kf[8];
  const lds_cptr shm3=(lds_cptr)shm; const lds_cptr kp0=shm3+LDS_K+hi*1024+r32*16; const lds_cptr vp0=shm3+LDS_V+((lane>>4)&1)*32+(lane&3)*8+(4*hi+((lane&15)>>2))*64;
  const int NT=(q0+QB)/KVBLK;
  DMA_K(0,0);DMA_V(0,0);DMA_K(1,SLOTB);
  bf16x8 qr[4];
  #pragma unroll
  for(int d0=0;d0<4;++d0)qr[d0]=*reinterpret_cast<const bf16x8*>(&Qw[(long)r32*PQ+d0*16+hi*8]);
  float mhat=0.f,l_reg=0.f;f32x16 o[2];o[0]=f32x16{};o[1]=f32x16{};f32x16 negm=f32x16{};asm volatile("":"+v"(negm));
  const int qrel=wid*QBLK+r32;
  #define CMASK(P0,P1,t) do{int jb_=(t)-(NT-4); if(jb_>=0)cmask(P0,P1,jb_,qrel,hi);}while(0)
  bool resc=false;
  #define START(P0,P1) do{ const float rm=rowmax(P0,P1); resc=false; \
    { const float dl=rm; mhat=fadd_s(mhat,dl); \
      _Pragma("unroll") for(int r=0;r<16;++r){P0[r]=fsub_s(P0[r],dl);P1[r]=fsub_s(P1[r],dl);} \
      _Pragma("unroll") for(int r=0;r<16;++r)negm[r]=-mhat; asm volatile("":"+v"(negm)); } \
    _Pragma("unroll") for(int r=0;r<16;++r)P0[r]=__builtin_amdgcn_exp2f(P0[r]); }while(0)
  #define RESC() do{ if(resc){ asm volatile("s_waitcnt lgkmcnt(0)":::"memory"); \
      _Pragma("unroll") for(int d_=0;d_<2;++d_) _Pragma("unroll") for(int r=0;r<16;++r)o[d_][r]*=wsf[crow(r,hi)]; } }while(0)
  f32x16 pA0,pA1,pB0,pB1;
  int sl_prev=0,sl_cur=0,sl_next=SLOTB;
  #define ROT() do{sl_prev=sl_cur;sl_cur=sl_next;sl_next=(sl_next==(NSLOT-1)*SLOTB)?0:sl_next+SLOTB;}while(0)
  DMA_K(2,2*SLOTB);
  WAIT_BAR(3);
  qkt(pA0,pA1,Kbase,qr,negm,r32,hi);asm volatile("s_nop 15\n\ts_nop 7":"+v"(pA0),"+v"(pA1));CMASK(pA0,pA1,0);
  START(pA0,pA1);
  _Pragma("unroll") for(int r=0;r<16;++r)pA1[r]=__builtin_amdgcn_exp2f(pA1[r]);
  WAIT_BAR(0);
  DMA_K(3,0);DMA_V(1,SLOTB);
  ROT();
  kload8(kf,kp0+sl_cur);
  WAIT_BAR(2);
  s16x4 vlo[8],vhi[8]; u32x4 pw0,pw1,pw2,pw3;
  #define PKW(P,B) cvtpk_s(P[B],P[B+1])
  #define PAF(k) __builtin_bit_cast(bf16x8,pw##k)
  #define VFR(i) (bf16x8){vlo[i][0],vlo[i][1],vlo[i][2],vlo[i][3],vhi[i][0],vhi[i][1],vhi[i][2],vhi[i][3]}
  #define PIN(x) asm volatile("":"+v"(x))
  #define MX3(a,b,c) __builtin_fmaxf(__builtin_fmaxf((a),(b)),(c))
  #define GAPA(MF,A0,A1,A2,A3,W0,W1,PW) do{ MF; sacc+=A0; sacc+=A1; sacc+=A2; sacc+=A3; PIN(sacc); W0; W1; PIN(PW); SBAR(); }while(0)
  #define EX(v) __builtin_amdgcn_exp2f(v)
  #define GAPB(MF,X,B) do{ MF; X[B]=EX(X[B]); X[B+1]=EX(X[B+1]); X[B+2]=EX(X[B+2]); X[B+3]=EX(X[B+3]); PIN(X); SBAR(); }while(0)
  #define VRD(i) do{ vlo[i]=vtr(vp_+(((i)>>2)*4096+((i)&3)*1024)); vhi[i]=vtr(vp_+(((i)>>2)*4096+((i)&3)*1024+512)); }while(0)
  #define KRD(G,j) do{ if(G){ kload2(kf,kp0+sl_next,j); SBAR(); } }while(0)
  #define STEP(C0,C1,P0,P1,t,GK,GV,GL) do{ SBAR(); \
    const lds_cptr vp_=vp0+sl_prev; \
    VRD(0); SBAR(); float sacc=(P0[0]+P0[1]); \
    GAPA(C0=__builtin_amdgcn_mfma_f32_32x32x16_bf16(kf[0],qr[0],negm,0,0,0), P0[2],P0[3],P0[4],P0[5],     pw0[0]=PKW(P0,0), pw0[1]=PKW(P0,2), pw0); \
    VRD(4); SBAR(); GAPA(C1=__builtin_amdgcn_mfma_f32_32x32x16_bf16(kf[1],qr[0],negm,0,0,0), P0[6],P0[7],P0[8],P0[9],     pw0[2]=PKW(P0,4), pw0[3]=PKW(P0,6), pw0); \
    VRD(1); SBAR(); GAPA(C0=__builtin_amdgcn_mfma_f32_32x32x16_bf16(kf[2],qr[1],C0,0,0,0),   P0[10],P0[11],P0[12],P0[13], pw1[0]=PKW(P0,8), pw1[1]=PKW(P0,10), pw1); \
    VRD(5); SBAR(); GAPA(C1=__builtin_amdgcn_mfma_f32_32x32x16_bf16(kf[3],qr[1],C1,0,0,0),   P0[14],P0[15],P1[0],P1[1],   pw1[2]=PKW(P0,12),pw1[3]=PKW(P0,14), pw1); \
    VRD(2); SBAR(); GAPA(C0=__builtin_amdgcn_mfma_f32_32x32x16_bf16(kf[4],qr[2],C0,0,0,0),   P1[2],P1[3],P1[4],P1[5],     pw2[0]=PKW(P1,0), pw2[1]=PKW(P1,2), pw2); \
    VRD(6); SBAR(); GAPA(C1=__builtin_amdgcn_mfma_f32_32x32x16_bf16(kf[5],qr[2],C1,0,0,0),   P1[6],P1[7],P1[8],P1[9],     pw2[2]=PKW(P1,4), pw2[3]=PKW(P1,6), pw2); \
    VRD(3); SBAR(); GAPA(C0=__builtin_amdgcn_mfma_f32_32x32x16_bf16(kf[6],qr[3],C0,0,0,0),   P1[10],P1[11],P1[12],P1[13], pw3[0]=PKW(P1,8), pw3[1]=PKW(P1,10), pw3); \
    VRD(7); SBAR(); GAPA(C1=__builtin_amdgcn_mfma_f32_32x32x16_bf16(kf[7],qr[3],C1,0,0,0),   P1[14],P1[15],0.f,0.f,       pw3[2]=PKW(P1,12),pw3[3]=PKW(P1,14), pw3); \
    l_reg+=sacc; \
    if(GK){DMA_K((t)+3,sl_cur);} if(GV){DMA_V((t)+1,sl_next);} \
    CMASK(C0,C1,t); \
    { float a=MX3(C0[0],C0[1],C1[0]),b=MX3(C0[2],C0[3],C1[1]); a=MX3(a,C1[2],C1[3]); \
      _Pragma("unroll") for(int r=4;r<16;r+=4){a=MX3(a,C0[r],C0[r+1]);b=MX3(b,C0[r+2],C0[r+3]);a=MX3(a,C1[r],C1[r+1]);b=MX3(b,C1[r+2],C1[r+3]);} \
      float rm=__builtin_fmaxf(a,b); { auto rr=__builtin_amdgcn_permlane32_swap(__float_as_uint(rm),__float_as_uint(rm),false,false); rm=__builtin_fmaxf(__uint_as_float(rr[0]),__uint_as_float(rr[1])); } \
      resc=false; \
      if(__builtin_expect(__any(rm>(float)THRL),0)){ const float dl=__builtin_fmaxf(rm,0.f); mhat+=dl; \
        _Pragma("unroll") for(int r=0;r<16;++r){C0[r]-=dl;C1[r]-=dl;} \
        _Pragma("unroll") for(int r=0;r<16;++r)negm[r]=-mhat; asm volatile("":"+v"(negm)); \
        const float f=__builtin_amdgcn_exp2f(-dl); l_reg*=f; if(hi==0)wsf[r32]=f; resc=true; } } \
    SBAR(); \
    GAPB(o[0]=__builtin_amdgcn_mfma_f32_32x32x16_bf16(PAF(0),VFR(0),o[0],0,0,0), C0,0); \
    GAPB(o[1]=__builtin_amdgcn_mfma_f32_32x32x16_bf16(PAF(0),VFR(4),o[1],0,0,0), C0,4); \
    KRD(GL,0); GAPB(o[0]=__builtin_amdgcn_mfma_f32_32x32x16_bf16(PAF(1),VFR(1),o[0],0,0,0), C0,8); \
    KRD(GL,1); GAPB(o[1]=__builtin_amdgcn_mfma_f32_32x32x16_bf16(PAF(1),VFR(5),o[1],0,0,0), C0,12); \
    KRD(GL,2); GAPB(o[0]=__builtin_amdgcn_mfma_f32_32x32x16_bf16(PAF(2),VFR(2),o[0],0,0,0), C1,0); \
    KRD(GL,3); GAPB(o[1]=__builtin_amdgcn_mfma_f32_32x32x16_bf16(PAF(2),VFR(6),o[1],0,0,0), C1,4); \
    GAPB(o[0]=__builtin_amdgcn_mfma_f32_32x32x16_bf16(PAF(3),VFR(3),o[0],0,0,0), C1,8); \
    GAPB(o[1]=__builtin_amdgcn_mfma_f32_32x32x16_bf16(PAF(3),VFR(7),o[1],0,0,0), C1,12); \
    }while(0)
  int t=1;
  #undef CMASK
  #define CMASK(P0,P1,t) do{}while(0)
  for(;t+5<NT;t+=2){
    STEP(pB0,pB1,pA0,pA1,t,true,true,true);     WAIT_BAR(2); RESC(); ROT();
    STEP(pA0,pA1,pB0,pB1,t+1,true,true,true);   WAIT_BAR(2); RESC(); ROT();
  }
  #undef CMASK
  #define CMASK(P0,P1,t) do{int jb_=(t)-(NT-4); if(jb_>=0)cmask(P0,P1,jb_,qrel,hi);}while(0)
  #define ENDW(tt) do{ if((tt)+3<NT){WAIT_BAR(2);} else if((tt)+2<NT){WAIT_BAR(1);} else {WAIT_BAR(0);} }while(0)
  for(;t+1<NT;t+=2){
    STEP(pB0,pB1,pA0,pA1,t,(t+3<NT),(t+1<NT),(t+1<NT));       ENDW(t);   RESC(); ROT();
    STEP(pA0,pA1,pB0,pB1,t+1,(t+4<NT),(t+2<NT),(t+2<NT));     ENDW(t+1); RESC(); ROT();
  }
  STEP(pB0,pB1,pA0,pA1,NT-1,false,false,false); RESC();
  { float sacc=pB0[0]+pB0[1]; _Pragma("unroll") for(int r=2;r<16;++r)sacc+=pB0[r]; _Pragma("unroll") for(int r=0;r<16;++r)sacc+=pB1[r]; l_reg+=sacc;
    pw0=(u32x4){PKW(pB0,0),PKW(pB0,2),PKW(pB0,4),PKW(pB0,6)};pw1=(u32x4){PKW(pB0,8),PKW(pB0,10),PKW(pB0,12),PKW(pB0,14)};pw2=(u32x4){PKW(pB1,0),PKW(pB1,2),PKW(pB1,4),PKW(pB1,6)};pw3=(u32x4){PKW(pB1,8),PKW(pB1,10),PKW(pB1,12),PKW(pB1,14)};
    SBAR(); pv(o,vb0+sl_cur,PAF(0),PAF(1),PAF(2),PAF(3)); }
  #undef PKW
  #undef PAF
  #undef VFR
  #undef PIN
  #undef MX3
  #undef GAPA
  #undef GAPB
  #undef EX
  #undef VRD
  #undef KRD
  #undef STEP
  #undef ENDW
  {auto rr=__builtin_amdgcn_permlane32_swap(__float_as_uint(l_reg),__float_as_uint(l_reg),false,false);l_reg=__uint_as_float(rr[0])+__uint_as_float(rr[1]);}
  if(hi==0)wsf[32+r32]=l_reg;asm volatile("s_waitcnt lgkmcnt(0)":::"memory");
  float rli[16];
  #pragma unroll
  for(int r=0;r<16;++r)rli[r]=__builtin_amdgcn_rcpf(wsf[32+crow(r,hi)]);
  bf16*Ow=O+(rowbase+q0+wid*QBLK)*PO;
  { bf16*stg=(bf16*)(shm+LDS_OST)+wid*2048;
    #pragma unroll
    for(int r=0;r<16;++r){const int orow=crow(r,hi);
      #pragma unroll
      for(int d0=0;d0<2;++d0)stg[orow*64+d0*32+r32]=__float2bfloat16(o[d0][r]*rli[r]);}
    asm volatile("s_waitcnt lgkmcnt(0)":::"memory");
    #pragma unroll
    for(int i=0;i<4;++i){const int row=i*8+(lane>>3),ch=lane&7; const u32x4 v=*(const u32x4*)(stg+row*64+ch*8); ATTN_STORE16(Ow+(long)row*PO+ch*8,v);} }
  asm volatile("s_waitcnt lgkmcnt(0)\n\ts_barrier":::"memory");
  #undef DMA_K
  #undef DMA_V
  #undef CMASK
  #undef START
  #undef RESC
  #undef ROT
}
constexpr int ATTN_LDS_BYTES=LDS_BYTES;
#undef SBAR
#undef WAIT_BAR
}
namespace attn_body {
#define SBAR() __builtin_amdgcn_sched_barrier(0)
#define WAIT_BAR(N) asm volatile("s_waitcnt vmcnt(" #N ") lgkmcnt(0)\n\ts_barrier":::"memory")
constexpr int VSLOTB=16384, LDS2_V=NSLOT*SLOTB, LDS2_WS=LDS2_V+NSLOT*VSLOTB, LDS2_OST=LDS2_WS+NW*64*4, LDS2_BYTES=LDS2_OST+NW*4096;
template<int THRL> __device__ __forceinline__ void attn_unit2(int b,int qb,const bf16*Q,const bf16*__restrict__ K,const bf16*__restrict__ V,bf16*O,char*shm,int tid_in){
  int tid_=tid_in; asm volatile("":"+v"(tid_));
  const int tid=tid_,lane=tid&63,r32=lane&31,hi=lane>>5; const int wid=__builtin_amdgcn_readfirstlane(tid>>6);
  const long rowbase=(long)b*SEQ; const int q0=qb*QB;
  const bf16*Qw=Q+(rowbase+q0+wid*QBLK)*PQ;
  const bf16*Kh=K+rowbase*PQ,*Vh=V+rowbase*PQ;
  const unsigned lds0=(unsigned)(uintptr_t)shm;
  float*wsf=(float*)(shm+LDS2_WS)+wid*64;
  const bf16*ksrc=Kh+(long)lane*PQ+wid*8;
  const bf16*vsrc=Vh+(long)(16*(wid&3)+(lane>>2))*PQ+(wid>>2)*32+(lane&3)*8;
  const unsigned kdst=lds0+LDS_K+wid*1024, vdst=lds0+LDS2_V+wid*1024;
  #define DMA_K(t,slot) glds16(ksrc+(long)(t)*KVBLK*PQ,(unsigned)__builtin_amdgcn_readfirstlane(kdst+(slot)))
  #define DMA_V(t,slot) do{ glds16(vsrc+(long)(t)*KVBLK*PQ,(unsigned)__builtin_amdgcn_readfirstlane(vdst+2*(slot))); glds16(vsrc+(long)(t)*KVBLK*PQ+64,(unsigned)__builtin_amdgcn_readfirstlane(vdst+2*(slot)+8192)); }while(0)
  const char*Kbase=shm+LDS_K; bf16x8 kfa[4],kfb[4];
  const lds_cptr shm3=(lds_cptr)shm; const lds_cptr kp0=shm3+LDS_K+hi*1024+r32*16; const lds_cptr vp0=shm3+LDS2_V+((lane>>4)&1)*32+(lane&3)*8+(4*hi+((lane&15)>>2))*64;
  const int NT=(q0+QB)/KVBLK;
  DMA_K(0,0);DMA_V(0,0);DMA_K(1,SLOTB);
  bf16x8 qr[4];
  #pragma unroll
  for(int d0=0;d0<4;++d0)qr[d0]=*reinterpret_cast<const bf16x8*>(&Qw[(long)r32*PQ+d0*16+hi*8]);
  float mhat=0.f,l_reg=0.f;f32x16 o[4];o[0]=f32x16{};o[1]=f32x16{};o[2]=f32x16{};o[3]=f32x16{};const f32x16 zero16=f32x16{};
  const int qrel=wid*QBLK+r32;
  #define CMASK(P0,P1,t) do{int jb_=(t)-(NT-4); if(jb_>=0)cmask(P0,P1,jb_,qrel,hi);}while(0)
  bool resc=false;
  #define RESC() do{ if(resc){ asm volatile("s_waitcnt lgkmcnt(0)":::"memory"); \
      _Pragma("unroll") for(int d_=0;d_<4;++d_) _Pragma("unroll") for(int r=0;r<16;++r)o[d_][r]*=wsf[crow(r,hi)]; } }while(0)
  f32x16 c0,c1;
  u32x4 pa0,pa1,pa2,pa3,pn0,pn1,pn2,pn3;
  int sl_prev=0,sl_cur=0,sl_next=SLOTB;
  #define ROT() do{sl_prev=sl_cur;sl_cur=sl_next;sl_next=(sl_next==(NSLOT-1)*SLOTB)?0:sl_next+SLOTB;}while(0)
  #define PKW(P,B) cvtpk_s(P[B],P[B+1])
  DMA_K(2,2*SLOTB);
  WAIT_BAR(4);
  qkt(c0,c1,Kbase,qr,zero16,r32,hi);asm volatile("s_nop 15\n\ts_nop 7":"+v"(c0),"+v"(c1));CMASK(c0,c1,0);
  { const float rm=rowmax(c0,c1); mhat=rm;
    _Pragma("unroll") for(int r=0;r<16;++r){c0[r]=__builtin_amdgcn_exp2f(c0[r]-rm);c1[r]=__builtin_amdgcn_exp2f(c1[r]-rm);}
    float sacc=c0[0]+c0[1]; _Pragma("unroll") for(int r=2;r<16;++r)sacc+=c0[r]; _Pragma("unroll") for(int r=0;r<16;++r)sacc+=c1[r]; l_reg=sacc;
    pa0=(u32x4){PKW(c0,0),PKW(c0,2),PKW(c0,4),PKW(c0,6)};pa1=(u32x4){PKW(c0,8),PKW(c0,10),PKW(c0,12),PKW(c0,14)};pa2=(u32x4){PKW(c1,0),PKW(c1,2),PKW(c1,4),PKW(c1,6)};pa3=(u32x4){PKW(c1,8),PKW(c1,10),PKW(c1,12),PKW(c1,14)}; }
  WAIT_BAR(0);
  DMA_V(1,SLOTB);
  ROT();
  kfa[0]=*(const __attribute__((address_space(3))) bf16x8*)(kp0+sl_cur);      kfa[1]=*(const __attribute__((address_space(3))) bf16x8*)(kp0+sl_cur+512);
  kfa[2]=*(const __attribute__((address_space(3))) bf16x8*)(kp0+sl_cur+2048); kfa[3]=*(const __attribute__((address_space(3))) bf16x8*)(kp0+sl_cur+2560);
  WAIT_BAR(2);
  s16x4 vlo[8],vhi[8];
  #define VFR(i) (bf16x8){vlo[i][0],vlo[i][1],vlo[i][2],vlo[i][3],vhi[i][0],vhi[i][1],vhi[i][2],vhi[i][3]}
  #define PIN(x) asm volatile("":"+v"(x))
  #define MX3(a,b,c) __builtin_fmaxf(__builtin_fmaxf((a),(b)),(c))
  #define EX(v) __builtin_amdgcn_exp2f(v)
  #define GAPA(MF) do{ MF; SBAR(); }while(0)
  #define GAPB(MF,X,B,i) do{ MF; VRD2(i); X[B]=EX(X[B]); X[B+1]=EX(X[B+1]); X[B+2]=EX(X[B+2]); X[B+3]=EX(X[B+3]); PIN(X); SBAR(); }while(0)
  #define GAPC(MF,A0,A1,A2,A3,W0,W1,PW) do{ MF; sacc+=A0; sacc+=A1; sacc+=A2; sacc+=A3; PIN(sacc); W0; W1; PIN(PW); SBAR(); }while(0)
  #define VRD(i) do{ vlo[i]=vtr(vp_+(((i)>>2)*4096+((i)&3)*1024)); vhi[i]=vtr(vp_+(((i)>>2)*4096+((i)&3)*1024+512)); }while(0)
  #define VRD2(i) do{ vlo[i]=vtr(vp_+(8192+((i)>>2)*4096+((i)&3)*1024)); vhi[i]=vtr(vp_+(8192+((i)>>2)*4096+((i)&3)*1024+512)); }while(0)
  #define KRD(G,j) do{ if(G){ kfa[2*(j)]=*(const __attribute__((address_space(3))) bf16x8*)(kp0+sl_next+(j)*2048); kfa[2*(j)+1]=*(const __attribute__((address_space(3))) bf16x8*)(kp0+sl_next+(j)*2048+512); SBAR(); } }while(0)
  #define MFMA32(a,b,c) __builtin_amdgcn_mfma_f32_32x32x16_bf16(a,b,c,0,0,0)
  #define PF(x) __builtin_bit_cast(bf16x8,x)
  #define STEP(A0,A1,A2,A3,N0,N1,N2,N3,t,GK,GV,GL) do{ SBAR(); \
    if(GK){DMA_K((t)+2,sl_prev);} \
    const lds_cptr vp_=vp0+2*sl_prev; \
    kfb[0]=*(const __attribute__((address_space(3))) bf16x8*)(kp0+sl_cur+4096); kfb[1]=*(const __attribute__((address_space(3))) bf16x8*)(kp0+sl_cur+4608); \
    kfb[2]=*(const __attribute__((address_space(3))) bf16x8*)(kp0+sl_cur+6144); kfb[3]=*(const __attribute__((address_space(3))) bf16x8*)(kp0+sl_cur+6656); SBAR(); \
    VRD(0); SBAR(); GAPA(c0=MFMA32(kfa[0],qr[0],zero16)); \
    VRD(4); SBAR(); GAPA(c1=MFMA32(kfa[1],qr[0],zero16)); \
    VRD(1); SBAR(); GAPA(c0=MFMA32(kfa[2],qr[1],c0)); \
    VRD(5); SBAR(); GAPA(c1=MFMA32(kfa[3],qr[1],c1)); \
    VRD(2); SBAR(); GAPA(c0=MFMA32(kfb[0],qr[2],c0)); \
    VRD(6); SBAR(); GAPA(c1=MFMA32(kfb[1],qr[2],c1)); \
    VRD(3); SBAR(); GAPA(c0=MFMA32(kfb[2],qr[3],c0)); \
    VRD(7); SBAR(); GAPA(c1=MFMA32(kfb[3],qr[3],c1)); \
    if(GV){DMA_V((t)+1,sl_next);} \
    _Pragma("unroll") for(int r=0;r<16;++r){c0[r]-=mhat;c1[r]-=mhat;} \
    CMASK(c0,c1,t); \
    { float a=MX3(c0[0],c0[1],c1[0]),bq=MX3(c0[2],c0[3],c1[1]); a=MX3(a,c1[2],c1[3]); \
      _Pragma("unroll") for(int r=4;r<16;r+=4){a=MX3(a,c0[r],c0[r+1]);bq=MX3(bq,c0[r+2],c0[r+3]);a=MX3(a,c1[r],c1[r+1]);bq=MX3(bq,c1[r+2],c1[r+3]);} \
      float rm=__builtin_fmaxf(a,bq); { auto rr=__builtin_amdgcn_permlane32_swap(__float_as_uint(rm),__float_as_uint(rm),false,false); rm=__builtin_fmaxf(__uint_as_float(rr[0]),__uint_as_float(rr[1])); } \
      resc=false; \
      if(__builtin_expect(__any(rm>(float)THRL),0)){ const float dl=__builtin_fmaxf(rm,0.f); mhat+=dl; \
        _Pragma("unroll") for(int r=0;r<16;++r){c0[r]-=dl;c1[r]-=dl;} \
        const float f=__builtin_amdgcn_exp2f(-dl); l_reg*=f; if(hi==0)wsf[r32]=f; resc=true; } } \
    SBAR(); \
    GAPB(o[0]=MFMA32(PF(A0),VFR(0),o[0]), c0,0, 0); \
    GAPB(o[1]=MFMA32(PF(A0),VFR(4),o[1]), c0,4, 4); \
    KRD(GL,0); GAPB(o[0]=MFMA32(PF(A1),VFR(1),o[0]), c0,8, 1); \
    KRD(GL,1); GAPB(o[1]=MFMA32(PF(A1),VFR(5),o[1]), c0,12, 5); \
    GAPB(o[0]=MFMA32(PF(A2),VFR(2),o[0]), c1,0, 2); \
    GAPB(o[1]=MFMA32(PF(A2),VFR(6),o[1]), c1,4, 6); \
    GAPB(o[0]=MFMA32(PF(A3),VFR(3),o[0]), c1,8, 3); \
    GAPB(o[1]=MFMA32(PF(A3),VFR(7),o[1]), c1,12, 7); \
    float sacc=(c0[0]+c0[1]); \
    GAPC(o[2]=MFMA32(PF(A0),VFR(0),o[2]), c0[2],c0[3],c0[4],c0[5],     N0[0]=PKW(c0,0), N0[1]=PKW(c0,2), N0); \
    GAPC(o[3]=MFMA32(PF(A0),VFR(4),o[3]), c0[6],c0[7],c0[8],c0[9],     N0[2]=PKW(c0,4), N0[3]=PKW(c0,6), N0); \
    GAPC(o[2]=MFMA32(PF(A1),VFR(1),o[2]), c0[10],c0[11],c0[12],c0[13], N1[0]=PKW(c0,8), N1[1]=PKW(c0,10), N1); \
    GAPC(o[3]=MFMA32(PF(A1),VFR(5),o[3]), c0[14],c0[15],c1[0],c1[1],   N1[2]=PKW(c0,12),N1[3]=PKW(c0,14), N1); \
    GAPC(o[2]=MFMA32(PF(A2),VFR(2),o[2]), c1[2],c1[3],c1[4],c1[5],     N2[0]=PKW(c1,0), N2[1]=PKW(c1,2), N2); \
    GAPC(o[3]=MFMA32(PF(A2),VFR(6),o[3]), c1[6],c1[7],c1[8],c1[9],     N2[2]=PKW(c1,4), N2[3]=PKW(c1,6), N2); \
    GAPC(o[2]=MFMA32(PF(A3),VFR(3),o[2]), c1[10],c1[11],c1[12],c1[13], N3[0]=PKW(c1,8), N3[1]=PKW(c1,10), N3); \
    GAPC(o[3]=MFMA32(PF(A3),VFR(7),o[3]), c1[14],c1[15],0.f,0.f,       N3[2]=PKW(c1,12),N3[3]=PKW(c1,14), N3); \
    l_reg+=sacc; \
    }while(0)
  int t=1;
  #undef CMASK
  #define CMASK(P0,P1,t) do{}while(0)
  for(;t+5<NT;t+=2){
    STEP(pa0,pa1,pa2,pa3,pn0,pn1,pn2,pn3,t,true,true,true);     WAIT_BAR(2); RESC(); ROT();
    STEP(pn0,pn1,pn2,pn3,pa0,pa1,pa2,pa3,t+1,true,true,true);   WAIT_BAR(2); RESC(); ROT();
  }
  #undef CMASK
  #define CMASK(P0,P1,t) do{int jb_=(t)-(NT-4); if(jb_>=0)cmask(P0,P1,jb_,qrel,hi);}while(0)
  #define ENDW(tt) do{ if((tt)+2<NT){WAIT_BAR(2);} else {WAIT_BAR(0);} }while(0)
  for(;t+1<NT;t+=2){
    STEP(pa0,pa1,pa2,pa3,pn0,pn1,pn2,pn3,t,(t+2<NT),(t+1<NT),(t+1<NT));       ENDW(t);   RESC(); ROT();
    STEP(pn0,pn1,pn2,pn3,pa0,pa1,pa2,pa3,t+1,(t+3<NT),(t+2<NT),(t+2<NT));     ENDW(t+1); RESC(); ROT();
  }
  STEP(pa0,pa1,pa2,pa3,pn0,pn1,pn2,pn3,NT-1,false,false,false); RESC();
  { SBAR(); int ln2_=tid_in&63; asm volatile("":"+v"(ln2_));
    const int vb0=(int)(lds0+LDS2_V)+((ln2_>>4)&1)*32+(ln2_&3)*8+(4*(ln2_>>5)+((ln2_&15)>>2))*64;
    pv(o,vb0+2*sl_cur,PF(pn0),PF(pn1),PF(pn2),PF(pn3)); pv(o+2,vb0+2*sl_cur+8192,PF(pn0),PF(pn1),PF(pn2),PF(pn3)); }
  #undef PKW
  #undef PF
  #undef MFMA32
  #undef VFR
  #undef PIN
  #undef MX3
  #undef GAPA
  #undef GAPB
  #undef GAPC
  #undef EX
  #undef VRD
  #undef VRD2
  #undef KRD
  #undef STEP
  #undef ENDW
  {auto rr=__builtin_amdgcn_permlane32_swap(__float_as_uint(l_reg),__float_as_uint(l_reg),false,false);l_reg=__uint_as_float(rr[0])+__uint_as_float(rr[1]);}
  int ln3_=tid_in&63; asm volatile("":"+v"(ln3_)); const int e_r32=ln3_&31,e_hi=ln3_>>5;
  float*wsf2=(float*)(shm+LDS2_WS)+wid*64;
  if(e_hi==0)wsf2[32+e_r32]=l_reg;asm volatile("s_waitcnt lgkmcnt(0)":::"memory");
  float rli[16];
  #pragma unroll
  for(int r=0;r<16;++r)rli[r]=__builtin_amdgcn_rcpf(wsf2[32+crow(r,e_hi)]);
  bf16*Ow=O+((long)b*SEQ+qb*QB+wid*QBLK)*PO;
  { bf16*stg=(bf16*)(shm+LDS2_OST)+wid*2048;
    #pragma unroll
    for(int ps=0;ps<2;++ps){
      #pragma unroll
      for(int r=0;r<16;++r){const int orow=crow(r,e_hi);
        #pragma unroll
        for(int d0=0;d0<2;++d0)stg[orow*64+d0*32+e_r32]=__float2bfloat16(o[2*ps+d0][r]*rli[r]);}
      asm volatile("s_waitcnt lgkmcnt(0)":::"memory");
      #pragma unroll
      for(int i=0;i<4;++i){const int row=i*8+(ln3_>>3),ch=ln3_&7; const u32x4 v=*(const u32x4*)(stg+row*64+ch*8); ATTN_STORE16(Ow+(long)row*PO+ps*64+ch*8,v);}
      asm volatile("s_waitcnt lgkmcnt(0)":::"memory"); } }
  asm volatile("s_waitcnt lgkmcnt(0)\n\ts_barrier":::"memory");
  #undef DMA_K
  #undef DMA_V
  #undef CMASK
  #undef RESC
  #undef ROT
}
#undef SBAR
#undef WAIT_BAR
}
#ifndef MK_MULTI
#define MK_MULTI 0
#endif
constexpr int NB = 8, SEQ = 2048, T = NB * SEQ, DM = 2048, INW = 4608, DEPTH = 2;
constexpr int CONV_CH = 512, CONV_W = 31;
constexpr int NEXP = 64, FF = 512;
constexpr int C_QS = 1024, C_KS = 1792, C_VS = 2048, C_QD = 2304, C_KD = 3072, C_VD = 3840;
constexpr int MAXTILES = 192, PROWS = MAXTILES * 256;
constexpr int NPHASE = 1 + 10 * DEPTH;
constexpr int CONV_TAIL = 128 * 12, CONV_OUT = 256 * 5;
constexpr float LOG2E = 1.4426950408889634f;
constexpr float QSCALE = 0.125f * LOG2E;
constexpr float RMS_EPS = 1e-6f, LN_EPS = 1e-5f;
constexpr float SA1 = 8.f, SW1 = 64.f, SA2 = 8.f, SW2 = 32.f, SY = 16.f;

constexpr size_t MiB = 1u << 20;
constexpr size_t WS_CTL = 0, CTL_ZERO_BYTES = 1 * MiB;
constexpr size_t WS_ROPEC = 2 * MiB, WS_ROPES = 4 * MiB;
constexpr size_t WS_RW = 6 * MiB;
constexpr size_t WS_WIN = 8 * MiB;
constexpr size_t WS_WOUT = 44 * MiB;
constexpr size_t WS_PW = 60 * MiB;
constexpr size_t WS_W13 = 64 * MiB;
constexpr size_t WS_W2 = 576 * MiB;
constexpr size_t WS_XN = 832 * MiB;
constexpr size_t WS_PROJ = 896 * MiB;
constexpr size_t WS_ZC = 1040 * MiB;
constexpr size_t WS_YCONV = 1056 * MiB;
constexpr size_t WS_YSWA = 1072 * MiB;
constexpr size_t WS_ODIFF = 1096 * MiB;
constexpr size_t WS_MIX = 1144 * MiB;
constexpr size_t WS_X = 1208 * MiB;
constexpr size_t WS_Z = 1336 * MiB;
constexpr size_t WS_ROWSS = 1368 * MiB;
constexpr size_t WS_ACT = 1528 * MiB;
constexpr size_t WS_YS = 1576 * MiB;
constexpr size_t WS_ROUTE = 1704 * MiB;
constexpr size_t RT_TOKE = 0, RT_TOKP = 128 * 1024, RT_GATE = 256 * 1024, RT_SLOT = 384 * 1024, RT_HIST = 640 * 1024;
constexpr size_t WS_END = 1706 * MiB;
constexpr int CW_ZC = 16384;
constexpr int CW_BAR = 4096;

constexpr int RING_OFF = 0, RING_BYTES = 131072;
constexpr int LCTL_OFF = RING_BYTES;
constexpr int TAB_OFF = LCTL_OFF + 512;
constexpr int TAB_PART = TAB_OFF + 2048;
constexpr int GOFS_OFF = TAB_PART + 4096;
constexpr int LDS_BYTES = 147456;
static_assert(GOFS_OFF + 3072 <= LDS_BYTES, "LDS map");

#define GAS __attribute__((address_space(1)))
#define LAS __attribute__((address_space(3)))
typedef unsigned short bf16;
typedef unsigned v4u __attribute__((ext_vector_type(4)));
typedef unsigned v2u __attribute__((ext_vector_type(2)));
typedef float f32x4 __attribute__((ext_vector_type(4)));
typedef short bf16x8 __attribute__((ext_vector_type(8)));
#define LDS_WAIT() asm volatile("s_waitcnt lgkmcnt(0)" ::: "memory")
#define VM_WAIT() asm volatile("s_waitcnt vmcnt(0)" ::: "memory")
typedef float f32x2_m __attribute__((ext_vector_type(2))); typedef __bf16 bf16x2_m __attribute__((ext_vector_type(2)));
__device__ __forceinline__ unsigned pk2(float lo, float hi) { f32x2_m v = {lo, hi}; bf16x2_m b = __builtin_convertvector(v, bf16x2_m); return __builtin_bit_cast(unsigned, b); }
__device__ __forceinline__ float bflo(unsigned w) { return __uint_as_float(w << 16); }
__device__ __forceinline__ float bfhi(unsigned w) { return __uint_as_float(w & 0xffff0000u); }
__device__ __forceinline__ float wave_sum(float v) {
#pragma unroll
    for (int o = 1; o < 64; o <<= 1) v += __shfl_xor(v, o);
    return v;
}
__device__ __forceinline__ float sigmoid_f(float x) { return __builtin_amdgcn_rcpf(1.0f + __builtin_amdgcn_exp2f(-LOG2E * x)); }

#define XB_TMO      128
#define XB_XCNT(j)  (256  + 64 * (j))
#define XB_XSUB(j)  (1280 + 64 * (j))
#define XB_XGEN(j)  (2304 + 64 * (j))
#define XB_TOP      3328
#define XB_TOPGEN   3392
#define XCD_BAR_WORDS 3456
#define XB_SPIN_CAP (1u << 18)

__device__ __forceinline__ unsigned xb_ld(unsigned* p)              { return __hip_atomic_load(p, __ATOMIC_RELAXED, __HIP_MEMORY_SCOPE_AGENT); }
__device__ __forceinline__ unsigned xb_add(unsigned* p, unsigned v) { return __hip_atomic_fetch_add(p, v, __ATOMIC_RELAXED, __HIP_MEMORY_SCOPE_AGENT); }
__device__ __forceinline__ unsigned xb_xcc_id() { return (unsigned)__builtin_amdgcn_s_getreg((3 << 11) | 20) & 0xFu; }
#define XB_SPIN(cond, bar) do { unsigned _sp = 0; while (cond) { __builtin_amdgcn_s_sleep(1); \
    if ((++_sp & 255u) == 0u) { if (xb_ld(&(bar)[XB_TMO])) break; if (_sp > XB_SPIN_CAP) { atomicAdd(&(bar)[XB_TMO], 1u); break; } } } } while (0)

struct XcdBarrier {
    unsigned* bar; unsigned x;
    volatile LAS unsigned* st;
};

__device__ __forceinline__ XcdBarrier xcd_barrier_post(unsigned* bar, volatile LAS unsigned* st) {
    XcdBarrier b; b.bar = bar; b.x = xb_xcc_id(); b.st = st;
    if (threadIdx.x == 0) (void)xb_add(&bar[XB_XCNT(b.x)], 1u);
    return b;
}
__device__ __forceinline__ void xcd_barrier_complete(unsigned* bar, unsigned x, unsigned& nloc, unsigned& nx) {
    const unsigned G = gridDim.x * gridDim.y * gridDim.z;
    unsigned sum, cnt, mine, sp = 0u;
    for (;;) {
        sum = 0u; cnt = 0u; mine = 0u;
#pragma unroll
        for (unsigned j = 0; j < 16; ++j) { const unsigned c = xb_ld(&bar[XB_XCNT(j)]); sum += c; cnt += (c > 0u) ? 1u : 0u; mine = (j == x) ? c : mine; }
        if (sum == G) break;
        __builtin_amdgcn_s_sleep(1);
        if ((++sp & 255u) == 0u) { if (xb_ld(&bar[XB_TMO])) break; if (sp > XB_SPIN_CAP) { atomicAdd(&bar[XB_TMO], 1u); break; } }
    }
    nloc = mine > 0u ? mine : 1u; nx = cnt > 0u ? cnt : 1u;
}

__device__ __forceinline__ void xcd_barrier(const XcdBarrier& b) {
    asm volatile("s_waitcnt vmcnt(0)" ::: "memory");
    __syncthreads();
    if (threadIdx.x == 0) {
        unsigned* bar = b.bar;
        __builtin_amdgcn_s_waitcnt(0);
        unsigned nloc = b.st[0], nx = b.st[1];
        if (nloc == 0u) { xcd_barrier_complete(bar, b.x, nloc, nx); b.st[0] = nloc; b.st[1] = nx; }
        const unsigned old = xb_add(&bar[XB_XSUB(b.x)], 1u);
        const unsigned gen = old / nloc;
        if (old + 1u == (gen + 1u) * nloc) {
            __builtin_amdgcn_fence(__ATOMIC_RELEASE, "agent");
            asm volatile("s_waitcnt vmcnt(0)" ::: "memory");
            const unsigned og = xb_add(&bar[XB_TOP], 1u);
            const unsigned tg = og / nx;
            if (og + 1u == (tg + 1u) * nx) xb_add(&bar[XB_TOPGEN], 1u);
            else XB_SPIN(xb_ld(&bar[XB_TOPGEN]) == tg, bar);
            __builtin_amdgcn_fence(__ATOMIC_ACQUIRE, "agent");
            xb_add(&bar[XB_XGEN(b.x)], 1u);
            asm volatile("s_waitcnt vmcnt(0)" ::: "memory");
        } else {
            XB_SPIN(xb_ld(&bar[XB_XGEN(b.x)]) == gen, bar);
            __builtin_amdgcn_fence(__ATOMIC_ACQUIRE, "agent");
            asm volatile("s_waitcnt vmcnt(0)" ::: "memory");
        }
    }
    __syncthreads();
}
constexpr int GRID = 256;
struct Ctx { LAS unsigned char* lds; int tid, lane, wave, blk, vcu, gw, gtid; static constexpr int G = GRID, NGW = GRID * 8, NT = GRID * 512; };

__device__ __forceinline__ int win_drow(int col) {
    if (col < 1024) { const int half = col >> 9, r = col & 511; return 256 * (r >> 7) + 128 * half + (r & 127); }
    if ((col >= C_VS && col < C_QD) || col >= C_VD) return col;
    const int d = col & 63; return (col & ~63) + 8 * ((d & 31) >> 2) + 4 * (d >> 5) + (d & 3);
}
__device__ __forceinline__ void sincos_d(double a, float& sn, float& cs) {
    const double q = __builtin_rint(a * 0.63661977236758134308);
    double r = __builtin_fma(-q, 1.57079632679489655800e+00, a); r = __builtin_fma(-q, 6.12323399573676603587e-17, r);
    const double r2 = r * r;
    double s = -7.6471637318198164759e-13; s = s * r2 + 1.6059043836821614599e-10; s = s * r2 - 2.5052108385441718775e-08; s = s * r2 + 2.7557319223985890653e-06; s = s * r2 - 1.9841269841269841270e-04;
    s = s * r2 + 8.3333333333333333333e-03; s = s * r2 - 1.6666666666666666667e-01; s = r + r * r2 * s;
    double c = 4.7794773323873852974e-14; c = c * r2 - 1.1470745597729724714e-11; c = c * r2 + 2.0876756987868098979e-09; c = c * r2 - 2.7557319223985890653e-07; c = c * r2 + 2.4801587301587301587e-05;
    c = c * r2 - 1.3888888888888888889e-03; c = c * r2 + 4.1666666666666666667e-02; c = c * r2 - 0.5; c = 1.0 + r2 * c;
    const int qi = (int)((long long)q & 3);
    const double ss = (qi & 1) ? c : s, cc = (qi & 1) ? s : c;
    sn = (float)((qi & 2) ? -ss : ss); cs = (float)(((qi + 1) & 2) ? -cc : cc);
}
__device__ __forceinline__ unsigned pk4_fp8m(float a, float b, float c, float d) {
    a = __builtin_fminf(__builtin_fmaxf(a, -448.f), 448.f); b = __builtin_fminf(__builtin_fmaxf(b, -448.f), 448.f); c = __builtin_fminf(__builtin_fmaxf(c, -448.f), 448.f); d = __builtin_fminf(__builtin_fmaxf(d, -448.f), 448.f);
    int w = 0; w = __builtin_amdgcn_cvt_pk_fp8_f32(a, b, w, false); w = __builtin_amdgcn_cvt_pk_fp8_f32(c, d, w, true); return (unsigned)w; }
struct P0In { const float *w_in, *w_out, *pw, *w13, *w2, *wg, *we, *ffn_g; const int* pos; };
struct P0Item { const float* src; unsigned char* dst; int N, Kb, n0, drow0, kind; float scale; };
__device__ __forceinline__ P0Item p0_decode(int it, const P0In& I, unsigned char* ws) {
    constexpr int IT_WIN = 32 * 144, IT_WOUT = 32 * 64, IT_PW = 8 * 16, IT_LAYER = IT_WIN + IT_WOUT + IT_PW;
    P0Item t; const int l = it / IT_LAYER; int r = it - l * IT_LAYER; t.scale = 1.0f;
    if (r < IT_WIN) { const int kb = r / 144, nb = r - kb * 144; t.src = I.w_in + (size_t)l * DM * INW + (size_t)(64 * kb) * INW + 32 * nb; t.N = INW; t.dst = ws + WS_WIN + ((size_t)l * INW * DM + 64 * kb) * 2; t.Kb = DM * 2; t.n0 = 32 * nb; t.drow0 = 0; t.kind = 1; return t; }
    r -= IT_WIN;
    if (r < IT_WOUT) { const int kb = r / 64, nb = r & 63; t.src = I.w_out + (size_t)l * DM * DM + (size_t)(64 * kb) * DM + 32 * nb; t.N = DM; t.dst = ws + WS_WOUT + ((size_t)l * DM * DM + 64 * kb) * 2; t.Kb = DM * 2; t.n0 = 32 * nb; t.drow0 = 32 * nb; t.kind = 0; return t; }
    r -= IT_WOUT;
    { const int kb = r / 16, nb = r & 15; t.src = I.pw + (size_t)l * 512 * 512 + (size_t)(64 * kb) * 512 + 32 * nb; t.N = 512; t.dst = ws + WS_PW + ((size_t)l * 512 * 512 + 64 * kb) * 2; t.Kb = 512 * 2; t.n0 = 32 * nb; t.drow0 = 32 * nb; t.kind = 0; return t; }
}
__device__ __forceinline__ void p0_load(const P0Item& t, float (&v)[32], int lane) {
    const float* p = t.src + (size_t)(lane >> 5) * t.N + (lane & 31);
#pragma unroll
    for (int i = 0; i < 32; ++i) v[i] = p[(size_t)(2 * i) * t.N];
}
__device__ __forceinline__ void p0_store(const P0Item& t, const float (&v)[32], LAS float* scr, int lane) {
#pragma unroll
    for (int i = 0; i < 32; ++i) scr[(2 * i + (lane >> 5)) * 33 + (lane & 31)] = v[i] * t.scale;
    LDS_WAIT(); asm volatile("" ::: "memory");
    const int c = lane & 7;
#pragma unroll
    for (int j = 0; j < 4; ++j) { const int n = (lane >> 3) + 8 * j; const LAS float* s = scr + (8 * c) * 33 + n;
        const int row = (t.kind == 1) ? win_drow(t.n0 + n) : t.drow0 + n;
        if (t.kind == 2) { v2u o; o.x = pk4_fp8m(s[0 * 33], s[1 * 33], s[2 * 33], s[3 * 33]); o.y = pk4_fp8m(s[4 * 33], s[5 * 33], s[6 * 33], s[7 * 33]); *(GAS v2u*)(t.dst + (size_t)row * t.Kb + 8 * c) = o; }
        else { v4u o; o.x = pk2(s[0 * 33], s[1 * 33]); o.y = pk2(s[2 * 33], s[3 * 33]); o.z = pk2(s[4 * 33], s[5 * 33]); o.w = pk2(s[6 * 33], s[7 * 33]); *(GAS v4u*)(t.dst + (size_t)row * t.Kb + 16 * c) = o; } }
    LDS_WAIT(); asm volatile("" ::: "memory");
}
struct P0Moe { const float* src; unsigned char* dst; int N, Kb, skip; float scale; };
constexpr int MOE_ITEMS_L = NEXP * 64 + NEXP * 32;
__device__ __forceinline__ P0Moe p0_moe_decode(int it, const P0In& I, unsigned char* ws) {
    P0Moe t; const int l = it / MOE_ITEMS_L; int r = it - l * MOE_ITEMS_L;
    if (r < NEXP * 64) { const int e = r >> 6, q = r & 63, kb = q >> 2, nb = q & 3, drow0 = 512 * (nb & 1) + 128 * (nb >> 1);
        t.src = I.w13 + (size_t)(l * NEXP + e) * DM * 1024 + (size_t)(128 * kb) * 1024 + 256 * nb; t.N = 1024; t.dst = ws + WS_W13 + (size_t)(l * NEXP + e) * 1024 * DM + (size_t)drow0 * DM + 128 * kb; t.Kb = DM; t.skip = 128; t.scale = SW1; return t; }
    r -= NEXP * 64;
    { const int e = r >> 5, q = r & 31, kb = q >> 3, nb = q & 7;
        t.src = I.w2 + (size_t)(l * NEXP + e) * FF * DM + (size_t)(128 * kb) * DM + 256 * nb; t.N = DM; t.dst = ws + WS_W2 + (size_t)(l * NEXP + e) * DM * FF + (size_t)(256 * nb) * FF + 128 * kb; t.Kb = FF; t.skip = 0; t.scale = SW2; return t; }
}
__device__ __forceinline__ void p0_moe_load(const P0Moe& t, f32x4 (&v)[16], int wave, int lane) {
    const float* p = t.src + (size_t)(16 * wave) * t.N + 4 * lane;
#pragma unroll
    for (int r = 0; r < 16; ++r) v[r] = *(const GAS f32x4*)(p + (size_t)r * t.N);
}
__device__ __forceinline__ void p0_moe_store(const P0Moe& t, const f32x4 (&v)[16], LAS unsigned* ob, int tid, int wave, int lane) {
#pragma unroll
    for (int g = 0; g < 4; ++g) { LAS unsigned* o = ob + (4 * lane) * 33 + 4 * wave + g;
        o[0] = pk4_fp8m(v[4 * g].x * t.scale, v[4 * g + 1].x * t.scale, v[4 * g + 2].x * t.scale, v[4 * g + 3].x * t.scale);
        o[33] = pk4_fp8m(v[4 * g].y * t.scale, v[4 * g + 1].y * t.scale, v[4 * g + 2].y * t.scale, v[4 * g + 3].y * t.scale);
        o[66] = pk4_fp8m(v[4 * g].z * t.scale, v[4 * g + 1].z * t.scale, v[4 * g + 2].z * t.scale, v[4 * g + 3].z * t.scale);
        o[99] = pk4_fp8m(v[4 * g].w * t.scale, v[4 * g + 1].w * t.scale, v[4 * g + 2].w * t.scale, v[4 * g + 3].w * t.scale); }
    __syncthreads();
    { const int row = tid >> 1, part = tid & 1; const LAS unsigned* sp = ob + row * 33 + 16 * part;
      v4u o0, o1, o2, o3; o0.x = sp[0]; o0.y = sp[1]; o0.z = sp[2]; o0.w = sp[3]; o1.x = sp[4]; o1.y = sp[5]; o1.z = sp[6]; o1.w = sp[7];
      o2.x = sp[8]; o2.y = sp[9]; o2.z = sp[10]; o2.w = sp[11]; o3.x = sp[12]; o3.y = sp[13]; o3.z = sp[14]; o3.w = sp[15];
      GAS v4u* d = (GAS v4u*)(t.dst + (size_t)(row + (row >= 128 ? t.skip : 0)) * t.Kb + 64 * part); d[0] = o0; d[1] = o1; d[2] = o2; d[3] = o3; }
    __syncthreads();
}
__device__ __forceinline__ void moe_convert(const Ctx& C, const P0In& I, unsigned char* ws, int lo, int hi, int idx, int stride) {
    LAS unsigned* ob = (LAS unsigned*)(C.lds + RING_OFF);
    __syncthreads();
    f32x4 va[16], vb[16]; int it = lo + idx;
#define MC_DEC(i) p0_moe_decode((i) < hi ? (i) : hi - 1, I, ws)
    P0Moe ta = MC_DEC(it), tb = ta;
    p0_moe_load(ta, va, C.wave, C.lane);
#pragma unroll 1
    while (it < hi) {
        tb = MC_DEC(it + stride); p0_moe_load(tb, vb, C.wave, C.lane); p0_moe_store(ta, va, ob, C.tid, C.wave, C.lane);
        if (it + stride >= hi) break;
        ta = MC_DEC(it + 2 * stride); p0_moe_load(ta, va, C.wave, C.lane); p0_moe_store(tb, vb, ob, C.tid, C.wave, C.lane);
        it += 2 * stride; }
#undef MC_DEC
    asm volatile("s_waitcnt vmcnt(0)" ::: "memory");
    __syncthreads();
}
constexpr int WCONV_L = 32 * 144 + 32 * 64 + 8 * 16;
__device__ __forceinline__ void wconv_bf16(const Ctx& C, const P0In& I, unsigned char* ws, int lo, int hi) {
    LAS float* scr = (LAS float*)(C.lds + RING_OFF + C.wave * 16384);
    __syncthreads();
    { float va[32], vb[32]; int it = lo + C.gw; P0Item ta = p0_decode(it < hi ? it : hi - 1, I, ws), tb = ta;
      p0_load(ta, va, C.lane);
#pragma unroll 1
      while (it < hi) {
          const int it1 = it + C.NGW, it2 = it1 + C.NGW;
          tb = p0_decode(it1 < hi ? it1 : hi - 1, I, ws); p0_load(tb, vb, C.lane);
          p0_store(ta, va, scr, C.lane);
          if (it1 >= hi) break;
          ta = p0_decode(it2 < hi ? it2 : hi - 1, I, ws); p0_load(ta, va, C.lane);
          p0_store(tb, vb, scr, C.lane);
          it = it2; } }
    asm volatile("s_waitcnt vmcnt(0)" ::: "memory");
    __syncthreads();
}
__device__ __forceinline__ void p0_prologue(const Ctx& C, const P0In& I, unsigned char* ws) {
    wconv_bf16(C, I, ws, 0, WCONV_L);
    for (int idx = C.gtid; idx < DEPTH * 80 * DM; idx += C.NT) {
        const int l = idx / (80 * DM), rem = idx - l * 80 * DM, k = rem / 80, o = rem - k * 80;
        float v = 0.f;
        if (o < 8) v = I.wg[((size_t)l * DM + k) * 8 + o]; else if (o < 72) v = I.we[((size_t)l * DM + k) * 64 + (o - 8)];
        v *= I.ffn_g[l * DM + k];
        const unsigned h = pk2(v, 0.f) & 0xffffu; const float hf = __uint_as_float(h << 16); const unsigned lo = pk2(v - hf, 0.f) & 0xffffu;
        bf16* rw = (bf16*)(ws + WS_RW) + (size_t)l * 2 * 80 * DM;
        rw[(size_t)o * DM + k] = (bf16)h; rw[(size_t)(80 + o) * DM + k] = (bf16)lo;
    }
    for (int idx = C.gtid; idx < T * 32; idx += C.NT) {
        const int tok = idx >> 5, i = idx & 31;
        const float inv = (float)exp2(-(double)i * (13.287712379549449 / 32.0));
        const float ang = (float)I.pos[tok] * inv;
        float sn, cs; sincos_d((double)ang, sn, cs);
        ((float*)(ws + WS_ROPEC))[idx] = cs; ((float*)(ws + WS_ROPES))[idx] = sn;
    }
}

template <int MODE>
__device__ __forceinline__ void norm_rows(const Ctx& C, const void* src, bf16* xdst, const unsigned char* YS8, const float* gate, const float* gain, bf16* XN, float* outf) {
    constexpr int NR = 2;
    for (int m0 = C.gw; m0 < T; m0 += NR * C.NGW) {
        f32x4 v[NR][8]; unsigned ya[NR][8], yb[NR][8]; float h0[NR], h1[NR];
#pragma unroll
        for (int q = 0; q < NR; ++q) { const int m = m0 + q * C.NGW;
            if (MODE == 0) { const GAS f32x4* xr = (const GAS f32x4*)((const float*)src + (size_t)m * DM) + C.lane;
#pragma unroll
                for (int j = 0; j < 8; ++j) v[q][j] = xr[64 * j]; }
            else { const GAS v2u* xr = (const GAS v2u*)((const bf16*)src + (size_t)m * DM) + C.lane;
#pragma unroll
                for (int j = 0; j < 8; ++j) { const v2u t_ = xr[64 * j]; v[q][j] = (f32x4){bflo(t_.x), bfhi(t_.x), bflo(t_.y), bfhi(t_.y)}; } }
            if (MODE >= 1) {
                h0[q] = gate[2 * m] * (1.0f / SY); h1[q] = gate[2 * m + 1] * (1.0f / SY);
                const GAS unsigned* y0 = (const GAS unsigned*)(YS8 + (size_t)(2 * m) * DM) + C.lane; const GAS unsigned* y1 = (const GAS unsigned*)(YS8 + (size_t)(2 * m + 1) * DM) + C.lane;
#pragma unroll
                for (int j = 0; j < 8; ++j) { ya[q][j] = y0[64 * j]; yb[q][j] = y1[64 * j]; } } }
#pragma unroll
        for (int q = 0; q < NR; ++q) { const int m = m0 + q * C.NGW;
            if (MODE >= 1) {
#pragma unroll
                for (int j = 0; j < 8; ++j) { const unsigned a = ya[q][j], b = yb[q][j];
                    const f32x2_m a01 = __builtin_amdgcn_cvt_pk_f32_fp8((int)a, false), a23 = __builtin_amdgcn_cvt_pk_f32_fp8((int)a, true), b01 = __builtin_amdgcn_cvt_pk_f32_fp8((int)b, false), b23 = __builtin_amdgcn_cvt_pk_f32_fp8((int)b, true);
                    v[q][j].x += h0[q] * a01.x + h1[q] * b01.x; v[q][j].y += h0[q] * a01.y + h1[q] * b01.y; v[q][j].z += h0[q] * a23.x + h1[q] * b23.x; v[q][j].w += h0[q] * a23.y + h1[q] * b23.y; } }
            float ss = 0.f;
#pragma unroll
            for (int j = 0; j < 8; ++j) ss += (v[q][j].x * v[q][j].x + v[q][j].y * v[q][j].y) + (v[q][j].z * v[q][j].z + v[q][j].w * v[q][j].w);
            const float rstd = 1.0f / sqrtf(wave_sum(ss) * (1.0f / DM) + RMS_EPS);
            if (MODE == 1) { GAS v2u* xo = (GAS v2u*)(xdst + (size_t)m * DM) + C.lane;
#pragma unroll
                for (int j = 0; j < 8; ++j) { v2u w; w.x = pk2(v[q][j].x, v[q][j].y); w.y = pk2(v[q][j].z, v[q][j].w); xo[64 * j] = w; } }
            const GAS f32x4* gg = (const GAS f32x4*)gain + C.lane;
            if (MODE <= 1) { GAS v2u* o = (GAS v2u*)(XN + (size_t)m * DM) + C.lane;
#pragma unroll
                for (int j = 0; j < 8; ++j) { const f32x4 g = gg[64 * j]; v2u w; w.x = pk2(v[q][j].x * rstd * g.x, v[q][j].y * rstd * g.y); w.y = pk2(v[q][j].z * rstd * g.z, v[q][j].w * rstd * g.w); o[64 * j] = w; } }
            else { GAS f32x4* o = (GAS f32x4*)(outf + (size_t)m * DM) + C.lane;
#pragma unroll
                for (int j = 0; j < 8; ++j) { const f32x4 g = gg[64 * j]; o[64 * j] = v[q][j] * rstd * g; } } }
    }
}

__device__ __forceinline__ void convpre_phase(const Ctx& C, const bf16* Z, const float* dw_w, const float* dw_b, const float* ln_g, const float* ln_b, bf16* ZC) {
    const __amdgpu_buffer_rsrc_t zrs = __builtin_amdgcn_make_buffer_rsrc((void*)ZC, (short)0, T * CONV_CH * 2, 0x00020000);
    LAS float* wl = (LAS float*)(C.lds + RING_OFF);
    LAS bf16* zs = (LAS bf16*)(C.lds + RING_OFF + 63488);
    __syncthreads();
    for (int i = C.tid; i < CONV_W * CONV_CH; i += 512) wl[i] = dw_w[i];
    const int c0 = 8 * C.lane;
    float bias[8], lg[8], lb[8];
#pragma unroll
    for (int i = 0; i < 8; ++i) { bias[i] = dw_b[c0 + i]; lg[i] = ln_g[c0 + i]; lb[i] = ln_b[c0 + i]; }
    for (int item = C.blk; item < T / 32; item += C.G) {
        const int t0 = item * 32, s0 = t0 & (SEQ - 1);
        __syncthreads();
#pragma unroll
        for (int i = 0; i < 8; ++i) { const int task = C.tid + 512 * i, rr = task >> 6, ch = task & 63;
            if (rr < 62) { v4u z = {0u, 0u, 0u, 0u};
                if (s0 - 30 + rr >= 0) z = *(const GAS v4u*)(Z + (size_t)(t0 - 30 + rr) * CONV_CH + 8 * ch);
                *(LAS v4u*)(zs + rr * 512 + 8 * ch) = z; } }
        __syncthreads();
        {
            const int tt = 4 * C.wave;
            float acc[4][8];
#pragma unroll
            for (int q = 0; q < 4; ++q)
#pragma unroll
                for (int i = 0; i < 8; ++i) acc[q][i] = bias[i];
#pragma unroll 2
            for (int j = 0; j < CONV_W; ++j) { const f32x4 w0 = *(const LAS f32x4*)(wl + j * 512 + c0), w1 = *(const LAS f32x4*)(wl + j * 512 + c0 + 4);
#pragma unroll
                for (int q = 0; q < 4; ++q) { const v4u z = *(const LAS v4u*)(zs + (tt + q + j) * 512 + c0);
                    acc[q][0] += w0.x * bflo(z.x); acc[q][1] += w0.y * bfhi(z.x); acc[q][2] += w0.z * bflo(z.y); acc[q][3] += w0.w * bfhi(z.y);
                    acc[q][4] += w1.x * bflo(z.z); acc[q][5] += w1.y * bfhi(z.z); acc[q][6] += w1.z * bflo(z.w); acc[q][7] += w1.w * bfhi(z.w); } }
#pragma unroll
            for (int q = 0; q < 4; ++q) {
                float s = 0.f;
#pragma unroll
                for (int i = 0; i < 8; ++i) s += acc[q][i];
                const float mean = wave_sum(s) * (1.0f / CONV_CH); float s2 = 0.f;
#pragma unroll
                for (int i = 0; i < 8; ++i) { acc[q][i] -= mean; s2 += acc[q][i] * acc[q][i]; }
                const float rstd = 1.0f / sqrtf(wave_sum(s2) * (1.0f / CONV_CH) + LN_EPS);
                float y[8];
#pragma unroll
                for (int i = 0; i < 8; ++i) { const float u = acc[q][i] * rstd * lg[i] + lb[i]; y[i] = u * sigmoid_f(u); }
                v4u o; o.x = pk2(y[0], y[1]); o.y = pk2(y[2], y[3]); o.z = pk2(y[4], y[5]); o.w = pk2(y[6], y[7]);
                __builtin_amdgcn_raw_buffer_store_b128(o, zrs, (int)(((size_t)(t0 + tt + q) * CONV_CH + c0) * 2), 0, 16); }
        }
    }
    __syncthreads();
}

#define MFMA16(a, b, c) __builtin_amdgcn_mfma_f32_16x16x32_bf16(a, b, c, 0, 0, 0)
__device__ __forceinline__ void swa_phase(const Ctx& C, const bf16* PROJ, const float* sinks, bf16* YSWA) {
    LAS bf16* vt = (LAS bf16*)(C.lds + RING_OFF);
    const int c16 = C.lane & 15, g4 = C.lane >> 4, w = C.wave;
    for (int u = C.vcu; u < 512; u += C.G) {
        const int n = u & 15, hk = (u >> 4) & 3, b = u >> 6, tb = b * SEQ + 128 * n;
        __syncthreads();
#pragma unroll
        for (int i = 0; i < 2; ++i) { const int task = C.tid + 512 * i, kk = 2 * (task >> 3), c8 = task & 7;
            v4u va = {0u, 0u, 0u, 0u}, vb = {0u, 0u, 0u, 0u};
            if (n > 0 || kk >= 128) { const bf16* vp = PROJ + (size_t)(tb - 128 + kk) * INW + C_VS + 64 * hk + 8 * c8; va = *(const GAS v4u*)vp; vb = *(const GAS v4u*)(vp + INW); }
            LAS unsigned* dst = (LAS unsigned*)(vt + (8 * c8) * 264 + kk);
            dst[0] = (va.x & 0xffffu) | (vb.x << 16); dst[132] = (va.x >> 16) | (vb.x & 0xffff0000u); dst[2 * 132] = (va.y & 0xffffu) | (vb.y << 16); dst[3 * 132] = (va.y >> 16) | (vb.y & 0xffff0000u);
            dst[4 * 132] = (va.z & 0xffffu) | (vb.z << 16); dst[5 * 132] = (va.z >> 16) | (vb.z & 0xffff0000u); dst[6 * 132] = (va.w & 0xffffu) | (vb.w << 16); dst[7 * 132] = (va.w >> 16) | (vb.w & 0xffff0000u); }
        bf16x8 kf[9][2], qf[3][2];
        { const int q0_ = tb + 16 * w;
#pragma unroll
          for (int j = 0; j < 9; ++j) { const int krow = 16 * w - 128 + 16 * j + c16; int ktok = tb + krow; if (128 * n + krow < 0) ktok = b * SEQ;
              const bf16* kp = PROJ + (size_t)ktok * INW + C_KS + 64 * hk + 8 * g4; kf[j][0] = *(const GAS bf16x8*)kp; kf[j][1] = *(const GAS bf16x8*)(kp + 32); }
#pragma unroll
          for (int g = 0; g < 3; ++g) { const bf16* qp = PROJ + (size_t)(q0_ + c16) * INW + C_QS + 64 * (3 * hk + g) + 8 * g4; qf[g][0] = *(const GAS bf16x8*)qp; qf[g][1] = *(const GAS bf16x8*)(qp + 32); } }
        __syncthreads();
#pragma unroll
        for (int g = 0; g < 3; ++g) {
            const int h = 3 * hk + g; const float sink2 = sinks[h] * LOG2E;
            const int q0 = tb + 16 * w;
            f32x4 s[9];
#pragma unroll
            for (int j = 0; j < 9; ++j) { f32x4 a = {0.f, 0.f, 0.f, 0.f}; a = MFMA16(kf[j][0], qf[g][0], a); a = MFMA16(kf[j][1], qf[g][1], a); s[j] = a; }
            const int qr = 16 * w + c16; float mx = -INFINITY;
#pragma unroll
            for (int j = 0; j < 9; ++j)
#pragma unroll
                for (int r = 0; r < 4; ++r) { const int kr = 16 * w - 128 + 16 * j + 4 * g4 + r, diff = qr - kr; const bool ok = diff >= 0 && diff < 128 && (128 * n + kr) >= 0;
                    s[j][r] = ok ? s[j][r] : -INFINITY; mx = fmaxf(mx, s[j][r]); }
            mx = fmaxf(mx, __shfl_xor(mx, 16)); mx = fmaxf(mx, __shfl_xor(mx, 32)); mx = fmaxf(mx, sink2);
            float sum = 0.f;
#pragma unroll
            for (int j = 0; j < 9; ++j)
#pragma unroll
                for (int r = 0; r < 4; ++r) { const float e = __builtin_amdgcn_exp2f(s[j][r] - mx); s[j][r] = e; sum += e; }
            sum += __shfl_xor(sum, 16); sum += __shfl_xor(sum, 32); sum += __builtin_amdgcn_exp2f(sink2 - mx);
            const float inv = 1.0f / sum;
            unsigned pw[10][2];
#pragma unroll
            for (int j = 0; j < 9; ++j) { pw[j][0] = pk2(s[j][0] * inv, s[j][1] * inv); pw[j][1] = pk2(s[j][2] * inv, s[j][3] * inv); }
            pw[9][0] = 0u; pw[9][1] = 0u;
            f32x4 o[4];
#pragma unroll
            for (int dt = 0; dt < 4; ++dt) o[dt] = (f32x4){0.f, 0.f, 0.f, 0.f};
#pragma unroll
            for (int sI = 0; sI < 5; ++sI) {
                const v4u pb = {pw[2 * sI][0], pw[2 * sI][1], pw[2 * sI + 1][0], pw[2 * sI + 1][1]};
                const int kkA = 16 * w + 32 * sI + 4 * g4; int kkB = kkA + 16; if (kkB > 252) kkB = 252;
#pragma unroll
                for (int dt = 0; dt < 4; ++dt) { const LAS bf16* vp = vt + (16 * dt + c16) * 264;
                    const v2u va = *(const LAS v2u*)(vp + kkA), vb = *(const LAS v2u*)(vp + kkB);
                    const v4u av = {va.x, va.y, vb.x, vb.y};
                    o[dt] = MFMA16(__builtin_bit_cast(bf16x8, av), __builtin_bit_cast(bf16x8, pb), o[dt]); }
            }
            bf16* op = YSWA + (size_t)(q0 + c16) * 768 + 64 * h + 4 * g4;
#pragma unroll
            for (int dt = 0; dt < 4; ++dt) { v2u wv; wv.x = pk2(o[dt][0], o[dt][1]); wv.y = pk2(o[dt][2], o[dt][3]); *(GAS v2u*)(op + 16 * dt) = wv; }
        }
    }
    __syncthreads();
}

__device__ __forceinline__ void mix_phase(const Ctx& C, const bf16* YCONV, const bf16* YSWA, const bf16* ODIFF, const float* conv_g, const float* swa_g, const float* lq1, const float* lk1, const float* lq2, const float* lk2,
                                          const float* sub_g, float lambda_init, bf16* MIX) {
    const float lam = __expf(wave_sum(lq1[C.lane] * lk1[C.lane])) - __expf(wave_sum(lq2[C.lane] * lk2[C.lane])) + lambda_init;
    const float osc = 1.0f - lambda_init;
    const int l = C.lane;
    const int vh = l >> 5, dd = 2 * (l & 31); const float gA = sub_g[2 * l] * osc, gB = sub_g[2 * l + 1] * osc;
    const f32x4 cg0 = *(const GAS f32x4*)(conv_g + 8 * l), cg1 = *(const GAS f32x4*)(conv_g + 8 * l + 4);
    const f32x4 sg0 = *(const GAS f32x4*)(swa_g + 8 * l), sg1 = *(const GAS f32x4*)(swa_g + 8 * l + 4), sg2 = *(const GAS f32x4*)(swa_g + 512 + 4 * l);
    constexpr int NR = 2;
    for (int m0 = C.gw; m0 < T; m0 += NR * C.NGW) {
        v4u yc[NR], ys[NR]; v2u ys2[NR]; unsigned oa[NR][6], ob[NR][6];
#pragma unroll
        for (int q = 0; q < NR; ++q) { const int m = m0 + q * C.NGW;
            yc[q] = *(const GAS v4u*)(YCONV + (size_t)m * 512 + 8 * l); ys[q] = *(const GAS v4u*)(YSWA + (size_t)m * 768 + 8 * l); ys2[q] = *(const GAS v2u*)(YSWA + (size_t)m * 768 + 512 + 4 * l);
#pragma unroll
            for (int h = 0; h < 6; ++h) { const bf16* op = ODIFF + (size_t)m * 1536 + 64 * (4 * h + vh) + dd; oa[q][h] = *(const GAS unsigned*)op; ob[q][h] = *(const GAS unsigned*)(op + 128); } }
#pragma unroll
        for (int q = 0; q < NR; ++q) { const int m = m0 + q * C.NGW;
            { const v4u y = yc[q];
              float f[8] = {bflo(y.x), bfhi(y.x), bflo(y.y), bfhi(y.y), bflo(y.z), bfhi(y.z), bflo(y.w), bfhi(y.w)}; float ss = 0.f;
#pragma unroll
              for (int i = 0; i < 8; ++i) ss += f[i] * f[i];
              const float r = 1.0f / sqrtf(wave_sum(ss) * (1.0f / 512.0f) + RMS_EPS);
              v4u o; o.x = pk2(f[0] * r * cg0.x, f[1] * r * cg0.y); o.y = pk2(f[2] * r * cg0.z, f[3] * r * cg0.w); o.z = pk2(f[4] * r * cg1.x, f[5] * r * cg1.y); o.w = pk2(f[6] * r * cg1.z, f[7] * r * cg1.w);
              *(GAS v4u*)(MIX + (size_t)m * DM + 8 * l) = o; }
            { const v4u y = ys[q]; const v2u y2 = ys2[q];
              float f[12] = {bflo(y.x), bfhi(y.x), bflo(y.y), bfhi(y.y), bflo(y.z), bfhi(y.z), bflo(y.w), bfhi(y.w), bflo(y2.x), bfhi(y2.x), bflo(y2.y), bfhi(y2.y)}; float ss = 0.f;
#pragma unroll
              for (int i = 0; i < 12; ++i) ss += f[i] * f[i];
              const float r = 1.0f / sqrtf(wave_sum(ss) * (1.0f / 768.0f) + RMS_EPS);
              v4u o; o.x = pk2(f[0] * r * sg0.x, f[1] * r * sg0.y); o.y = pk2(f[2] * r * sg0.z, f[3] * r * sg0.w); o.z = pk2(f[4] * r * sg1.x, f[5] * r * sg1.y); o.w = pk2(f[6] * r * sg1.z, f[7] * r * sg1.w);
              v2u o2; o2.x = pk2(f[8] * r * sg2.x, f[9] * r * sg2.y); o2.y = pk2(f[10] * r * sg2.z, f[11] * r * sg2.w);
              *(GAS v4u*)(MIX + (size_t)m * DM + 512 + 8 * l) = o; *(GAS v2u*)(MIX + (size_t)m * DM + 1024 + 4 * l) = o2; }
#pragma unroll
            for (int h = 0; h < 6; ++h) { const unsigned a = oa[q][h], bq = ob[q][h];
                const float v0 = bflo(a) - lam * bflo(bq), v1 = bfhi(a) - lam * bfhi(bq);
                const float r = 1.0f / sqrtf(wave_sum(v0 * v0 + v1 * v1) * (1.0f / 128.0f) + LN_EPS);
                *(GAS unsigned*)(MIX + (size_t)m * DM + 1280 + 128 * h + 2 * l) = pk2(v0 * r * gA, v1 * r * gB); } }
    }
}

__device__ __forceinline__ void router_phase(const Ctx& C, const bf16* X, const float* rowss, const bf16* RW, const float* gain, const float* bg, const float* be, unsigned char* XN8, unsigned char* rt) {
    int* tok_e = (int*)(rt + RT_TOKE); int* tok_p = (int*)(rt + RT_TOKP); float* tok_g = (float*)(rt + RT_GATE); int* row_slot = (int*)(rt + RT_SLOT); int* hist = (int*)(rt + RT_HIST);
    LAS int* lh = (LAS int*)(C.lds + RING_OFF);
    LAS float* lg = (LAS float*)(C.lds + RING_OFF + 1024) + C.wave * 640;
    for (int i = C.gtid; i < PROWS; i += C.NT) row_slot[i] = -1;
    __syncthreads();
    if (C.tid < 64) lh[C.tid] = 0;
    __syncthreads();
    const int r0 = C.blk * 64 + C.wave * 8, c16 = C.lane & 15, g4 = C.lane >> 4;
    float rstd_l;
    { const GAS f32x4* pp = (const GAS f32x4*)(rowss + (size_t)(r0 + (C.lane >> 3)) * 32) + (C.lane & 7); const f32x4 q = pp[0]; float ssr = (q.x + q.y) + (q.z + q.w);
      ssr += __shfl_xor(ssr, 1); ssr += __shfl_xor(ssr, 2); ssr += __shfl_xor(ssr, 4); rstd_l = 1.0f / sqrtf(ssr * (1.0f / DM) + RMS_EPS); }
    const float rstd = __shfl(rstd_l, (c16 & 7) * 8);
    const float hsc = rstd * SA1;
    const bf16* xrow = X + (size_t)(r0 + (c16 & 7)) * DM + 8 * g4;
    LAS float* gl = (LAS float*)(C.lds + RING_OFF + 114688);
    for (int i = C.tid; i < DM; i += 512) gl[i] = gain[i];
    const LAS float* grow = gl + 8 * g4;
    unsigned char* hrow = XN8 + (size_t)(r0 + (c16 & 7)) * DM + 8 * g4;
    LAS bf16* wb = (LAS bf16*)(C.lds + RING_OFF + 24576);
    constexpr int WROW = 136, WBUF = 160 * WROW;
    f32x4 acc[5];
#pragma unroll
    for (int i = 0; i < 5; ++i) acc[i] = (f32x4){0.f, 0.f, 0.f, 0.f};
    v4u wreg[5]; v4u x0[4], x1[4], x2[4];
#define RT_WLOAD(c) do { _Pragma("unroll") for (int i = 0; i < 5; ++i) { const int task = C.tid + 512 * i, row = task >> 4, seg = task & 15; wreg[i] = *(const GAS v4u*)(RW + (size_t)row * DM + (c) * 128 + seg * 8); } } while (0)
#define RT_WSTORE(c) do { _Pragma("unroll") for (int i = 0; i < 5; ++i) { const int task = C.tid + 512 * i, row = task >> 4, seg = task & 15; *(LAS v4u*)(wb + ((c) & 1) * WBUF + row * WROW + seg * 8) = wreg[i]; } } while (0)
#define RT_XLOAD(XB, c) do { const int cc_ = (c) < 16 ? (c) : 15; _Pragma("unroll") for (int ks = 0; ks < 4; ++ks) XB[ks] = *(const GAS v4u*)(xrow + cc_ * 128 + 32 * ks); } while (0)
#define RT_HLOAD(BF, ks) do { _Pragma("unroll") for (int nt = 0; nt < 5; ++nt) BF[nt] = *(const LAS bf16x8*)(cur + nt * 16 * WROW + 32 * (ks)); } while (0)
#define RT_LLOAD(BF, ks) do { _Pragma("unroll") for (int nt = 0; nt < 5; ++nt) BF[nt] = *(const LAS bf16x8*)(cur + (80 + nt * 16) * WROW + 32 * (ks)); } while (0)
#define RT_KSTEP(c, XB, ks, BH, BL) do { const v4u xq = XB[ks]; const bf16x8 ax = __builtin_bit_cast(bf16x8, xq); \
            _Pragma("unroll") for (int nt = 0; nt < 5; ++nt) acc[nt] = MFMA16(ax, BH[nt], acc[nt]); \
            _Pragma("unroll") for (int nt = 0; nt < 5; ++nt) acc[nt] = MFMA16(ax, BL[nt], acc[nt]); \
            { const f32x4 ga = *(const LAS f32x4*)(grow + (c) * 128 + 32 * (ks)), gb = *(const LAS f32x4*)(grow + (c) * 128 + 32 * (ks) + 4); v2u hw;     \
                hw.x = pk4_fp8m(bflo(xq.x) * hsc * ga.x, bfhi(xq.x) * hsc * ga.y, bflo(xq.y) * hsc * ga.z, bfhi(xq.y) * hsc * ga.w); hw.y = pk4_fp8m(bflo(xq.z) * hsc * gb.x, bfhi(xq.z) * hsc * gb.y, bflo(xq.w) * hsc * gb.z, bfhi(xq.w) * hsc * gb.w); \
                *(GAS v2u*)(hrow + (c) * 128 + 32 * (ks)) = hw; }     } while (0)
#define RT_CHUNK(c, XB) do { const LAS bf16* cur = wb + ((c) & 1) * WBUF + c16 * WROW + 8 * g4; bf16x8 hA[5], hB[5], lF[5]; RT_HLOAD(hA, 0); \
        RT_LLOAD(lF, 0); RT_HLOAD(hB, 1); RT_KSTEP(c, XB, 0, hA, lF); RT_LLOAD(lF, 1); RT_HLOAD(hA, 2); RT_KSTEP(c, XB, 1, hB, lF); \
        RT_LLOAD(lF, 2); RT_HLOAD(hB, 3); RT_KSTEP(c, XB, 2, hA, lF); RT_LLOAD(lF, 3); RT_KSTEP(c, XB, 3, hB, lF); } while (0)
    RT_WLOAD(0); RT_XLOAD(x0, 0); RT_XLOAD(x1, 1); RT_WSTORE(0);
    __syncthreads();
#pragma unroll 1
    for (int c = 0; c < 15; c += 3) {
        RT_WLOAD(c + 1); RT_XLOAD(x2, c + 2); RT_CHUNK(c, x0); RT_WSTORE(c + 1); __syncthreads();
        RT_WLOAD(c + 2); RT_XLOAD(x0, c + 3); RT_CHUNK(c + 1, x1); RT_WSTORE(c + 2); __syncthreads();
        RT_WLOAD(c + 3); RT_XLOAD(x1, c + 4); RT_CHUNK(c + 2, x2); RT_WSTORE(c + 3); __syncthreads();
    }
    RT_CHUNK(15, x0);
#undef RT_WLOAD
#undef RT_WSTORE
#undef RT_XLOAD
#undef RT_CHUNK
#undef RT_KSTEP
#undef RT_HLOAD
#undef RT_LLOAD
    float rs4[4];
#pragma unroll
    for (int r = 0; r < 4; ++r) rs4[r] = __shfl(rstd_l, ((4 * g4 + r) & 7) * 8);
    if (g4 < 2) {
#pragma unroll
        for (int r = 0; r < 4; ++r) { const int row = 4 * g4 + r;
#pragma unroll
            for (int nt = 0; nt < 5; ++nt) { const int o = 16 * nt + c16; if (o < 72) lg[row * 80 + o] = acc[nt][r] * rs4[r] + (o < 8 ? bg[o] : be[o - 8]); } }
    }
    LDS_WAIT(); asm volatile("" ::: "memory");
    if (C.lane < 8) { const LAS float* L = lg + C.lane * 80;
        int gi = 0; float gm = L[0];
#pragma unroll
        for (int j = 1; j < 8; ++j) { const float v = L[j]; if (v > gm) { gm = v; gi = j; } }
        float gs = 0.f;
#pragma unroll
        for (int j = 0; j < 8; ++j) gs += __expf(L[j] - gm);
        const float gw_ = 1.0f / gs;
        const LAS float* E = L + 8 + 8 * gi;
        int j1 = 0; float m1 = E[0];
#pragma unroll
        for (int j = 1; j < 8; ++j) { const float v = E[j]; if (v > m1) { m1 = v; j1 = j; } }
        int j2 = (j1 == 0) ? 1 : 0; float m2 = E[j2];
#pragma unroll
        for (int j = 0; j < 8; ++j) { const float v = E[j]; if (j != j1 && v > m2) { m2 = v; j2 = j; } }
        const float ex = __expf(m2 - m1), w1 = 1.0f / (1.0f + ex), w2 = ex * w1;
        const int e0 = 8 * gi + j1, e1 = 8 * gi + j2, tok = r0 + C.lane;
        const int p0 = atomicAdd((int*)&lh[e0], 1), p1 = atomicAdd((int*)&lh[e1], 1);
        tok_e[2 * tok] = e0; tok_e[2 * tok + 1] = e1; tok_p[2 * tok] = p0; tok_p[2 * tok + 1] = p1; tok_g[2 * tok] = gw_ * w1; tok_g[2 * tok + 1] = gw_ * w2;
    }
    __syncthreads();
    if (C.tid < 64) hist[C.blk * 64 + C.tid] = lh[C.tid];
    __syncthreads();
}

__device__ __forceinline__ void moe_table(const Ctx& C, const int* hist) {
    LAS int* padstart = (LAS int*)(C.lds + TAB_OFF); LAS int* base = padstart + 64; LAS int* tab = padstart + 128; LAS int* ntl = padstart + 320;
    LAS int* part = (LAS int*)(C.lds + TAB_PART);
    __syncthreads();
    { const int e = C.tid & 63, p = C.tid >> 6; int tot = 0, pre = 0;
      int hv[32];
#pragma unroll
      for (int i = 0; i < 32; ++i) hv[i] = hist[(32 * p + i) * 64 + e];
#pragma unroll
      for (int i = 0; i < 32; ++i) { tot += hv[i]; pre += (32 * p + i < C.blk) ? hv[i] : 0; }
      part[(p * 64 + e) * 2] = tot; part[(p * 64 + e) * 2 + 1] = pre; }
    __syncthreads();
    if (C.tid < 64) { const int e = C.tid; int cnt = 0, pre = 0;
#pragma unroll
        for (int p = 0; p < 8; ++p) { cnt += part[(p * 64 + e) * 2]; pre += part[(p * 64 + e) * 2 + 1]; }
        const int nt = (cnt + 255) >> 8; int inc = nt;
#pragma unroll
        for (int off = 1; off < 64; off <<= 1) { const int t = __shfl_up(inc, off); if (e >= off) inc += t; }
        const int ts = inc - nt; padstart[e] = 256 * ts; base[e] = pre;
        for (int i = 0; i < nt; ++i) tab[ts + i] = e;
        if (e == 63) ntl[0] = inc; }
    __syncthreads();
}
__device__ __forceinline__ void slot_phase(const Ctx& C, unsigned char* rt) {
    const int* tok_e = (const int*)(rt + RT_TOKE); const int* tok_p = (const int*)(rt + RT_TOKP); int* row_slot = (int*)(rt + RT_SLOT);
    const LAS int* padstart = (const LAS int*)(C.lds + TAB_OFF); const LAS int* base = padstart + 64;
    if (C.tid < 128) { const int slot = 2 * (C.blk * 64) + C.tid; const int e = tok_e[slot]; row_slot[padstart[e] + base[e] + tok_p[slot]] = slot; }
}
__device__ __forceinline__ int att_unit_tab(int i) {
    static constexpr unsigned char T_[96] = {7, 2, 10, 15, 18, 26, 23, 34, 42, 31, 50, 58, 39, 66, 74, 47, 82, 90, 55, 4, 0, 63, 12, 8, 71, 20, 16, 79, 28, 24, 87, 36, 32, 95, 44, 40, 6, 5, 48, 14, 13, 56, 22, 21, 64, 30, 29, 72, 38, 37, 80, 46, 45, 88, 54, 3, 1, 62, 11, 9, 70, 19, 17, 78, 27, 25, 86, 35, 33, 94, 43, 41, 53, 52, 49, 61, 60, 57, 69, 68, 65, 77, 76, 73, 85, 84, 81, 93, 92, 89, 51, 59, 67, 75, 83, 91};
    return T_[i];
}
typedef const void* const __attribute__((address_space(4)))* KARGP;
struct Args { const void* in[26]; float* out; unsigned char* ws; int ph_lo, ph_hi, use_bar, pad; };
__global__ void __launch_bounds__(512, 2) mega_fwd(Args args) {
    extern __shared__ __attribute__((aligned(16))) unsigned char lds_raw[];
    const int wave0 = __builtin_amdgcn_readfirstlane((int)threadIdx.x >> 6), blk0 = blockIdx.x;
    LAS unsigned char* const ldsb = (LAS unsigned char*)lds_raw;
#define MKCTX Ctx C; C.lds = ldsb; C.wave = wave0; asm volatile("v_mbcnt_lo_u32_b32 %0, -1, 0\n\tv_mbcnt_hi_u32_b32 %0, -1, %0" : "=v"(C.lane)); C.tid = wave0 * 64 + C.lane; C.blk = blk0; \
    C.vcu = (blk0 % 8) * (GRID / 8) + blk0 / 8; C.gw = blk0 * 8 + wave0; C.gtid = blk0 * 512 + C.tid
    unsigned char* ws0 = args.ws;
    for (int u = threadIdx.x; u < 128; u += 512) ((LAS unsigned*)(ldsb + LCTL_OFF))[u] = 0u;
    __syncthreads();
    XcdBarrier bar; bar.bar = (unsigned*)(ws0 + WS_CTL) + CW_BAR; bar.x = 0; bar.st = (volatile LAS unsigned*)(ldsb + LCTL_OFF + 64);
    if (args.use_bar) bar = xcd_barrier_post((unsigned*)(ws0 + WS_CTL) + CW_BAR, (volatile LAS unsigned*)(ldsb + LCTL_OFF + 64));
    const int lo = args.ph_lo, hi = args.ph_hi;
#ifndef PH_DIS
#define PH_DIS 0
#endif
#define INR(k) (lo <= (k) && (k) < hi)
#define IN0 (INR(0) && !(PH_DIS & 1))
#define INL(off) (INR(pb + (off)) && !((PH_DIS >> (1 + (off))) & 1))
#ifndef PROBE_DUP
#define PROBE_DUP 0
#endif
#define NREP(bit) (((PROBE_DUP >> (bit)) & 1) ? 2 : 1)
#define LAUNDER MKCTX; asm volatile("" : "+v"(C.tid), "+v"(C.lane), "+v"(C.gtid)); PTRS
#ifndef PROBE_BAR2
#define PROBE_BAR2 0
#endif
#define SEAM(k) do { if (INR(k) && INR((k) + 1)) { xcd_barrier(bar); if (PROBE_BAR2) xcd_barrier(bar); } } while (0)
#define GIN(i) ((const float*)(const GAS float*)ain[i])
#define PTRS GAS unsigned char* wsg_ = (GAS unsigned char*)ws0; asm volatile("" : "+s"(wsg_)); unsigned char* ws = (unsigned char*)wsg_;     \
    KARGP ain = (KARGP)__builtin_amdgcn_kernarg_segment_ptr(); asm volatile("" : "+s"(ain));     \
    const float* x_in = GIN(0); \
    bf16* XN = (bf16*)(ws + WS_XN); bf16* PROJ = (bf16*)(ws + WS_PROJ); bf16* ZC = (bf16*)(ws + WS_ZC); bf16* YCONV = (bf16*)(ws + WS_YCONV); bf16* YSWA = (bf16*)(ws + WS_YSWA); \
    bf16* ODIFF = (bf16*)(ws + WS_ODIFF); bf16* MIX = (bf16*)(ws + WS_MIX); bf16* X = (bf16*)(ws + WS_X); bf16* Zb = (bf16*)(ws + WS_Z); bf16* ACT = (bf16*)(ws + WS_ACT); bf16* YS = (bf16*)(ws + WS_YS); \
    unsigned char* rt = ws + WS_ROUTE; (void)x_in; (void)XN; (void)PROJ; (void)ZC; (void)YCONV; (void)YSWA; (void)ODIFF; (void)MIX; (void)X; (void)Zb; (void)ACT; (void)YS; (void)rt
    if (IN0) for (int rep_ = 0; rep_ < NREP(0); ++rep_) { LAUNDER;
        P0In I{GIN(3), GIN(17), GIN(8), GIN(23), GIN(24), GIN(19), GIN(21), GIN(18), ((const int*)GIN(1))};
        p0_prologue(C, I, ws);
        norm_rows<0>(C, x_in, nullptr, nullptr, nullptr, GIN(2), XN, nullptr);
    }
    SEAM(0);
#pragma unroll 1
    for (int l = 0; l < DEPTH; ++l) {
        const int pb = 1 + 10 * l;
        const float lambda_init = (l == 0) ? 0.2f : 0.35550906759096927f;
        if (INL(0)) for (int rep_ = 0; rep_ < NREP(1); ++rep_) { LAUNDER;
            pg8::Gemm g{XN, (const bf16*)(ws + WS_WIN) + (size_t)l * INW * DM, T, INW, DM}; pg8::StaticOrder S; S.init(T, INW, C.G, C.blk);
            pg8::EpiProj E{PROJ, INW, Zb, (const float*)(ws + WS_ROPEC), (const float*)(ws + WS_ROPES), QSCALE};
            pg8::gemm_phase<pg8::EpiProj, pg8::StaticOrder, true, true>(C.lds + RING_OFF, g, S, E, C.tid);
            if (C.blk >= 128) { P0In I{nullptr, nullptr, nullptr, GIN(23), GIN(24), nullptr, nullptr, nullptr, nullptr};
                constexpr int PER_L = MOE_ITEMS_L;
                moe_convert(C, I, ws, l * PER_L, l * PER_L + CONV_TAIL, C.blk - 128, 128); }
        }
        SEAM(pb + 0);
        if (INL(2)) for (int rep_ = 0; rep_ < NREP(3); ++rep_) { LAUNDER;
            unsigned* zc_cnt = (unsigned*)(ws + WS_CTL) + CW_ZC + 64 * l + 2048 * rep_;
            convpre_phase(C, Zb, GIN(4) + l * CONV_W * CONV_CH, GIN(5) + l * CONV_CH, GIN(6) + l * CONV_CH, GIN(7) + l * CONV_CH, ZC);
            asm volatile("s_waitcnt vmcnt(0)" ::: "memory");
            __syncthreads();
            if (C.tid == 0) __hip_atomic_fetch_add(zc_cnt, 1u, __ATOMIC_RELAXED, __HIP_MEMORY_SCOPE_AGENT);
#ifndef NO_ATT
            for (int rep2_ = 0; rep2_ < NREP(11); ++rep2_)
#pragma unroll 1
            for (int step = 0; step < 6; ++step) {
                const int third = step >> 1;
                if ((step & 1) == (C.vcu & 1)) {
                    P0In I{nullptr, nullptr, nullptr, GIN(23), GIN(24), nullptr, nullptr, nullptr, nullptr};
                    constexpr int PER_L = MOE_ITEMS_L, NIT = PER_L - CONV_TAIL - CONV_OUT, T3 = (NIT / 3 + C.G - 1) / C.G * C.G;
                    const int lo = l * PER_L + CONV_TAIL + third * T3, hi = (third == 2) ? (l + 1) * PER_L - CONV_OUT : lo + T3;
                    moe_convert(C, I, ws, lo, hi, C.blk, C.G);
                } else {
                    { const int xcd = C.vcu >> 5, ci = C.vcu & 31, tv = att_unit_tab(ci * 3 + third), qb = tv & 7, gi = xcd * 12 + (tv >> 3), b = gi / 12, hc = gi - b * 12, h = hc >> 1, c = hc & 1;
                        const attn_body::bf16* Q = (const attn_body::bf16*)PROJ + C_QD + (2 * h + c) * 64; const attn_body::bf16* K = (const attn_body::bf16*)PROJ + C_KD + (2 * h + c) * 64;
                        const attn_body::bf16* V = (const attn_body::bf16*)PROJ + C_VD + 128 * h; attn_body::bf16* O = (attn_body::bf16*)ODIFF + 64 * (4 * h + 2 * c);
                        attn_body::attn_unit2<8>(b, qb, Q, K, V, O, (char*)lds_raw + RING_OFF, C.tid); }
                }
            }
#endif
            __syncthreads();
#ifndef NO_SWA
            for (int rep2_ = 0; rep2_ < NREP(12); ++rep2_)
            swa_phase(C, PROJ, GIN(10) + l * 12, YSWA);
#endif
#ifndef NO_PW
            if (C.tid == 0) { unsigned sp_ = 0;
                while (__hip_atomic_load(zc_cnt, __ATOMIC_RELAXED, __HIP_MEMORY_SCOPE_AGENT) < (unsigned)C.G) { __builtin_amdgcn_s_sleep(2); if (++sp_ > (1u << 22)) break; }
                __builtin_amdgcn_fence(__ATOMIC_ACQUIRE, "agent"); asm volatile("s_waitcnt vmcnt(0)" ::: "memory"); }
            __syncthreads();
            for (int rep2_ = 0; rep2_ < NREP(13); ++rep2_)
            { pg8::Gemm g{ZC, (const bf16*)(ws + WS_PW) + (size_t)l * 512 * 512, T, 512, 512}; pg8::StaticOrder S; S.init(T, 512, C.G, C.blk);
              pg8::EpiBf16<0> E{YCONV, 512, nullptr, 0, 0, 1.f};
              pg8::gemm_phase<pg8::EpiBf16<0>, pg8::StaticOrder, true, true>(C.lds + RING_OFF, g, S, E, C.tid); }
#endif
        }
        SEAM(pb + 2);
        if (INL(3)) for (int rep_ = 0; rep_ < NREP(4); ++rep_) { LAUNDER;
            mix_phase(C, YCONV, YSWA, ODIFF, GIN(9) + l * 512, GIN(11) + l * 768, GIN(12) + l * 64, GIN(13) + l * 64,
                      GIN(14) + l * 64, GIN(15) + l * 64, GIN(16) + l * 128, lambda_init, MIX);
        }
        SEAM(pb + 3);
        if (INL(4)) for (int rep_ = 0; rep_ < ((l == 0) ? NREP(5) : 1); ++rep_) { LAUNDER;
            pg8::Gemm g{MIX, (const bf16*)(ws + WS_WOUT) + (size_t)l * DM * DM, T, DM, DM}; pg8::StaticOrder S; S.init(T, DM, C.G, C.blk);
            P0In Ic{nullptr, nullptr, nullptr, GIN(23), GIN(24), nullptr, nullptr, nullptr, nullptr};
            constexpr int PER_Lc = MOE_ITEMS_L;
            P0In Iw{GIN(3), GIN(17), GIN(8), nullptr, nullptr, nullptr, nullptr, nullptr, nullptr};
            if ((C.vcu & 1) == 0) { moe_convert(C, Ic, ws, (l + 1) * PER_Lc - CONV_OUT, (l + 1) * PER_Lc, C.blk, C.G); if (l + 1 < DEPTH) wconv_bf16(C, Iw, ws, (l + 1) * WCONV_L, (l + 2) * WCONV_L); }
            if (l == 0) { pg8::EpiResBf16<true> E{x_in, X, DM, (float*)(ws + WS_ROWSS)}; pg8::gemm_phase<pg8::EpiResBf16<true>, pg8::StaticOrder, true, true>(C.lds + RING_OFF, g, S, E, C.tid); }
            else { pg8::EpiResBf16<false> E{X, X, DM, (float*)(ws + WS_ROWSS)}; pg8::gemm_phase<pg8::EpiResBf16<false>, pg8::StaticOrder, true, true>(C.lds + RING_OFF, g, S, E, C.tid); }
            if ((C.vcu & 1) != 0) { moe_convert(C, Ic, ws, (l + 1) * PER_Lc - CONV_OUT, (l + 1) * PER_Lc, C.blk, C.G); if (l + 1 < DEPTH) wconv_bf16(C, Iw, ws, (l + 1) * WCONV_L, (l + 2) * WCONV_L); }
        }
        SEAM(pb + 4);
        if (INL(5)) for (int rep_ = 0; rep_ < NREP(6); ++rep_) { LAUNDER;
            router_phase(C, X, (const float*)(ws + WS_ROWSS), (const bf16*)(ws + WS_RW) + (size_t)l * 2 * 80 * DM, GIN(18) + l * DM, GIN(20) + l * 8, GIN(22) + l * 64, (unsigned char*)XN, rt);
        }
        SEAM(pb + 5);
        if (INL(6)) for (int rep_ = 0; rep_ < NREP(7); ++rep_) { LAUNDER; moe_table(C, (const int*)(rt + RT_HIST)); slot_phase(C, rt); }
        SEAM(pb + 6);
        if (INL(7)) for (int rep_ = 0; rep_ < NREP(8); ++rep_) { LAUNDER;
            if (!args.use_bar) moe_table(C, (const int*)(rt + RT_HIST));
            const LAS int* tb = (const LAS int*)(C.lds + TAB_OFF);
            pg8::Gemm g{XN, (const bf16*)(ws + WS_W13 + (size_t)l * NEXP * 1024 * DM), PROWS, NEXP * 1024, DM / 2};
            pg8::GroupedOrder S{tb + 128, tb[320], 4, C.G, C.vcu};
            LAS unsigned* gofs = (LAS unsigned*)(C.lds + GOFS_OFF); const int* row_slot = (const int*)(rt + RT_SLOT);
            { int slv[3] = {-1, -1, -1};
#pragma unroll
              for (int i = 0; i < 3; ++i) { pg8::Unit u; if (S.next(i, u) && C.tid < 256) slv[i] = row_slot[u.pm * 256 + C.tid]; }
#pragma unroll
              for (int i = 0; i < 3; ++i) if (C.tid < 256) gofs[i * 256 + C.tid] = (unsigned)(slv[i] < 0 ? 0 : slv[i] >> 1) * (unsigned)DM; }
            __syncthreads();
            pg8::EpiSiluMul8 E{(unsigned char*)ACT, FF, 1.0f / (SA1 * SW1), SA2};
            pg8::gemm_phase<pg8::EpiSiluMul8, pg8::GroupedOrder, true, true, true, true>(C.lds + RING_OFF, g, S, E, C.tid, gofs);
        }
        SEAM(pb + 7);
        if (INL(8)) for (int rep_ = 0; rep_ < NREP(9); ++rep_) { LAUNDER;
            if (!args.use_bar) moe_table(C, (const int*)(rt + RT_HIST));
            const LAS int* tb = (const LAS int*)(C.lds + TAB_OFF);
            pg8::Gemm g{ACT, (const bf16*)(ws + WS_W2 + (size_t)l * NEXP * DM * FF), PROWS, NEXP * DM, FF / 2};
            pg8::GroupedOrder S{tb + 128, tb[320], 8, C.G, C.vcu};
            pg8::EpiScatter E{(unsigned char*)YS, DM, (const int*)(rt + RT_SLOT), SY / (SA2 * SW2)};
            pg8::gemm_phase<pg8::EpiScatter, pg8::GroupedOrder, true, true, false, true>(C.lds + RING_OFF, g, S, E, C.tid);
        }
        SEAM(pb + 8);
        if (INL(9)) for (int rep_ = 0; rep_ < ((l + 1 == DEPTH) ? NREP(10) : 1); ++rep_) { LAUNDER;
            if (l + 1 < DEPTH) norm_rows<1>(C, X, X, (const unsigned char*)YS, (const float*)(rt + RT_GATE), GIN(2) + (l + 1) * DM, XN, nullptr);
            else norm_rows<2>(C, X, nullptr, (const unsigned char*)YS, (const float*)(rt + RT_GATE), GIN(25), nullptr, args.out);
        }
        SEAM(pb + 9);
    }
#undef LAUNDER
#undef MKCTX
#undef PTRS
#undef GIN
#undef INR
#undef IN0
#undef INL
#undef SEAM
}

extern "C" void kernel_launch(void* const* d_in, const int* in_sizes, int n_in, void* d_out, int out_size, void* d_ws, size_t ws_size, hipStream_t stream) {
    static int grid = 0;
    if (grid == 0) {
        if (n_in != 26 || in_sizes[0] != T * DM || out_size != T * DM || ws_size < WS_END) { fprintf(stderr, "kernel_launch: unexpected shapes (n_in %d, in0 %d, out %d, ws %zu < %zu); nothing launched\n", n_in, n_in > 0 ? in_sizes[0] : -1, out_size, ws_size, (size_t)WS_END); grid = -1; return; }
        int dev = 0, cus = 0, per_cu = 0;
        if (hipGetDevice(&dev) != hipSuccess || hipDeviceGetAttribute(&cus, hipDeviceAttributeMultiprocessorCount, dev) != hipSuccess) { fprintf(stderr, "kernel_launch: device query failed\n"); grid = -1; return; }
        if (hipFuncSetAttribute((const void*)mega_fwd, hipFuncAttributeMaxDynamicSharedMemorySize, LDS_BYTES) != hipSuccess) { fprintf(stderr, "kernel_launch: hipFuncSetAttribute failed\n"); grid = -1; return; }
        if (hipOccupancyMaxActiveBlocksPerMultiprocessor(&per_cu, (const void*)mega_fwd, 512, LDS_BYTES) != hipSuccess || per_cu < 1) fprintf(stderr, "kernel_launch: note: occupancy query reports %d workgroups per CU\n", per_cu);
        (void)hipGetLastError();
        if (cus != 256) { fprintf(stderr, "kernel_launch: built for a 256-CU device (got %d); nothing launched\n", cus); grid = -1; return; }
        grid = cus;
    }
    if (grid < 0) return;
    if (hipMemsetAsync((char*)d_ws + WS_CTL, 0, CTL_ZERO_BYTES, stream) != hipSuccess) { fprintf(stderr, "kernel_launch: memset failed\n"); return; }
    if (grid != GRID) return;
    Args a{};
    for (int i = 0; i < 26; ++i) a.in[i] = d_in[i];
    a.out = (float*)d_out; a.ws = (unsigned char*)d_ws; a.pad = 0;
#if MK_MULTI
    for (int k = 0; k < NPHASE; ++k) { a.ph_lo = k; a.ph_hi = k + 1; a.use_bar = 0; hipLaunchKernelGGL(mega_fwd, dim3(grid), dim3(512), LDS_BYTES, stream, a); }
#else
    a.ph_lo = 0; a.ph_hi = NPHASE; a.use_bar = 1;
    hipLaunchKernelGGL(mega_fwd, dim3(grid), dim3(512), LDS_BYTES, stream, a);
#endif
    const hipError_t le = hipPeekAtLastError();
    if (le != hipSuccess) fprintf(stderr, "kernel_launch: launch failed: %s\n", hipGetErrorName(le));
}
```

```cpp
#include <hip/hip_runtime.h>
#include <cstdio>
#include <cstdint>
namespace pg8 {
#define PG8_LAS __attribute__((address_space(3)))
typedef unsigned short bf16_t;
typedef short bf16x8 __attribute__((ext_vector_type(8)));
typedef float f32x4 __attribute__((ext_vector_type(4)));
typedef unsigned u32x4 __attribute__((ext_vector_type(4)));
typedef int pg8_i4 __attribute__((ext_vector_type(4)));
#ifndef PG8_WT
#define PG8_WT 0
#endif
#define PG8_RSRC(base) __builtin_amdgcn_make_buffer_rsrc((void*)(base), (short)0, -1, 0x00020000)
#if PG8_WT
#define PG8_ST16(rs, b0, p, v) __builtin_amdgcn_raw_buffer_store_b128(v, rs, (int)((const char*)(p) - (const char*)(b0)), 0, 16)
#define PG8_ST8(rs, b0, p, v) __builtin_amdgcn_raw_buffer_store_b64(v, rs, (int)((const char*)(p) - (const char*)(b0)), 0, 16)
#else
#define PG8_ST16(rs, b0, p, v) (*(u32x4*)(p) = (v))
#define PG8_ST8(rs, b0, p, v) (*(u32x2_g*)(p) = (v))
#endif
typedef unsigned u32x2_g __attribute__((ext_vector_type(2)));
typedef int pg8_i8 __attribute__((ext_vector_type(8)));
constexpr int BM = 256, BK = 64, HALF = 128, HTB = HALF * BK * 2  , STAGE_BYTES = 8 * HTB, NXCD = 8, WGM = 8;

__host__ __device__ __forceinline__ int lds_byte(int r, int c) { const int st = (r >> 4) * 2 + (c >> 5), rr = r & 15, cc = c & 31, ob = rr * 64 + cc * 2; return st * 1024 + (ob ^ (((ob >> 9) & 1) << 5)); }
__host__ __device__ __forceinline__ void stage_rc(int b, int& R, int& C) { const int st = b / 1024, sb = b % 1024, swz = sb ^ (((sb >> 9) & 1) << 5); R = (st >> 1) * 16 + swz / 64; C = (st & 1) * 32 + (swz % 64) / 2; }
__host__ __device__ __forceinline__ int perm32(int rho) { const int n = rho >> 4, i = rho & 15; return 8 * (i >> 2) + 4 * n + (i & 3); }

struct Unit { int pm, pn, ui; };
struct Gemm { const bf16_t* A; const bf16_t* Bt; int M, N, K; };

struct StaticOrder {
    int nM, nN, nwg, G, c;
    __host__ __device__ void init(int M, int N, int G_, int c_) { nM = M / BM; nN = N / BM; nwg = nM * nN; G = G_; c = c_; }
    __host__ __device__ bool next(int i, Unit& u) const {
        const long L = (long)i * G + c; if (L >= nwg) return false;
        int wgid = (int)L; { const int q = nwg / NXCD, r = nwg % NXCD, xcd = wgid % NXCD, off = wgid / NXCD; wgid = (xcd < r ? xcd * (q + 1) : r * (q + 1) + (xcd - r) * q) + off; }
        const int nig = WGM * nN, gid = wgid / nig, fm = gid * WGM, gsz = (nM - fm) < WGM ? (nM - fm) : WGM;
        u.pm = fm + ((wgid % nig) % gsz); u.pn = (wgid % nig) / gsz; return true;
    }
    __device__ __forceinline__ void a_ready(const Unit&) const {}
    __device__ __forceinline__ void done(const Unit&) const {}
};

__device__ __forceinline__ unsigned cvt_pk_bf16(float lo, float hi) { unsigned r; asm volatile("v_cvt_pk_bf16_f32 %0, %1, %2" : "=v"(r) : "v"(lo), "v"(hi)); return r; }
typedef float f32x2 __attribute__((ext_vector_type(2)));
__device__ __forceinline__ f32x2 gelu_pk(f32x2 v) {
    const f32x2 av = __builtin_elementwise_abs(v), d = av * 0.2316418882f + 1.0f;
    f32x2 t; t.x = __builtin_amdgcn_rcpf(d.x); t.y = __builtin_amdgcn_rcpf(d.y);
    f32x2 q = t * 0.5307027145f + (-0.7265760135f); q = q * t + 0.7107068705f; q = q * t + (-0.142248368f); q = q * t + 0.127414796f; q = q * t;
    const f32x2 s = (v * v) * (-0.72134752044f);
    f32x2 e; e.x = __builtin_amdgcn_exp2f(s.x); e.y = __builtin_amdgcn_exp2f(s.y);
    const f32x2 m = v * (q * e), r = v - m;
    f32x2 o; o.x = v.x < 0.f ? m.x : r.x; o.y = v.y < 0.f ? m.y : r.y; return o;
}

template <int ACT  > struct EpiBf16 {
    static constexpr bool PERM = true, AFTER_DRAIN = false; static_assert(ACT == 0 || ACT == 1, "EpiBf16: ACT is 0 (none) or 1 (gelu_pk)");
    bf16_t* O; int ldc; const float* bias; int split_cols; size_t split_stride; float scale0;
    __device__ __forceinline__ void operator()(const f32x4 (&acc)[2][2][4][2], const Unit& u, int wr, int wc, int fr, int fq) const {
        const int row0 = u.pm * BM + wr * 64 + fr; int colt = u.pn * BM; bf16_t* base = O;
        float sc = 1.f; if (split_cols) { const int t = colt / split_cols; base += (size_t)t * split_stride; colt -= t * split_cols; if (t == 0) sc = scale0; }
        const int col0 = colt + wc * 32 + 8 * fq, bcol0 = u.pn * BM + wc * 32 + 8 * fq; const __amdgpu_buffer_rsrc_t rs_ = PG8_RSRC(base);
        f32x4 bv[2][2];
#pragma unroll
        for (int bj = 0; bj < 2; ++bj)
#pragma unroll
            for (int n = 0; n < 2; ++n) bv[bj][n] = bias ? *(const f32x4*)(bias + bcol0 + bj * HALF + 4 * n) : (f32x4){0.f, 0.f, 0.f, 0.f};
#pragma unroll
        for (int ai = 0; ai < 2; ++ai)
#pragma unroll
            for (int m = 0; m < 4; ++m) { bf16_t* rowp = base + (size_t)(row0 + ai * HALF + m * 16) * ldc + col0;
#pragma unroll
                for (int bj = 0; bj < 2; ++bj) { f32x4 v0 = acc[ai][bj][m][0] + bv[bj][0], v1 = acc[ai][bj][m][1] + bv[bj][1];
                    if (ACT == 1) { f32x2 a = gelu_pk((f32x2){v0[0], v0[1]}), b = gelu_pk((f32x2){v0[2], v0[3]}), c = gelu_pk((f32x2){v1[0], v1[1]}), d = gelu_pk((f32x2){v1[2], v1[3]});
                        v0 = (f32x4){a.x, a.y, b.x, b.y}; v1 = (f32x4){c.x, c.y, d.x, d.y}; }
                    v0 = v0 * sc; v1 = v1 * sc; u32x4 w; w.x = cvt_pk_bf16(v0[0], v0[1]); w.y = cvt_pk_bf16(v0[2], v0[3]); w.z = cvt_pk_bf16(v1[0], v1[1]); w.w = cvt_pk_bf16(v1[2], v1[3]);
                    PG8_ST16(rs_, base, rowp + bj * HALF, w); } }
    }
};
struct EpiResF32 {
    static constexpr bool PERM = false, AFTER_DRAIN = false;
    const float* base; float* out; int ldc; float* rowss;
    __device__ __forceinline__ void operator()(const f32x4 (&acc)[2][2][4][2], const Unit& u, int wr, int wc, int fr, int fq) const {
        const int row0 = u.pm * BM + wr * 64 + fr, col0 = u.pn * BM + wc * 32 + 4 * fq;
#pragma unroll
        for (int ai = 0; ai < 2; ++ai)
#pragma unroll
            for (int m = 0; m < 4; ++m) { const size_t off = (size_t)(row0 + ai * HALF + m * 16) * ldc + col0; float ssq = 0.f;
#pragma unroll
                for (int bj = 0; bj < 2; ++bj)
#pragma unroll
                    for (int n = 0; n < 2; ++n) { const f32x4 b = *(const f32x4*)(base + off + bj * HALF + n * 16); const f32x4 o = b + acc[ai][bj][m][n]; *(f32x4*)(out + off + bj * HALF + n * 16) = o;
                        ssq += (o[0] * o[0] + o[1] * o[1]) + (o[2] * o[2] + o[3] * o[3]); }
                ssq += __shfl_xor(ssq, 16); ssq += __shfl_xor(ssq, 32);
                if (fq == 0) rowss[(size_t)(row0 + ai * HALF + m * 16) * 32 + 4 * u.pn + wc] = ssq; }
    }
};
template <bool BASE_F32> struct EpiResBf16 {
    static constexpr bool PERM = true, AFTER_DRAIN = false;
    const void* base; bf16_t* out; int ldc; float* rowss;
    __device__ __forceinline__ void operator()(const f32x4 (&acc)[2][2][4][2], const Unit& u, int wr, int wc, int fr, int fq) const {
        const int row0 = u.pm * BM + wr * 64 + fr, col0 = u.pn * BM + wc * 32 + 8 * fq; const __amdgpu_buffer_rsrc_t rs_ = PG8_RSRC(out);
#pragma unroll
        for (int ai = 0; ai < 2; ++ai) {
            f32x4 b0[4][2], b1[4][2];
#pragma unroll
            for (int m = 0; m < 4; ++m) { const size_t off = (size_t)(row0 + ai * HALF + m * 16) * ldc + col0;
#pragma unroll
                for (int bj = 0; bj < 2; ++bj) {
                    if (BASE_F32) { b0[m][bj] = *(const f32x4*)((const float*)base + off + bj * HALF); b1[m][bj] = *(const f32x4*)((const float*)base + off + bj * HALF + 4); }
                    else { const u32x4 q = *(const u32x4*)((const bf16_t*)base + off + bj * HALF);
                        b0[m][bj] = (f32x4){__uint_as_float(q.x << 16), __uint_as_float(q.x & 0xffff0000u), __uint_as_float(q.y << 16), __uint_as_float(q.y & 0xffff0000u)};
                        b1[m][bj] = (f32x4){__uint_as_float(q.z << 16), __uint_as_float(q.z & 0xffff0000u), __uint_as_float(q.w << 16), __uint_as_float(q.w & 0xffff0000u)}; } } }
            asm volatile("" ::: "memory");
#pragma unroll
            for (int m = 0; m < 4; ++m) { const size_t off = (size_t)(row0 + ai * HALF + m * 16) * ldc + col0; float ssq = 0.f;
#pragma unroll
                for (int bj = 0; bj < 2; ++bj) {
                    const f32x4 o0 = b0[m][bj] + acc[ai][bj][m][0], o1 = b1[m][bj] + acc[ai][bj][m][1];
                    ssq += ((o0[0] * o0[0] + o0[1] * o0[1]) + (o0[2] * o0[2] + o0[3] * o0[3])) + ((o1[0] * o1[0] + o1[1] * o1[1]) + (o1[2] * o1[2] + o1[3] * o1[3]));
                    u32x4 w; w.x = cvt_pk_bf16(o0[0], o0[1]); w.y = cvt_pk_bf16(o0[2], o0[3]); w.z = cvt_pk_bf16(o1[0], o1[1]); w.w = cvt_pk_bf16(o1[2], o1[3]);
                    PG8_ST16(rs_, out, out + off + bj * HALF, w); }
                ssq += __shfl_xor(ssq, 16); ssq += __shfl_xor(ssq, 32);
                if (fq == 0) rowss[(size_t)(row0 + ai * HALF + m * 16) * 32 + 4 * u.pn + wc] = ssq; }
            asm volatile("" ::: "memory");
        }
    }
};
__device__ __forceinline__ float silu_f(float a) { return a * __builtin_amdgcn_rcpf(1.0f + __builtin_amdgcn_exp2f(-1.4426950408889634f * a)); }
struct EpiSiluMul {
    static constexpr bool PERM = true, AFTER_DRAIN = false;
    bf16_t* O; int ldc;
    __device__ __forceinline__ void operator()(const f32x4 (&acc)[2][2][4][2], const Unit& u, int wr, int wc, int fr, int fq) const {
        const int row0 = u.pm * BM + wr * 64 + fr, col0 = (u.pn & 3) * HALF + wc * 32 + 8 * fq; const __amdgpu_buffer_rsrc_t rs_ = PG8_RSRC(O);
#pragma unroll
        for (int ai = 0; ai < 2; ++ai)
#pragma unroll
            for (int m = 0; m < 4; ++m) { bf16_t* rowp = O + (size_t)(row0 + ai * HALF + m * 16) * ldc + col0;
                const f32x4 a0 = acc[ai][0][m][0], a1 = acc[ai][0][m][1], b0 = acc[ai][1][m][0], b1 = acc[ai][1][m][1];
                u32x4 w; w.x = cvt_pk_bf16(silu_f(a0[0]) * b0[0], silu_f(a0[1]) * b0[1]); w.y = cvt_pk_bf16(silu_f(a0[2]) * b0[2], silu_f(a0[3]) * b0[3]);
                w.z = cvt_pk_bf16(silu_f(a1[0]) * b1[0], silu_f(a1[1]) * b1[1]); w.w = cvt_pk_bf16(silu_f(a1[2]) * b1[2], silu_f(a1[3]) * b1[3]);
                PG8_ST16(rs_, O, rowp, w); }
    }
};
__device__ __forceinline__ unsigned pk4_fp8(float a, float b, float c, float d) {
    a = __builtin_fminf(__builtin_fmaxf(a, -448.f), 448.f); b = __builtin_fminf(__builtin_fmaxf(b, -448.f), 448.f); c = __builtin_fminf(__builtin_fmaxf(c, -448.f), 448.f); d = __builtin_fminf(__builtin_fmaxf(d, -448.f), 448.f);
    int w = 0; w = __builtin_amdgcn_cvt_pk_fp8_f32(a, b, w, false); w = __builtin_amdgcn_cvt_pk_fp8_f32(c, d, w, true); return (unsigned)w; }
struct EpiSiluMul8 {
    static constexpr bool PERM = true, AFTER_DRAIN = false;
    unsigned char* O; int ldc; float inv, osc;
    __device__ __forceinline__ void operator()(const f32x4 (&acc)[2][2][4][2], const Unit& u, int wr, int wc, int fr, int fq) const {
        typedef unsigned u32x2 __attribute__((ext_vector_type(2)));
        const int row0 = u.pm * BM + wr * 64 + fr, col0 = (u.pn & 3) * HALF + wc * 32 + 8 * fq; const __amdgpu_buffer_rsrc_t rs_ = PG8_RSRC(O);
#pragma unroll
        for (int ai = 0; ai < 2; ++ai)
#pragma unroll
            for (int m = 0; m < 4; ++m) { unsigned char* rowp = O + (size_t)(row0 + ai * HALF + m * 16) * ldc + col0;
                const f32x4 a0 = acc[ai][0][m][0] * inv, a1 = acc[ai][0][m][1] * inv, b0 = acc[ai][1][m][0] * (inv * osc), b1 = acc[ai][1][m][1] * (inv * osc);
                u32x2 w; w.x = pk4_fp8(silu_f(a0[0]) * b0[0], silu_f(a0[1]) * b0[1], silu_f(a0[2]) * b0[2], silu_f(a0[3]) * b0[3]);
                w.y = pk4_fp8(silu_f(a1[0]) * b1[0], silu_f(a1[1]) * b1[1], silu_f(a1[2]) * b1[2], silu_f(a1[3]) * b1[3]);
                PG8_ST8(rs_, O, rowp, w); }
    }
};
struct EpiScatter {
    static constexpr bool PERM = true, AFTER_DRAIN = false;
    unsigned char* O; int ldc; const PG8_LAS unsigned short* nvalid; float sc;
    __device__ __forceinline__ void operator()(const f32x4 (&acc)[2][2][4][2], const Unit& u, int wr, int wc, int fr, int fq) const {
        const int rl0 = wr * 64 + fr, col0 = (u.pn & 7) * BM + wc * 64 + 16 * fq, nv = nvalid[u.pm];
        const __amdgpu_buffer_rsrc_t rs_ = PG8_RSRC(O + (size_t)u.pm * BM * ldc);
#pragma unroll
        for (int ai = 0; ai < 2; ++ai)
#pragma unroll
            for (int m = 0; m < 4; ++m) { const int rl = rl0 + ai * HALF + m * 16; if (rl < nv) {
                const f32x4 v00 = acc[ai][0][m][0] * sc, v01 = acc[ai][0][m][1] * sc, v10 = acc[ai][1][m][0] * sc, v11 = acc[ai][1][m][1] * sc;
                u32x4 w; w.x = pk4_fp8(v00[0], v00[1], v00[2], v00[3]); w.y = pk4_fp8(v01[0], v01[1], v01[2], v01[3]); w.z = pk4_fp8(v10[0], v10[1], v10[2], v10[3]); w.w = pk4_fp8(v11[0], v11[1], v11[2], v11[3]);
                __builtin_amdgcn_raw_buffer_store_b128(w, rs_, rl * ldc + col0, 0, 0); } }
    }
};
struct EpiProj {
    static constexpr bool PERM = true, AFTER_DRAIN = false;
    bf16_t* P; int ldp; bf16_t* Z; const float* rc; const float* rs; float qscale;
    __device__ __forceinline__ void operator()(const f32x4 (&acc)[2][2][4][2], const Unit& u, int wr, int wc, int fr, int fq) const {
        typedef unsigned u32x2 __attribute__((ext_vector_type(2)));
        const int row0 = u.pm * BM + wr * 64 + fr, pn = u.pn; const __amdgpu_buffer_rsrc_t rsz_ = PG8_RSRC(Z), rsp_ = PG8_RSRC(P);
        if (pn < 4) {
#pragma unroll
            for (int ai = 0; ai < 2; ++ai)
#pragma unroll
                for (int m = 0; m < 4; ++m) { bf16_t* rowp = Z + (size_t)(row0 + ai * HALF + m * 16) * 512 + pn * HALF + wc * 32 + 8 * fq;
                    const f32x4 a0 = acc[ai][0][m][0], a1 = acc[ai][0][m][1], g0 = acc[ai][1][m][0], g1 = acc[ai][1][m][1];
#define PG8_SIG(x) __builtin_amdgcn_rcpf(1.0f + __builtin_amdgcn_exp2f(-1.4426950408889634f * (x)))
                    u32x4 w; w.x = cvt_pk_bf16(a0[0] * PG8_SIG(g0[0]), a0[1] * PG8_SIG(g0[1])); w.y = cvt_pk_bf16(a0[2] * PG8_SIG(g0[2]), a0[3] * PG8_SIG(g0[3]));
                    w.z = cvt_pk_bf16(a1[0] * PG8_SIG(g1[0]), a1[1] * PG8_SIG(g1[1])); w.w = cvt_pk_bf16(a1[2] * PG8_SIG(g1[2]), a1[3] * PG8_SIG(g1[3]));
#undef PG8_SIG
                    PG8_ST16(rsz_, Z, rowp, w); }
        } else if (pn == 8 || pn >= 15) {
            const int col0 = pn * BM + wc * 32 + 8 * fq;
#pragma unroll
            for (int ai = 0; ai < 2; ++ai)
#pragma unroll
                for (int m = 0; m < 4; ++m) { bf16_t* rowp = P + (size_t)(row0 + ai * HALF + m * 16) * ldp + col0;
#pragma unroll
                    for (int bj = 0; bj < 2; ++bj) { const f32x4 v0 = acc[ai][bj][m][0], v1 = acc[ai][bj][m][1]; u32x4 w; w.x = cvt_pk_bf16(v0[0], v0[1]); w.y = cvt_pk_bf16(v0[2], v0[3]); w.z = cvt_pk_bf16(v1[0], v1[1]); w.w = cvt_pk_bf16(v1[2], v1[3]);
                        PG8_ST16(rsp_, P, rowp + bj * HALF, w); } }
        } else {
            const float sc = (pn <= 6 || (pn >= 9 && pn <= 11)) ? qscale : 1.0f;
            const int f = 16 * (wc & 1) + 4 * fq, col0 = pn * BM + 64 * (wc >> 1) + f;
#pragma unroll
            for (int ai = 0; ai < 2; ++ai) {
                f32x4 c4[4], s4[4];
#pragma unroll
                for (int m = 0; m < 4; ++m) { const int row = row0 + ai * HALF + m * 16; c4[m] = *(const f32x4*)(rc + (size_t)row * 32 + f); s4[m] = *(const f32x4*)(rs + (size_t)row * 32 + f); }
                asm volatile("" ::: "memory");
#pragma unroll
                for (int m = 0; m < 4; ++m) { const int row = row0 + ai * HALF + m * 16;
                    const f32x4 cc = c4[m] * sc, ss = s4[m] * sc;
                    bf16_t* rowp = P + (size_t)row * ldp + col0;
#pragma unroll
                    for (int bj = 0; bj < 2; ++bj) { const f32x4 x1 = acc[ai][bj][m][0], x2 = acc[ai][bj][m][1]; const f32x4 o1 = x1 * cc - x2 * ss, o2 = x2 * cc + x1 * ss;
                        u32x2 w1, w2; w1.x = cvt_pk_bf16(o1[0], o1[1]); w1.y = cvt_pk_bf16(o1[2], o1[3]); w2.x = cvt_pk_bf16(o2[0], o2[1]); w2.y = cvt_pk_bf16(o2[2], o2[3]);
                        PG8_ST8(rsp_, P, rowp + bj * HALF, w1); PG8_ST8(rsp_, P, rowp + bj * HALF + 32, w2); } }
                asm volatile("" ::: "memory"); }
        }
    }
};
struct EpiNull {
    static constexpr bool PERM = true, AFTER_DRAIN = false;
    __device__ __forceinline__ void operator()(const f32x4 (&acc)[2][2][4][2], const Unit&, int, int, int, int) const {
#pragma unroll
        for (int ai = 0; ai < 2; ++ai)
#pragma unroll
            for (int bj = 0; bj < 2; ++bj)
#pragma unroll
                for (int m = 0; m < 4; ++m)
#pragma unroll
                    for (int n = 0; n < 2; ++n) asm volatile("" :: "v"(acc[ai][bj][m][n]));
    }
};
struct GroupedOrder {
    const PG8_LAS int* tab; int ntiles, NC, G, c;
    __device__ __forceinline__ bool next(int i, Unit& u) const {
        const int L = i * G + c; if (L >= ntiles * NC) return false;
        const int rt = L / NC, j = L - rt * NC; u.pm = rt; u.pn = tab[rt] * NC + j; u.ui = i; return true;
    }
    __device__ __forceinline__ void a_ready(const Unit&) const {}
    __device__ __forceinline__ void done(const Unit&) const {}
};
template <class Epi, class Sched, bool ALIGN_EPI = false, bool SP2 = false, bool GATHER = false, bool FP8 = false>
__device__ __forceinline__ void gemm_phase(PG8_LAS unsigned char* lds, const Gemm g, const Sched& S, const Epi& E, int tid_in  , const PG8_LAS unsigned* gofs = nullptr) {
    static_assert(!GATHER || SP2, "GATHER is wired into the SP2 loop only");
    int tid_ = tid_in; asm volatile("" : "+v"(tid_));
    const int tid = tid_, wid = __builtin_amdgcn_readfirstlane(tid >> 6), lane = tid & 63, wr = wid >> 2, wc = wid & 3, fr = lane & 15, fq = lane >> 4;
    int K_ = g.K; asm volatile("" : "+s"(K_));
    const int K = K_, nt = K / BK;
    unsigned voffA[2], voffB[2];
#pragma unroll
    for (int i = 0; i < 2; ++i) { int R, C; stage_rc(tid * 16 + i * 8192, R, C); const int Rb = Epi::PERM ? ((R & ~31) + perm32(R & 31)) : R;
        voffA[i] = (unsigned)(R * K + C) * 2u; voffB[i] = (unsigned)(Rb * K + C) * 2u; }
    int gL[2], gC[2];
#pragma unroll
    for (int i = 0; i < 2; ++i) { int R, C; stage_rc(tid * 16 + i * 8192, R, C); gL[i] = R; gC[i] = C * 2; }
    const size_t kstep = (size_t)(BK * 2);
    const size_t hstep = (size_t)HALF * K * 2;
    const size_t tstep = 2 * hstep;
    const unsigned ldsw = (unsigned)wid * 1024u;
    const int aoff = lds_byte(wr * 64 + fr, fq * 8), boff = lds_byte(wc * 32 + fr, fq * 8);
#define PG8_SA(b, h) (((b) * 2 + (h)) * HTB)
#define PG8_SB(b, h) ((4 + (b) * 2 + (h)) * HTB)
#define PG8_STAGE(bufoff, gbase, voff) do { _Pragma("unroll") for (int _i = 0; _i < 2; ++_i) \
        __builtin_amdgcn_global_load_lds((const unsigned*)((const char*)(gbase) + (voff)[_i]), (PG8_LAS unsigned*)(lds + (bufoff) + ldsw + _i * 8192), 16, 0, 0); } while (0)
#define PG8_STAGE_A(bufoff, ptr, h, nx) do { if constexpr (GATHER) { const int ub_ = ((nx) ? gnext : ui) * 256 + (h) * 128; unsigned vv_[2]; _Pragma("unroll") for (int _j = 0; _j < 2; ++_j) vv_[_j] = gofs[ub_ + gL[_j]] + (unsigned)gC[_j]; PG8_STAGE(bufoff, ptr, vv_); } \
        else { PG8_STAGE(bufoff, (ptr) + (size_t)(h) * hstep, voffA); } } while (0)
#define PG8_LDA(dst, b, h) do { _Pragma("unroll") for (int m = 0; m < 4; ++m) _Pragma("unroll") for (int k = 0; k < 2; ++k) dst[m][k] = *(const PG8_LAS bf16x8*)(lds + PG8_SA(b, h) + aoff + m * 2048 + k * 1024); } while (0)
#define PG8_LDB(dst, b, h) do { _Pragma("unroll") for (int n = 0; n < 2; ++n) _Pragma("unroll") for (int k = 0; k < 2; ++k) dst[n][k] = *(const PG8_LAS bf16x8*)(lds + PG8_SB(b, h) + boff + n * 2048 + k * 1024); } while (0)
#define PG8_CAT(x0, x1) __builtin_shufflevector(__builtin_bit_cast(pg8_i4, x0), __builtin_bit_cast(pg8_i4, x1), 0, 1, 2, 3, 4, 5, 6, 7)
#define PG8_MMA(ai, bj, At, Bt) do { __builtin_amdgcn_s_setprio(1); if constexpr (FP8) { _Pragma("unroll") for (int m = 0; m < 4; ++m) _Pragma("unroll") for (int n = 0; n < 2; ++n) \
        { const pg8_i8 b8_ = PG8_CAT(Bt[n][0], Bt[n][1]), a8_ = PG8_CAT(At[m][0], At[m][1]); asm volatile("v_mfma_f32_16x16x128_f8f6f4 %0, %1, %2, %0" : "+v"(acc[ai][bj][m][n]) : "v"(b8_), "v"(a8_)); } } \
        else { _Pragma("unroll") for (int m = 0; m < 4; ++m) _Pragma("unroll") for (int n = 0; n < 2; ++n) _Pragma("unroll") for (int k = 0; k < 2; ++k) \
        acc[ai][bj][m][n] = __builtin_amdgcn_mfma_f32_16x16x32_bf16(Bt[n][k], At[m][k], acc[ai][bj][m][n], 0, 0, 0); } __builtin_amdgcn_s_setprio(0); } while (0)
#define PG8_WAIT_V(n) asm volatile("s_waitcnt vmcnt(" #n ")" ::: "memory")
#define PG8_WAIT_L(n) asm volatile("s_waitcnt lgkmcnt(" #n ")" ::: "memory")
#define PG8_BAR __builtin_amdgcn_s_barrier()
#define PG8_SCHED __builtin_amdgcn_sched_barrier(0)
    Unit cur, nxt; int ui = 0;
    if (!S.next(0, cur)) return;
    f32x4 acc[2][2][4][2];
#pragma unroll
    for (int a = 0; a < 2; ++a)
#pragma unroll
        for (int b = 0; b < 2; ++b)
#pragma unroll
            for (int m = 0; m < 4; ++m)
#pragma unroll
                for (int n = 0; n < 2; ++n) acc[a][b][m][n] = (f32x4){0.f, 0.f, 0.f, 0.f};
    bf16x8 At[4][2], B0[2][2], B1[2][2];
    const char* cA = GATHER ? (const char*)g.A : (const char*)g.A + (size_t)cur.pm * tstep; int gnext = 0;
    const char* cB = (const char*)g.Bt + (size_t)cur.pn * tstep;
    S.a_ready(cur);
    if constexpr (SP2) {
        PG8_STAGE(PG8_SB(0, 0), cB, voffB); PG8_STAGE(PG8_SB(0, 1), cB + hstep, voffB); PG8_STAGE_A(PG8_SA(0, 0), cA, 0, false); PG8_STAGE_A(PG8_SA(0, 1), cA, 1, false);
        if (wr == 1) PG8_BAR;
        PG8_WAIT_V(2); PG8_BAR;
        PG8_STAGE(PG8_SB(1, 0), cB + kstep, voffB); PG8_STAGE_A(PG8_SA(1, 0), cA + kstep, 0, false); PG8_STAGE(PG8_SB(1, 1), cB + hstep + kstep, voffB);
        PG8_WAIT_V(6); PG8_BAR;
    } else {
        PG8_STAGE(PG8_SB(0, 0), cB, voffB); PG8_STAGE(PG8_SA(0, 0), cA, voffA); PG8_STAGE(PG8_SB(0, 1), cB + hstep, voffB); PG8_STAGE(PG8_SA(0, 1), cA + hstep, voffA);
        if (wr == 1) PG8_BAR;
        PG8_WAIT_V(4); PG8_BAR;
        PG8_STAGE(PG8_SB(1, 0), cB + kstep, voffB); PG8_STAGE(PG8_SA(1, 0), cA + kstep, voffA); PG8_STAGE(PG8_SB(1, 1), cB + hstep + kstep, voffB);
        PG8_WAIT_V(6); PG8_BAR;
    }
    for (;;) {
        const bool has_next = S.next(ui + 1, nxt);
        const char* nA = (has_next && !GATHER) ? (const char*)g.A + (size_t)nxt.pm * tstep : cA;
        gnext = has_next ? ui + 1 : ui;
        const char* nB = has_next ? (const char*)g.Bt + (size_t)nxt.pn * tstep : cB;
        for (int t = 0; t < nt; t += 2) {
            const bool last = (t == nt - 2);
            const char* a1 = cA + (size_t)(t + 1) * kstep;
            const char* a2 = last ? nA : cA + (size_t)(t + 2) * kstep; const char* b2 = last ? nB : cB + (size_t)(t + 2) * kstep;
            const char* a3 = a2 + kstep; const char* b3 = b2 + kstep;
            if (last && has_next) S.a_ready(nxt);
            if constexpr (SP2) {
            PG8_LDB(B0, 0, 0); PG8_LDB(B1, 0, 1); PG8_SCHED; PG8_LDA(At, 0, 0); PG8_STAGE_A(PG8_SA(1, 1), a1, 1, false);
            PG8_WAIT_V(8); PG8_WAIT_L(0); PG8_BAR; PG8_MMA(0, 0, At, B0); PG8_MMA(0, 1, At, B1); PG8_BAR; PG8_SCHED;
            PG8_LDA(At, 0, 1); PG8_STAGE(PG8_SB(0, 0), b2, voffB); PG8_STAGE(PG8_SB(0, 1), b2 + hstep, voffB); PG8_STAGE_A(PG8_SA(0, 0), a2, 0, last);
            PG8_WAIT_V(8); PG8_WAIT_L(0); PG8_BAR; PG8_MMA(1, 0, At, B0); PG8_MMA(1, 1, At, B1); PG8_BAR; PG8_SCHED;
            PG8_LDB(B0, 1, 0); PG8_LDB(B1, 1, 1); PG8_SCHED; PG8_LDA(At, 1, 0); PG8_STAGE_A(PG8_SA(0, 1), a2, 1, last);
            PG8_WAIT_V(8); PG8_WAIT_L(0); PG8_BAR; PG8_MMA(0, 0, At, B0); PG8_MMA(0, 1, At, B1); PG8_BAR; PG8_SCHED;
            PG8_LDA(At, 1, 1); PG8_STAGE(PG8_SB(1, 0), b3, voffB); PG8_STAGE(PG8_SB(1, 1), b3 + hstep, voffB); PG8_STAGE_A(PG8_SA(1, 0), a3, 0, last);
            PG8_WAIT_V(8); PG8_WAIT_L(0); PG8_BAR; PG8_MMA(1, 0, At, B0); PG8_MMA(1, 1, At, B1); PG8_BAR; PG8_SCHED;
            } else {
            PG8_LDB(B0, 0, 0); PG8_SCHED; PG8_LDA(At, 0, 0); PG8_STAGE(PG8_SA(1, 1), a1 + hstep, voffA);
            PG8_WAIT_L(8); PG8_BAR; PG8_WAIT_L(0); PG8_MMA(0, 0, At, B0); PG8_BAR; PG8_SCHED;
            PG8_LDB(B1, 0, 1); PG8_STAGE(PG8_SB(0, 0), b2, voffB);
            PG8_BAR; PG8_WAIT_L(0); PG8_MMA(0, 1, At, B1); PG8_BAR;
            PG8_LDA(At, 0, 1); PG8_STAGE(PG8_SA(0, 0), a2, voffA);
            PG8_BAR; PG8_WAIT_L(0); PG8_MMA(1, 0, At, B0); PG8_BAR; PG8_SCHED;
            PG8_STAGE(PG8_SB(0, 1), b2 + hstep, voffB);
            PG8_WAIT_V(6); PG8_BAR; PG8_MMA(1, 1, At, B1); PG8_BAR;
            PG8_LDB(B0, 1, 0); PG8_SCHED; PG8_LDA(At, 1, 0); PG8_STAGE(PG8_SA(0, 1), a2 + hstep, voffA);
            PG8_WAIT_L(8); PG8_BAR; PG8_WAIT_L(0); PG8_MMA(0, 0, At, B0); PG8_BAR; PG8_SCHED;
            PG8_LDB(B1, 1, 1); PG8_STAGE(PG8_SB(1, 0), b3, voffB);
            PG8_BAR; PG8_WAIT_L(0); PG8_MMA(0, 1, At, B1); PG8_BAR;
            PG8_LDA(At, 1, 1); PG8_STAGE(PG8_SA(1, 0), a3, voffA);
            PG8_BAR; PG8_WAIT_L(0); PG8_MMA(1, 0, At, B0); PG8_BAR; PG8_SCHED;
            PG8_STAGE(PG8_SB(1, 1), b3 + hstep, voffB);
            PG8_WAIT_V(6); PG8_BAR; PG8_MMA(1, 1, At, B1); PG8_BAR;
            }
        }
        if constexpr (FP8) asm volatile("s_nop 15\n\ts_nop 15" ::: "memory");
        if constexpr (ALIGN_EPI) { if (wr == 0) PG8_BAR; }
        if constexpr (!Epi::AFTER_DRAIN) { E(acc, cur, wr, wc, fr, fq); S.done(cur); }
        if (!has_next) break;
#pragma unroll
        for (int a = 0; a < 2; ++a)
#pragma unroll
            for (int b = 0; b < 2; ++b)
#pragma unroll
                for (int m = 0; m < 4; ++m)
#pragma unroll
                    for (int n = 0; n < 2; ++n) acc[a][b][m][n] = (f32x4){0.f, 0.f, 0.f, 0.f};
        cur = nxt; cA = nA; cB = nB; ++ui;
        if constexpr (ALIGN_EPI) { if (wr == 1) PG8_BAR; }
    }
    PG8_WAIT_V(0);
    if constexpr (!ALIGN_EPI) { if (wr == 0) PG8_BAR; }
    PG8_BAR;
    if constexpr (Epi::AFTER_DRAIN) { E.fused(acc, cur, wr, wc, fr, fq, lds, wid, lane); S.done(cur); }
#undef PG8_SA
#undef PG8_STAGE_A
#undef PG8_SB
#undef PG8_STAGE
#undef PG8_LDA
#undef PG8_LDB
#undef PG8_MMA
#undef PG8_CAT
#undef PG8_WAIT_V
#undef PG8_WAIT_L
#undef PG8_BAR
#undef PG8_SCHED
}
}
#include <hip/hip_bf16.h>
#include <cmath>
namespace attn_body {
using bf16=__hip_bfloat16;
using bf16x8=__attribute__((ext_vector_type(8)))short;
using s16x4=__attribute__((ext_vector_type(4)))short;
using f32x16=__attribute__((ext_vector_type(16)))float;
using u32x4=__attribute__((ext_vector_type(4)))unsigned;
constexpr int SEQ=2048,D=64,PQ=4608,PO=1536;
constexpr int NW=8,QBLK=32,QB=QBLK*NW,KVBLK=64,NQB=SEQ/QB;
constexpr int ATTN_UNIT_ROWS=QB;
__device__ __forceinline__ int crow(int r,int hi){return (r&3)+8*(r>>2)+4*hi;}
#define SBAR() __builtin_amdgcn_sched_barrier(0)
__device__ __forceinline__ void cmask(f32x16&p0,f32x16&p1,int jb,int qrel,int hi){
  const float NEG=-INFINITY; int kb=64*jb+4*hi;
  #pragma unroll
  for(int r=0;r<16;++r){int kv=kb+(r&3)+8*(r>>2); if(kv>qrel)p0[r]=NEG; if(kv+32>qrel)p1[r]=NEG;}
}

constexpr int NSLOT=3, SLOTB=8192;
constexpr int LDS_K=0, LDS_V=NSLOT*SLOTB, LDS_WS=2*NSLOT*SLOTB, LDS_OST=LDS_WS+NW*64*4, LDS_BYTES=LDS_OST+NW*4096;
constexpr float C2=0.125f*1.4426950408889634f;
__device__ __forceinline__ void glds16(const void*gsrc,unsigned lds_dst){unsigned keep;
  asm volatile("s_mov_b32 %0, m0\n\ts_mov_b32 m0, %2\n\ts_nop 0\n\tglobal_load_lds_dwordx4 %1, off\n\ts_mov_b32 m0, %0":"=&s"(keep):"v"(gsrc),"s"(lds_dst):"memory");}
__device__ __forceinline__ float max3f(float a,float b,float c){float r;asm("v_max3_f32 %0, %1, %2, %3":"=v"(r):"v"(a),"v"(b),"v"(c));return r;}
__device__ __forceinline__ float max2f(float a,float b){float r;asm("v_max_f32_e32 %0, %1, %2":"=v"(r):"v"(a),"v"(b));return r;}
__device__ __forceinline__ float fadd_s(float a,float b){float r;asm("v_add_f32_e32 %0, %1, %2":"=v"(r):"v"(a),"v"(b));return r;}
__device__ __forceinline__ float fsub_s(float a,float b){float r;asm("v_sub_f32_e32 %0, %1, %2":"=v"(r):"v"(a),"v"(b));return r;}
typedef float f32x2_t __attribute__((ext_vector_type(2))); typedef __bf16 bf16x2_t __attribute__((ext_vector_type(2)));
__device__ __forceinline__ unsigned cvtpk_s(float lo,float hi){f32x2_t v={lo,hi};bf16x2_t b=__builtin_convertvector(v,bf16x2_t);return __builtin_bit_cast(unsigned,b);}
#define WAIT_BAR(N) asm volatile("s_waitcnt vmcnt(" #N ") lgkmcnt(0)\n\ts_barrier":::"memory")

__device__ __forceinline__ void qkt(f32x16&p0,f32x16&p1,const char*Kslot,const bf16x8*qr,const f32x16&negm,int r32,int hi){
  const char*kb=Kslot+hi*1024+r32*16;
  #pragma unroll
  for(int d0=0;d0<4;++d0){
    const bf16x8 b0=*reinterpret_cast<const bf16x8*>(kb+d0*2048);
    const bf16x8 b1=*reinterpret_cast<const bf16x8*>(kb+d0*2048+512);
    if(d0==0){p0=__builtin_amdgcn_mfma_f32_32x32x16_bf16(b0,qr[0],negm,0,0,0);p1=__builtin_amdgcn_mfma_f32_32x32x16_bf16(b1,qr[0],negm,0,0,0);}
    else{p0=__builtin_amdgcn_mfma_f32_32x32x16_bf16(b0,qr[d0],p0,0,0,0);p1=__builtin_amdgcn_mfma_f32_32x32x16_bf16(b1,qr[d0],p1,0,0,0);}}
}
typedef __attribute__((address_space(3))) const char* lds_cptr;
typedef short v4i16_t __attribute__((ext_vector_type(4)));
__device__ __forceinline__ void kload8(bf16x8*kf,lds_cptr kp){
  kf[0]=*(const __attribute__((address_space(3))) bf16x8*)(kp);      kf[1]=*(const __attribute__((address_space(3))) bf16x8*)(kp+512);
  kf[2]=*(const __attribute__((address_space(3))) bf16x8*)(kp+2048); kf[3]=*(const __attribute__((address_space(3))) bf16x8*)(kp+2560);
  kf[4]=*(const __attribute__((address_space(3))) bf16x8*)(kp+4096); kf[5]=*(const __attribute__((address_space(3))) bf16x8*)(kp+4608);
  kf[6]=*(const __attribute__((address_space(3))) bf16x8*)(kp+6144); kf[7]=*(const __attribute__((address_space(3))) bf16x8*)(kp+6656);
}
__device__ __forceinline__ void kload2(bf16x8*kf,lds_cptr kp,int j){ kf[2*j]=*(const __attribute__((address_space(3))) bf16x8*)(kp+j*2048); kf[2*j+1]=*(const __attribute__((address_space(3))) bf16x8*)(kp+j*2048+512); }
__device__ __forceinline__ s16x4 vtr(lds_cptr p){ return __builtin_bit_cast(s16x4,__builtin_amdgcn_ds_read_tr16_b64_v4i16((__attribute__((address_space(3))) v4i16_t*)p)); }
__device__ __forceinline__ float rowmax(const f32x16&p0,const f32x16&p1){
  float a=max3f(p0[0],p0[1],p1[0]),b=max3f(p0[2],p0[3],p1[1]);a=max3f(a,p1[2],p1[3]);
  #pragma unroll
  for(int r=4;r<16;r+=4){a=max3f(a,p0[r],p0[r+1]);b=max3f(b,p0[r+2],p0[r+3]);a=max3f(a,p1[r],p1[r+1]);b=max3f(b,p1[r+2],p1[r+3]);}
  const float m=max2f(a,b);
  auto rr=__builtin_amdgcn_permlane32_swap(__float_as_uint(m),__float_as_uint(m),false,false);
  return max2f(__uint_as_float(rr[0]),__uint_as_float(rr[1]));
}
__device__ __forceinline__ void pv(f32x16*o,int vb,bf16x8 pa0,bf16x8 pa1,bf16x8 pa2,bf16x8 pa3){
  #pragma unroll
  for(int d0=0;d0<2;++d0){s16x4 lo[4],hi[4];
    #pragma unroll
    for(int ks=0;ks<4;++ks){
      asm volatile("ds_read_b64_tr_b16 %0,%1 offset:%c2":"=&v"(lo[ks]):"v"(vb),"i"(d0*4096+ks*1024):"memory");
      asm volatile("ds_read_b64_tr_b16 %0,%1 offset:%c2":"=&v"(hi[ks]):"v"(vb),"i"(d0*4096+ks*1024+512):"memory");}
    asm volatile("s_waitcnt lgkmcnt(0)":::"memory");SBAR();
    #define PK(k) (bf16x8){lo[k][0],lo[k][1],lo[k][2],lo[k][3],hi[k][0],hi[k][1],hi[k][2],hi[k][3]}
    o[d0]=__builtin_amdgcn_mfma_f32_32x32x16_bf16(pa0,PK(0),o[d0],0,0,0);
    o[d0]=__builtin_amdgcn_mfma_f32_32x32x16_bf16(pa1,PK(1),o[d0],0,0,0);
    o[d0]=__builtin_amdgcn_mfma_f32_32x32x16_bf16(pa2,PK(2),o[d0],0,0,0);
    o[d0]=__builtin_amdgcn_mfma_f32_32x32x16_bf16(pa3,PK(3),o[d0],0,0,0);
    #undef PK
  }
}

#ifndef ATTN_STORE16
#define ATTN_STORE16(p,v) (*(u32x4*)(p)=(v))
#endif
template<int THRL> __device__ __forceinline__ void attn_unit(int b,int qb,const bf16*Q,const bf16*__restrict__ K,const bf16*__restrict__ V,bf16*O,char*shm,int tid_in){
  int tid_=tid_in; asm volatile("":"+v"(tid_));
  const int tid=tid_,lane=tid&63,r32=lane&31,hi=lane>>5; const int wid=__builtin_amdgcn_readfirstlane(tid>>6);
  const long rowbase=(long)b*SEQ; const int q0=qb*QB;
  const bf16*Qw=Q+(rowbase+q0+wid*QBLK)*PQ;
  const bf16*Kh=K+rowbase*PQ,*Vh=V+rowbase*PQ;
  const unsigned lds0=(unsigned)(uintptr_t)shm;
  float*wsf=(float*)(shm+LDS_WS)+wid*64;
  const bf16*ksrc=Kh+(long)lane*PQ+wid*8;
  const bf16*vsrc=Vh+(long)(16*(wid&3)+(lane>>2))*PQ+(wid>>2)*32+(lane&3)*8;
  const unsigned kdst=lds0+LDS_K+wid*1024, vdst=lds0+LDS_V+wid*1024;
  #define DMA_K(t,slot) glds16(ksrc+(long)(t)*KVBLK*PQ,(unsigned)__builtin_amdgcn_readfirstlane(kdst+(slot)))
  #define DMA_V(t,slot) glds16(vsrc+(long)(t)*KVBLK*PQ,(unsigned)__builtin_amdgcn_readfirstlane(vdst+(slot)))
  const int vb0=(int)(lds0+LDS_V)+((lane>>4)&1)*32+(lane&3)*8+(4*hi+((lane&15)>>2))*64;
  const char*Kbase=shm+LDS_K; bf16x8 kf[8];
  const lds_cptr shm3=(lds_cptr)shm; const lds_cptr kp0=shm3+LDS_K+hi*1024+r32*16; const lds_cptr vp0=shm3+LDS_V+((lane>>4)&1)*32+(lane&3)*8+(4*hi+((lane&15)>>2))*64;
  const int NT=(q0+QB)/KVBLK;
  DMA_K(0,0);DMA_V(0,0);DMA_K(1,SLOTB);
  bf16x8 qr[4];
  #pragma unroll
  for(int d0=0;d0<4;++d0)qr[d0]=*reinterpret_cast<const bf16x8*>(&Qw[(long)r32*PQ+d0*16+hi*8]);
  float mhat=0.f,l_reg=0.f;f32x16 o[2];o[0]=f32x16{};o[1]=f32x16{};f32x16 negm=f32x16{};asm volatile("":"+v"(negm));
  const int qrel=wid*QBLK+r32;
  #define CMASK(P0,P1,t) do{int jb_=(t)-(NT-4); if(jb_>=0)cmask(P0,P1,jb_,qrel,hi);}while(0)
  bool resc=false;
  #define START(P0,P1) do{ const float rm=rowmax(P0,P1); resc=false; \
    { const float dl=rm; mhat=fadd_s(mhat,dl); \
      _Pragma("unroll") for(int r=0;r<16;++r){P0[r]=fsub_s(P0[r],dl);P1[r]=fsub_s(P1[r],dl);} \
      _Pragma("unroll") for(int r=0;r<16;++r)negm[r]=-mhat; asm volatile("":"+v"(negm)); } \
    _Pragma("unroll") for(int r=0;r<16;++r)P0[r]=__builtin_amdgcn_exp2f(P0[r]); }while(0)
  #define RESC() do{ if(resc){ asm volatile("s_waitcnt lgkmcnt(0)":::"memory"); \
      _Pragma("unroll") for(int d_=0;d_<2;++d_) _Pragma("unroll") for(int r=0;r<16;++r)o[d_][r]*=wsf[crow(r,hi)]; } }while(0)
  f32x16 pA0,pA1,pB0,pB1;
  int sl_prev=0,sl_cur=0,sl_next=SLOTB;
  #define ROT() do{sl_prev=sl_cur;sl_cur=sl_next;sl_next=(sl_next==(NSLOT-1)*SLOTB)?0:sl_next+SLOTB;}while(0)
  DMA_K(2,2*SLOTB);
  WAIT_BAR(3);
  qkt(pA0,pA1,Kbase,qr,negm,r32,hi);asm volatile("s_nop 15\n\ts_nop 7":"+v"(pA0),"+v"(pA1));CMASK(pA0,pA1,0);
  START(pA0,pA1);
  _Pragma("unroll") for(int r=0;r<16;++r)pA1[r]=__builtin_amdgcn_exp2f(pA1[r]);
  WAIT_BAR(0);
  DMA_K(3,0);DMA_V(1,SLOTB);
  ROT();
  kload8(kf,kp0+sl_cur);
  WAIT_BAR(2);
  s16x4 vlo[8],vhi[8]; u32x4 pw0,pw1,pw2,pw3;
  #define PKW(P,B) cvtpk_s(P[B],P[B+1])
  #define PAF(k) __builtin_bit_cast(bf16x8,pw##k)
  #define VFR(i) (bf16x8){vlo[i][0],vlo[i][1],vlo[i][2],vlo[i][3],vhi[i][0],vhi[i][1],vhi[i][2],vhi[i][3]}
  #define PIN(x) asm volatile("":"+v"(x))
  #define MX3(a,b,c) __builtin_fmaxf(__builtin_fmaxf((a),(b)),(c))
  #define GAPA(MF,A0,A1,A2,A3,W0,W1,PW) do{ MF; sacc+=A0; sacc+=A1; sacc+=A2; sacc+=A3; PIN(sacc); W0; W1; PIN(PW); SBAR(); }while(0)
  #define EX(v) __builtin_amdgcn_exp2f(v)
  #define GAPB(MF,X,B) do{ MF; X[B]=EX(X[B]); X[B+1]=EX(X[B+1]); X[B+2]=EX(X[B+2]); X[B+3]=EX(X[B+3]); PIN(X); SBAR(); }while(0)
  #define VRD(i) do{ vlo[i]=vtr(vp_+(((i)>>2)*4096+((i)&3)*1024)); vhi[i]=vtr(vp_+(((i)>>2)*4096+((i)&3)*1024+512)); }while(0)
  #define KRD(G,j) do{ if(G){ kload2(kf,kp0+sl_next,j); SBAR(); } }while(0)
  #define STEP(C0,C1,P0,P1,t,GK,GV,GL) do{ SBAR(); \
    const lds_cptr vp_=vp0+sl_prev; \
    VRD(0); SBAR(); float sacc=(P0[0]+P0[1]); \
    GAPA(C0=__builtin_amdgcn_mfma_f32_32x32x16_bf16(kf[0],qr[0],negm,0,0,0), P0[2],P0[3],P0[4],P0[5],     pw0[0]=PKW(P0,0), pw0[1]=PKW(P0,2), pw0); \
    VRD(4); SBAR(); GAPA(C1=__builtin_amdgcn_mfma_f32_32x32x16_bf16(kf[1],qr[0],negm,0,0,0), P0[6],P0[7],P0[8],P0[9],     pw0[2]=PKW(P0,4), pw0[3]=PKW(P0,6), pw0); \
    VRD(1); SBAR(); GAPA(C0=__builtin_amdgcn_mfma_f32_32x32x16_bf16(kf[2],qr[1],C0,0,0,0),   P0[10],P0[11],P0[12],P0[13], pw1[0]=PKW(P0,8), pw1[1]=PKW(P0,10), pw1); \
    VRD(5); SBAR(); GAPA(C1=__builtin_amdgcn_mfma_f32_32x32x16_bf16(kf[3],qr[1],C1,0,0,0),   P0[14],P0[15],P1[0],P1[1],   pw1[2]=PKW(P0,12),pw1[3]=PKW(P0,14), pw1); \
    VRD(2); SBAR(); GAPA(C0=__builtin_amdgcn_mfma_f32_32x32x16_bf16(kf[4],qr[2],C0,0,0,0),   P1[2],P1[3],P1[4],P1[5],     pw2[0]=PKW(P1,0), pw2[1]=PKW(P1,2), pw2); \
    VRD(6); SBAR(); GAPA(C1=__builtin_amdgcn_mfma_f32_32x32x16_bf16(kf[5],qr[2],C1,0,0,0),   P1[6],P1[7],P1[8],P1[9],     pw2[2]=PKW(P1,4), pw2[3]=PKW(P1,6), pw2); \
    VRD(3); SBAR(); GAPA(C0=__builtin_amdgcn_mfma_f32_32x32x16_bf16(kf[6],qr[3],C0,0,0,0),   P1[10],P1[11],P1[12],P1[13], pw3[0]=PKW(P1,8), pw3[1]=PKW(P1,10), pw3); \
    VRD(7); SBAR(); GAPA(C1=__builtin_amdgcn_mfma_f32_32x32x16_bf16(kf[7],qr[3],C1,0,0,0),   P1[14],P1[15],0.f,0.f,       pw3[2]=PKW(P1,12),pw3[3]=PKW(P1,14), pw3); \
    l_reg+=sacc; \
    if(GK){DMA_K((t)+3,sl_cur);} if(GV){DMA_V((t)+1,sl_next);} \
    CMASK(C0,C1,t); \
    { float a=MX3(C0[0],C0[1],C1[0]),b=MX3(C0[2],C0[3],C1[1]); a=MX3(a,C1[2],C1[3]); \
      _Pragma("unroll") for(int r=4;r<16;r+=4){a=MX3(a,C0[r],C0[r+1]);b=MX3(b,C0[r+2],C0[r+3]);a=MX3(a,C1[r],C1[r+1]);b=MX3(b,C1[r+2],C1[r+3]);} \
      float rm=__builtin_fmaxf(a,b); { auto rr=__builtin_amdgcn_permlane32_swap(__float_as_uint(rm),__float_as_uint(rm),false,false); rm=__builtin_fmaxf(__uint_as_float(rr[0]),__uint_as_float(rr[1])); } \
      resc=false; \
      if(__builtin_expect(__any(rm>(float)THRL),0)){ const float dl=__builtin_fmaxf(rm,0.f); mhat+=dl; \
        _Pragma("unroll") for(int r=0;r<16;++r){C0[r]-=dl;C1[r]-=dl;} \
        _Pragma("unroll") for(int r=0;r<16;++r)negm[r]=-mhat; asm volatile("":"+v"(negm)); \
        const float f=__builtin_amdgcn_exp2f(-dl); l_reg*=f; if(hi==0)wsf[r32]=f; resc=true; } } \
    SBAR(); \
    GAPB(o[0]=__builtin_amdgcn_mfma_f32_32x32x16_bf16(PAF(0),VFR(0),o[0],0,0,0), C0,0); \
    GAPB(o[1]=__builtin_amdgcn_mfma_f32_32x32x16_bf16(PAF(0),VFR(4),o[1],0,0,0), C0,4); \
    KRD(GL,0); GAPB(o[0]=__builtin_amdgcn_mfma_f32_32x32x16_bf16(PAF(1),VFR(1),o[0],0,0,0), C0,8); \
    KRD(GL,1); GAPB(o[1]=__builtin_amdgcn_mfma_f32_32x32x16_bf16(PAF(1),VFR(5),o[1],0,0,0), C0,12); \
    KRD(GL,2); GAPB(o[0]=__builtin_amdgcn_mfma_f32_32x32x16_bf16(PAF(2),VFR(2),o[0],0,0,0), C1,0); \
    KRD(GL,3); GAPB(o[1]=__builtin_amdgcn_mfma_f32_32x32x16_bf16(PAF(2),VFR(6),o[1],0,0,0), C1,4); \
    GAPB(o[0]=__builtin_amdgcn_mfma_f32_32x32x16_bf16(PAF(3),VFR(3),o[0],0,0,0), C1,8); \
    GAPB(o[1]=__builtin_amdgcn_mfma_f32_32x32x16_bf16(PAF(3),VFR(7),o[1],0,0,0), C1,12); \
    }while(0)
  int t=1;
  #undef CMASK
  #define CMASK(P0,P1,t) do{}while(0)
  for(;t+5<NT;t+=2){
    STEP(pB0,pB1,pA0,pA1,t,true,true,true);     WAIT_BAR(2); RESC(); ROT();
    STEP(pA0,pA1,pB0,pB1,t+1,true,true,true);   WAIT_BAR(2); RESC(); ROT();
  }
  #undef CMASK
  #define CMASK(P0,P1,t) do{int jb_=(t)-(NT-4); if(jb_>=0)cmask(P0,P1,jb_,qrel,hi);}while(0)
  #define ENDW(tt) do{ if((tt)+3<NT){WAIT_BAR(2);} else if((tt)+2<NT){WAIT_BAR(1);} else {WAIT_BAR(0);} }while(0)
  for(;t+1<NT;t+=2){
    STEP(pB0,pB1,pA0,pA1,t,(t+3<NT),(t+1<NT),(t+1<NT));       ENDW(t);   RESC(); ROT();
    STEP(pA0,pA1,pB0,pB1,t+1,(t+4<NT),(t+2<NT),(t+2<NT));     ENDW(t+1); RESC(); ROT();
  }
  STEP(pB0,pB1,pA0,pA1,NT-1,false,false,false); RESC();
  { float sacc=pB0[0]+pB0[1]; _Pragma("unroll") for(int r=2;r<16;++r)sacc+=pB0[r]; _Pragma("unroll") for(int r=0;r<16;++r)sacc+=pB1[r]; l_reg+=sacc;
    pw0=(u32x4){PKW(pB0,0),PKW(pB0,2),PKW(pB0,4),PKW(pB0,6)};pw1=(u32x4){PKW(pB0,8),PKW(pB0,10),PKW(pB0,12),PKW(pB0,14)};pw2=(u32x4){PKW(pB1,0),PKW(pB1,2),PKW(pB1,4),PKW(pB1,6)};pw3=(u32x4){PKW(pB1,8),PKW(pB1,10),PKW(pB1,12),PKW(pB1,14)};
    SBAR(); pv(o,vb0+sl_cur,PAF(0),PAF(1),PAF(2),PAF(3)); }
  #undef PKW
  #undef PAF
  #undef VFR
  #undef PIN
  #undef MX3
  #undef GAPA
  #undef GAPB
  #undef EX
  #undef VRD
  #undef KRD
  #undef STEP
  #undef ENDW
  {auto rr=__builtin_amdgcn_permlane32_swap(__float_as_uint(l_reg),__float_as_uint(l_reg),false,false);l_reg=__uint_as_float(rr[0])+__uint_as_float(rr[1]);}
  if(hi==0)wsf[32+r32]=l_reg;asm volatile("s_waitcnt lgkmcnt(0)":::"memory");
  float rli[16];
  #pragma unroll
  for(int r=0;r<16;++r)rli[r]=__builtin_amdgcn_rcpf(wsf[32+crow(r,hi)]);
  bf16*Ow=O+(rowbase+q0+wid*QBLK)*PO;
  { bf16*stg=(bf16*)(shm+LDS_OST)+wid*2048;
    #pragma unroll
    for(int r=0;r<16;++r){const int orow=crow(r,hi);
      #pragma unroll
      for(int d0=0;d0<2;++d0)stg[orow*64+d0*32+r32]=__float2bfloat16(o[d0][r]*rli[r]);}
    asm volatile("s_waitcnt lgkmcnt(0)":::"memory");
    #pragma unroll
    for(int i=0;i<4;++i){const int row=i*8+(lane>>3),ch=lane&7; const u32x4 v=*(const u32x4*)(stg+row*64+ch*8); ATTN_STORE16(Ow+(long)row*PO+ch*8,v);} }
  asm volatile("s_waitcnt lgkmcnt(0)\n\ts_barrier":::"memory");
  #undef DMA_K
  #undef DMA_V
  #undef CMASK
  #undef START
  #undef RESC
  #undef ROT
}
constexpr int ATTN_LDS_BYTES=LDS_BYTES;
#undef SBAR
#undef WAIT_BAR
}
namespace attn_body {
#define SBAR() __builtin_amdgcn_sched_barrier(0)
#define WAIT_BAR(N) asm volatile("s_waitcnt vmcnt(" #N ") lgkmcnt(0)\n\ts_barrier":::"memory")
constexpr int VSLOTB=16384, LDS2_V=NSLOT*SLOTB, LDS2_WS=LDS2_V+NSLOT*VSLOTB, LDS2_OST=LDS2_WS+NW*64*4, LDS2_BYTES=LDS2_OST+NW*4096;
template<int THRL> __device__ __forceinline__ void attn_unit2(int b,int qb,const bf16*Q,const bf16*__restrict__ K,const bf16*__restrict__ V,bf16*O,char*shm,int tid_in){
  int tid_=tid_in; asm volatile("":"+v"(tid_));
  const int tid=tid_,lane=tid&63,r32=lane&31,hi=lane>>5; const int wid=__builtin_amdgcn_readfirstlane(tid>>6);
  const long rowbase=(long)b*SEQ; const int q0=qb*QB;
  const bf16*Qw=Q+(rowbase+q0+wid*QBLK)*PQ;
  const bf16*Kh=K+rowbase*PQ,*Vh=V+rowbase*PQ;
  const unsigned lds0=(unsigned)(uintptr_t)shm;
  float*wsf=(float*)(shm+LDS2_WS)+wid*64;
  const bf16*ksrc=Kh+(long)lane*PQ+wid*8;
  const bf16*vsrc=Vh+(long)(16*(wid&3)+(lane>>2))*PQ+(wid>>2)*32+(lane&3)*8;
  const unsigned kdst=lds0+LDS_K+wid*1024, vdst=lds0+LDS2_V+wid*1024;
  #define DMA_K(t,slot) glds16(ksrc+(long)(t)*KVBLK*PQ,(unsigned)__builtin_amdgcn_readfirstlane(kdst+(slot)))
  #define DMA_V(t,slot) do{ glds16(vsrc+(long)(t)*KVBLK*PQ,(unsigned)__builtin_amdgcn_readfirstlane(vdst+2*(slot))); glds16(vsrc+(long)(t)*KVBLK*PQ+64,(unsigned)__builtin_amdgcn_readfirstlane(vdst+2*(slot)+8192)); }while(0)
  const char*Kbase=shm+LDS_K; bf16x8 kfa[4],kfb[4];
  const lds_cptr shm3=(lds_cptr)shm; const lds_cptr kp0=shm3+LDS_K+hi*1024+r32*16; const lds_cptr vp0=shm3+LDS2_V+((lane>>4)&1)*32+(lane&3)*8+(4*hi+((lane&15)>>2))*64;
  const int NT=(q0+QB)/KVBLK;
  DMA_K(0,0);DMA_V(0,0);DMA_K(1,SLOTB);
  bf16x8 qr[4];
  #pragma unroll
  for(int d0=0;d0<4;++d0)qr[d0]=*reinterpret_cast<const bf16x8*>(&Qw[(long)r32*PQ+d0*16+hi*8]);
  float mhat=0.f,l_reg=0.f;f32x16 o[4];o[0]=f32x16{};o[1]=f32x16{};o[2]=f32x16{};o[3]=f32x16{};const f32x16 zero16=f32x16{};
  const int qrel=wid*QBLK+r32;
  #define CMASK(P0,P1,t) do{int jb_=(t)-(NT-4); if(jb_>=0)cmask(P0,P1,jb_,qrel,hi);}while(0)
  bool resc=false;
  #define RESC() do{ if(resc){ asm volatile("s_waitcnt lgkmcnt(0)":::"memory"); \
      _Pragma("unroll") for(int d_=0;d_<4;++d_) _Pragma("unroll") for(int r=0;r<16;++r)o[d_][r]*=wsf[crow(r,hi)]; } }while(0)
  f32x16 c0,c1;
  u32x4 pa0,pa1,pa2,pa3,pn0,pn1,pn2,pn3;
  int sl_prev=0,sl_cur=0,sl_next=SLOTB;
  #define ROT() do{sl_prev=sl_cur;sl_cur=sl_next;sl_next=(sl_next==(NSLOT-1)*SLOTB)?0:sl_next+SLOTB;}while(0)
  #define PKW(P,B) cvtpk_s(P[B],P[B+1])
  DMA_K(2,2*SLOTB);
  WAIT_BAR(4);
  qkt(c0,c1,Kbase,qr,zero16,r32,hi);asm volatile("s_nop 15\n\ts_nop 7":"+v"(c0),"+v"(c1));CMASK(c0,c1,0);
  { const float rm=rowmax(c0,c1); mhat=rm;
    _Pragma("unroll") for(int r=0;r<16;++r){c0[r]=__builtin_amdgcn_exp2f(c0[r]-rm);c1[r]=__builtin_amdgcn_exp2f(c1[r]-rm);}
    float sacc=c0[0]+c0[1]; _Pragma("unroll") for(int r=2;r<16;++r)sacc+=c0[r]; _Pragma("unroll") for(int r=0;r<16;++r)sacc+=c1[r]; l_reg=sacc;
    pa0=(u32x4){PKW(c0,0),PKW(c0,2),PKW(c0,4),PKW(c0,6)};pa1=(u32x4){PKW(c0,8),PKW(c0,10),PKW(c0,12),PKW(c0,14)};pa2=(u32x4){PKW(c1,0),PKW(c1,2),PKW(c1,4),PKW(c1,6)};pa3=(u32x4){PKW(c1,8),PKW(c1,10),PKW(c1,12),PKW(c1,14)}; }
  WAIT_BAR(0);
  DMA_V(1,SLOTB);
  ROT();
  kfa[0]=*(const __attribute__((address_space(3))) bf16x8*)(kp0+sl_cur);      kfa[1]=*(const __attribute__((address_space(3))) bf16x8*)(kp0+sl_cur+512);
  kfa[2]=*(const __attribute__((address_space(3))) bf16x8*)(kp0+sl_cur+2048); kfa[3]=*(const __attribute__((address_space(3))) bf16x8*)(kp0+sl_cur+2560);
  WAIT_BAR(2);
  s16x4 vlo[8],vhi[8];
  #define VFR(i) (bf16x8){vlo[i][0],vlo[i][1],vlo[i][2],vlo[i][3],vhi[i][0],vhi[i][1],vhi[i][2],vhi[i][3]}
  #define PIN(x) asm volatile("":"+v"(x))
  #define MX3(a,b,c) __builtin_fmaxf(__builtin_fmaxf((a),(b)),(c))
  #define EX(v) __builtin_amdgcn_exp2f(v)
  #define GAPA(MF) do{ MF; SBAR(); }while(0)
  #define GAPB(MF,X,B,i) do{ MF; VRD2(i); X[B]=EX(X[B]); X[B+1]=EX(X[B+1]); X[B+2]=EX(X[B+2]); X[B+3]=EX(X[B+3]); PIN(X); SBAR(); }while(0)
  #define GAPC(MF,A0,A1,A2,A3,W0,W1,PW) do{ MF; sacc+=A0; sacc+=A1; sacc+=A2; sacc+=A3; PIN(sacc); W0; W1; PIN(PW); SBAR(); }while(0)
  #define VRD(i) do{ vlo[i]=vtr(vp_+(((i)>>2)*4096+((i)&3)*1024)); vhi[i]=vtr(vp_+(((i)>>2)*4096+((i)&3)*1024+512)); }while(0)
  #define VRD2(i) do{ vlo[i]=vtr(vp_+(8192+((i)>>2)*4096+((i)&3)*1024)); vhi[i]=vtr(vp_+(8192+((i)>>2)*4096+((i)&3)*1024+512)); }while(0)
  #define KRD(G,j) do{ if(G){ kfa[2*(j)]=*(const __attribute__((address_space(3))) bf16x8*)(kp0+sl_next+(j)*2048); kfa[2*(j)+1]=*(const __attribute__((address_space(3))) bf16x8*)(kp0+sl_next+(j)*2048+512); SBAR(); } }while(0)
  #define MFMA32(a,b,c) __builtin_amdgcn_mfma_f32_32x32x16_bf16(a,b,c,0,0,0)
  #define PF(x) __builtin_bit_cast(bf16x8,x)
  #define STEP(A0,A1,A2,A3,N0,N1,N2,N3,t,GK,GV,GL) do{ SBAR(); \
    if(GK){DMA_K((t)+2,sl_prev);} \
    const lds_cptr vp_=vp0+2*sl_prev; \
    kfb[0]=*(const __attribute__((address_space(3))) bf16x8*)(kp0+sl_cur+4096); kfb[1]=*(const __attribute__((address_space(3))) bf16x8*)(kp0+sl_cur+4608); \
    kfb[2]=*(const __attribute__((address_space(3))) bf16x8*)(kp0+sl_cur+6144); kfb[3]=*(const __attribute__((address_space(3))) bf16x8*)(kp0+sl_cur+6656); SBAR(); \
    VRD(0); SBAR(); GAPA(c0=MFMA32(kfa[0],qr[0],zero16)); \
    VRD(4); SBAR(); GAPA(c1=MFMA32(kfa[1],qr[0],zero16)); \
    VRD(1); SBAR(); GAPA(c0=MFMA32(kfa[2],qr[1],c0)); \
    VRD(5); SBAR(); GAPA(c1=MFMA32(kfa[3],qr[1],c1)); \
    VRD(2); SBAR(); GAPA(c0=MFMA32(kfb[0],qr[2],c0)); \
    VRD(6); SBAR(); GAPA(c1=MFMA32(kfb[1],qr[2],c1)); \
    VRD(3); SBAR(); GAPA(c0=MFMA32(kfb[2],qr[3],c0)); \
    VRD(7); SBAR(); GAPA(c1=MFMA32(kfb[3],qr[3],c1)); \
    if(GV){DMA_V((t)+1,sl_next);} \
    _Pragma("unroll") for(int r=0;r<16;++r){c0[r]-=mhat;c1[r]-=mhat;} \
    CMASK(c0,c1,t); \
    { float a=MX3(c0[0],c0[1],c1[0]),bq=MX3(c0[2],c0[3],c1[1]); a=MX3(a,c1[2],c1[3]); \
      _Pragma("unroll") for(int r=4;r<16;r+=4){a=MX3(a,c0[r],c0[r+1]);bq=MX3(bq,c0[r+2],c0[r+3]);a=MX3(a,c1[r],c1[r+1]);bq=MX3(bq,c1[r+2],c1[r+3]);} \
      float rm=__builtin_fmaxf(a,bq); { auto rr=__builtin_amdgcn_permlane32_swap(__float_as_uint(rm),__float_as_uint(rm),false,false); rm=__builtin_fmaxf(__uint_as_float(rr[0]),__uint_as_float(rr[1])); } \
      resc=false; \
      if(__builtin_expect(__any(rm>(float)THRL),0)){ const float dl=__builtin_fmaxf(rm,0.f); mhat+=dl; \
        _Pragma("unroll") for(int r=0;r<16;++r){c0[r]-=dl;c1[r]-=dl;} \
        const float f=__builtin_amdgcn_exp2f(-dl); l_reg*=f; if(hi==0)wsf[r32]=f; resc=true; } } \
    SBAR(); \
    GAPB(o[0]=MFMA32(PF(A0),VFR(0),o[0]), c0,0, 0); \
    GAPB(o[1]=MFMA32(PF(A0),VFR(4),o[1]), c0,4, 4); \
    KRD(GL,0); GAPB(o[0]=MFMA32(PF(A1),VFR(1),o[0]), c0,8, 1); \
    KRD(GL,1); GAPB(o[1]=MFMA32(PF(A1),VFR(5),o[1]), c0,12, 5); \
    GAPB(o[0]=MFMA32(PF(A2),VFR(2),o[0]), c1,0, 2); \
    GAPB(o[1]=MFMA32(PF(A2),VFR(6),o[1]), c1,4, 6); \
    GAPB(o[0]=MFMA32(PF(A3),VFR(3),o[0]), c1,8, 3); \
    GAPB(o[1]=MFMA32(PF(A3),VFR(7),o[1]), c1,12, 7); \
    float sacc=(c0[0]+c0[1]); \
    GAPC(o[2]=MFMA32(PF(A0),VFR(0),o[2]), c0[2],c0[3],c0[4],c0[5],     N0[0]=PKW(c0,0), N0[1]=PKW(c0,2), N0); \
    GAPC(o[3]=MFMA32(PF(A0),VFR(4),o[3]), c0[6],c0[7],c0[8],c0[9],     N0[2]=PKW(c0,4), N0[3]=PKW(c0,6), N0); \
    GAPC(o[2]=MFMA32(PF(A1),VFR(1),o[2]), c0[10],c0[11],c0[12],c0[13], N1[0]=PKW(c0,8), N1[1]=PKW(c0,10), N1); \
    GAPC(o[3]=MFMA32(PF(A1),VFR(5),o[3]), c0[14],c0[15],c1[0],c1[1],   N1[2]=PKW(c0,12),N1[3]=PKW(c0,14), N1); \
    GAPC(o[2]=MFMA32(PF(A2),VFR(2),o[2]), c1[2],c1[3],c1[4],c1[5],     N2[0]=PKW(c1,0), N2[1]=PKW(c1,2), N2); \
    GAPC(o[3]=MFMA32(PF(A2),VFR(6),o[3]), c1[6],c1[7],c1[8],c1[9],     N2[2]=PKW(c1,4), N2[3]=PKW(c1,6), N2); \
    GAPC(o[2]=MFMA32(PF(A3),VFR(3),o[2]), c1[10],c1[11],c1[12],c1[13], N3[0]=PKW(c1,8), N3[1]=PKW(c1,10), N3); \
    GAPC(o[3]=MFMA32(PF(A3),VFR(7),o[3]), c1[14],c1[15],0.f,0.f,       N3[2]=PKW(c1,12),N3[3]=PKW(c1,14), N3); \
    l_reg+=sacc; \
    }while(0)
  int t=1;
  #undef CMASK
  #define CMASK(P0,P1,t) do{}while(0)
  for(;t+5<NT;t+=2){
    STEP(pa0,pa1,pa2,pa3,pn0,pn1,pn2,pn3,t,true,true,true);     WAIT_BAR(2); RESC(); ROT();
    STEP(pn0,pn1,pn2,pn3,pa0,pa1,pa2,pa3,t+1,true,true,true);   WAIT_BAR(2); RESC(); ROT();
  }
  #undef CMASK
  #define CMASK(P0,P1,t) do{int jb_=(t)-(NT-4); if(jb_>=0)cmask(P0,P1,jb_,qrel,hi);}while(0)
  #define ENDW(tt) do{ if((tt)+2<NT){WAIT_BAR(2);} else {WAIT_BAR(0);} }while(0)
  for(;t+1<NT;t+=2){
    STEP(pa0,pa1,pa2,pa3,pn0,pn1,pn2,pn3,t,(t+2<NT),(t+1<NT),(t+1<NT));       ENDW(t);   RESC(); ROT();
    STEP(pn0,pn1,pn2,pn3,pa0,pa1,pa2,pa3,t+1,(t+3<NT),(t+2<NT),(t+2<NT));     ENDW(t+1); RESC(); ROT();
  }
  STEP(pa0,pa1,pa2,pa3,pn0,pn1,pn2,pn3,NT-1,false,false,false); RESC();
  { SBAR(); int ln2_=tid_in&63; asm volatile("":"+v"(ln2_));
    const int vb0=(int)(lds0+LDS2_V)+((ln2_>>4)&1)*32+(ln2_&3)*8+(4*(ln2_>>5)+((ln2_&15)>>2))*64;
    pv(o,vb0+2*sl_cur,PF(pn0),PF(pn1),PF(pn2),PF(pn3)); pv(o+2,vb0+2*sl_cur+8192,PF(pn0),PF(pn1),PF(pn2),PF(pn3)); }
  #undef PKW
  #undef PF
  #undef MFMA32
  #undef VFR
  #undef PIN
  #undef MX3
  #undef GAPA
  #undef GAPB
  #undef GAPC
  #undef EX
  #undef VRD
  #undef VRD2
  #undef KRD
  #undef STEP
  #undef ENDW
  {auto rr=__builtin_amdgcn_permlane32_swap(__float_as_uint(l_reg),__float_as_uint(l_reg),false,false);l_reg=__uint_as_float(rr[0])+__uint_as_float(rr[1]);}
  int ln3_=tid_in&63; asm volatile("":"+v"(ln3_)); const int e_r32=ln3_&31,e_hi=ln3_>>5;
  float*wsf2=(float*)(shm+LDS2_WS)+wid*64;
  if(e_hi==0)wsf2[32+e_r32]=l_reg;asm volatile("s_waitcnt lgkmcnt(0)":::"memory");
  float rli[16];
  #pragma unroll
  for(int r=0;r<16;++r)rli[r]=__builtin_amdgcn_rcpf(wsf2[32+crow(r,e_hi)]);
  bf16*Ow=O+((long)b*SEQ+qb*QB+wid*QBLK)*PO;
  { bf16*stg=(bf16*)(shm+LDS2_OST)+wid*2048;
    #pragma unroll
    for(int ps=0;ps<2;++ps){
      #pragma unroll
      for(int r=0;r<16;++r){const int orow=crow(r,e_hi);
        #pragma unroll
        for(int d0=0;d0<2;++d0)stg[orow*64+d0*32+e_r32]=__float2bfloat16(o[2*ps+d0][r]*rli[r]);}
      asm volatile("s_waitcnt lgkmcnt(0)":::"memory");
      #pragma unroll
      for(int i=0;i<4;++i){const int row=i*8+(ln3_>>3),ch=ln3_&7; const u32x4 v=*(const u32x4*)(stg+row*64+ch*8); ATTN_STORE16(Ow+(long)row*PO+ps*64+ch*8,v);}
      asm volatile("s_waitcnt lgkmcnt(0)":::"memory"); } }
  asm volatile("s_waitcnt lgkmcnt(0)\n\ts_barrier":::"memory");
  #undef DMA_K
  #undef DMA_V
  #undef CMASK
  #undef RESC
  #undef ROT
}
#undef SBAR
#undef WAIT_BAR
}
#ifndef MK_MULTI
#define MK_MULTI 0
#endif
constexpr int NB = 8, SEQ = 2048, T = NB * SEQ, DM = 2048, INW = 4608, DEPTH = 2;
constexpr int CONV_CH = 512, CONV_W = 31;
constexpr int NEXP = 64, FF = 512;
constexpr int C_QS = 1024, C_KS = 1792, C_VS = 2048, C_QD = 2304, C_KD = 3072, C_VD = 3840;
constexpr int MAXTILES = 192, PROWS = MAXTILES * 256;
constexpr int NPHASE = 1 + 10 * DEPTH;
constexpr int CONV_TAIL = 128 * 12, CONV_OUT = 256 * 5;
constexpr float LOG2E = 1.4426950408889634f;
constexpr float QSCALE = 0.125f * LOG2E;
constexpr float RMS_EPS = 1e-6f, LN_EPS = 1e-5f;
constexpr float SA1 = 8.f, SW1 = 64.f, SA2 = 8.f, SW2 = 32.f, SY = 16.f;

constexpr size_t MiB = 1u << 20;
constexpr size_t WS_CTL = 0, CTL_ZERO_BYTES = 1 * MiB;
constexpr size_t WS_ROPEC = 2 * MiB, WS_ROPES = 4 * MiB;
constexpr size_t WS_RW = 6 * MiB;
constexpr size_t WS_WIN = 8 * MiB;
constexpr size_t WS_WOUT = 44 * MiB;
constexpr size_t WS_PW = 60 * MiB;
constexpr size_t WS_W13 = 64 * MiB;
constexpr size_t WS_W2 = 576 * MiB;
constexpr size_t WS_XN = 832 * MiB;
constexpr size_t WS_PROJ = 896 * MiB;
constexpr size_t WS_ZC = 1040 * MiB;
constexpr size_t WS_YCONV = 1056 * MiB;
constexpr size_t WS_YSWA = 1072 * MiB;
constexpr size_t WS_ODIFF = 1096 * MiB;
constexpr size_t WS_MIX = 1144 * MiB;
constexpr size_t WS_X = 1208 * MiB;
constexpr size_t WS_Z = 1336 * MiB;
constexpr size_t WS_ROWSS = 1368 * MiB;
constexpr size_t WS_ACT = 1528 * MiB;
constexpr size_t WS_YS = 1576 * MiB;
constexpr size_t WS_ROUTE = 1704 * MiB;
constexpr size_t RT_TOKE = 0, RT_TOKP = 128 * 1024, RT_GATE = 256 * 1024, RT_SLOT = 384 * 1024, RT_HIST = 640 * 1024;
constexpr size_t WS_END = 1706 * MiB;
constexpr int CW_ZC = 16384;
constexpr int CW_BAR = 4096;

constexpr int RING_OFF = 0, RING_BYTES = 131072;
constexpr int LCTL_OFF = RING_BYTES;
constexpr int TAB_OFF = LCTL_OFF + 512;
constexpr int TAB_PART = TAB_OFF + 2048;
constexpr int GOFS_OFF = TAB_PART + 4096;
constexpr int LDS_BYTES = 147456;
static_assert(GOFS_OFF + 3072 <= LDS_BYTES && TAB_PART + 6 * 1024 <= GOFS_OFF + 3072, "LDS map");

#define GAS __attribute__((address_space(1)))
#define LAS __attribute__((address_space(3)))
typedef unsigned short bf16;
typedef unsigned v4u __attribute__((ext_vector_type(4)));
typedef unsigned v2u __attribute__((ext_vector_type(2)));
typedef float f32x4 __attribute__((ext_vector_type(4)));
typedef short bf16x8 __attribute__((ext_vector_type(8)));
#define LDS_WAIT() asm volatile("s_waitcnt lgkmcnt(0)" ::: "memory")
#define VM_WAIT() asm volatile("s_waitcnt vmcnt(0)" ::: "memory")
typedef float f32x2_m __attribute__((ext_vector_type(2))); typedef __bf16 bf16x2_m __attribute__((ext_vector_type(2)));
__device__ __forceinline__ unsigned pk2(float lo, float hi) { f32x2_m v = {lo, hi}; bf16x2_m b = __builtin_convertvector(v, bf16x2_m); return __builtin_bit_cast(unsigned, b); }
__device__ __forceinline__ float bflo(unsigned w) { return __uint_as_float(w << 16); }
__device__ __forceinline__ float bfhi(unsigned w) { return __uint_as_float(w & 0xffff0000u); }
__device__ __forceinline__ float wave_sum(float v) {
#pragma unroll
    for (int o = 1; o < 64; o <<= 1) v += __shfl_xor(v, o);
    return v;
}
__device__ __forceinline__ float sigmoid_f(float x) { return __builtin_amdgcn_rcpf(1.0f + __builtin_amdgcn_exp2f(-LOG2E * x)); }

#define XB_TMO      128
#define XB_XCNT(j)  (256  + 64 * (j))
#define XB_XSUB(j)  (1280 + 64 * (j))
#define XB_XGEN(j)  (2304 + 64 * (j))
#define XB_TOP      3328
#define XB_TOPGEN   3392
#define XCD_BAR_WORDS 3456
#define XB_SPIN_CAP (1u << 18)

__device__ __forceinline__ unsigned xb_ld(unsigned* p)              { return __hip_atomic_load(p, __ATOMIC_RELAXED, __HIP_MEMORY_SCOPE_AGENT); }
__device__ __forceinline__ unsigned xb_add(unsigned* p, unsigned v) { return __hip_atomic_fetch_add(p, v, __ATOMIC_RELAXED, __HIP_MEMORY_SCOPE_AGENT); }
__device__ __forceinline__ unsigned xb_xcc_id() { return (unsigned)__builtin_amdgcn_s_getreg((3 << 11) | 20) & 0xFu; }
#define XB_SPIN(cond, bar) do { unsigned _sp = 0; while (cond) { __builtin_amdgcn_s_sleep(1); \
    if ((++_sp & 255u) == 0u) { if (xb_ld(&(bar)[XB_TMO])) break; if (_sp > XB_SPIN_CAP) { atomicAdd(&(bar)[XB_TMO], 1u); break; } } } } while (0)

struct XcdBarrier {
    unsigned* bar; unsigned x;
    volatile LAS unsigned* st;
};

__device__ __forceinline__ XcdBarrier xcd_barrier_post(unsigned* bar, volatile LAS unsigned* st) {
    XcdBarrier b; b.bar = bar; b.x = xb_xcc_id(); b.st = st;
    if (threadIdx.x == 0) (void)xb_add(&bar[XB_XCNT(b.x)], 1u);
    return b;
}
__device__ __forceinline__ void xcd_barrier_complete(unsigned* bar, unsigned x, unsigned& nloc, unsigned& nx) {
    const unsigned G = gridDim.x * gridDim.y * gridDim.z;
    unsigned sum, cnt, mine, sp = 0u;
    for (;;) {
        sum = 0u; cnt = 0u; mine = 0u;
#pragma unroll
        for (unsigned j = 0; j < 16; ++j) { const unsigned c = xb_ld(&bar[XB_XCNT(j)]); sum += c; cnt += (c > 0u) ? 1u : 0u; mine = (j == x) ? c : mine; }
        if (sum == G) break;
        __builtin_amdgcn_s_sleep(1);
        if ((++sp & 255u) == 0u) { if (xb_ld(&bar[XB_TMO])) break; if (sp > XB_SPIN_CAP) { atomicAdd(&bar[XB_TMO], 1u); break; } }
    }
    nloc = mine > 0u ? mine : 1u; nx = cnt > 0u ? cnt : 1u;
}

__device__ __forceinline__ void xcd_barrier(const XcdBarrier& b) {
    asm volatile("s_waitcnt vmcnt(0)" ::: "memory");
    __syncthreads();
    if (threadIdx.x == 0) {
        unsigned* bar = b.bar;
        __builtin_amdgcn_s_waitcnt(0);
        unsigned nloc = b.st[0], nx = b.st[1];
        if (nloc == 0u) { xcd_barrier_complete(bar, b.x, nloc, nx); b.st[0] = nloc; b.st[1] = nx; }
        const unsigned old = xb_add(&bar[XB_XSUB(b.x)], 1u);
        const unsigned gen = old / nloc;
        if (old + 1u == (gen + 1u) * nloc) {
            __builtin_amdgcn_fence(__ATOMIC_RELEASE, "agent");
            asm volatile("s_waitcnt vmcnt(0)" ::: "memory");
            const unsigned og = xb_add(&bar[XB_TOP], 1u);
            const unsigned tg = og / nx;
            if (og + 1u == (tg + 1u) * nx) xb_add(&bar[XB_TOPGEN], 1u);
            else XB_SPIN(xb_ld(&bar[XB_TOPGEN]) == tg, bar);
            __builtin_amdgcn_fence(__ATOMIC_ACQUIRE, "agent");
            xb_add(&bar[XB_XGEN(b.x)], 1u);
            asm volatile("s_waitcnt vmcnt(0)" ::: "memory");
        } else {
            XB_SPIN(xb_ld(&bar[XB_XGEN(b.x)]) == gen, bar);
            __builtin_amdgcn_fence(__ATOMIC_ACQUIRE, "agent");
            asm volatile("s_waitcnt vmcnt(0)" ::: "memory");
        }
    }
    __syncthreads();
}
constexpr int GRID = 256;
struct Ctx { LAS unsigned char* lds; int tid, lane, wave, blk, vcu, gw, gtid; static constexpr int G = GRID, NGW = GRID * 8, NT = GRID * 512; };

__device__ __forceinline__ int win_drow(int col) {
    if (col < 1024) { const int half = col >> 9, r = col & 511; return 256 * (r >> 7) + 128 * half + (r & 127); }
    if ((col >= C_VS && col < C_QD) || col >= C_VD) return col;
    const int d = col & 63; return (col & ~63) + 8 * ((d & 31) >> 2) + 4 * (d >> 5) + (d & 3);
}
__device__ __forceinline__ void sincos_d(double a, float& sn, float& cs) {
    const double q = __builtin_rint(a * 0.63661977236758134308);
    double r = __builtin_fma(-q, 1.57079632679489655800e+00, a); r = __builtin_fma(-q, 6.12323399573676603587e-17, r);
    const double r2 = r * r;
    double s = -7.6471637318198164759e-13; s = s * r2 + 1.6059043836821614599e-10; s = s * r2 - 2.5052108385441718775e-08; s = s * r2 + 2.7557319223985890653e-06; s = s * r2 - 1.9841269841269841270e-04;
    s = s * r2 + 8.3333333333333333333e-03; s = s * r2 - 1.6666666666666666667e-01; s = r + r * r2 * s;
    double c = 4.7794773323873852974e-14; c = c * r2 - 1.1470745597729724714e-11; c = c * r2 + 2.0876756987868098979e-09; c = c * r2 - 2.7557319223985890653e-07; c = c * r2 + 2.4801587301587301587e-05;
    c = c * r2 - 1.3888888888888888889e-03; c = c * r2 + 4.1666666666666666667e-02; c = c * r2 - 0.5; c = 1.0 + r2 * c;
    const int qi = (int)((long long)q & 3);
    const double ss = (qi & 1) ? c : s, cc = (qi & 1) ? s : c;
    sn = (float)((qi & 2) ? -ss : ss); cs = (float)(((qi + 1) & 2) ? -cc : cc);
}
__device__ __forceinline__ unsigned pk4_fp8m(float a, float b, float c, float d) {
    a = __builtin_fminf(__builtin_fmaxf(a, -448.f), 448.f); b = __builtin_fminf(__builtin_fmaxf(b, -448.f), 448.f); c = __builtin_fminf(__builtin_fmaxf(c, -448.f), 448.f); d = __builtin_fminf(__builtin_fmaxf(d, -448.f), 448.f);
    int w = 0; w = __builtin_amdgcn_cvt_pk_fp8_f32(a, b, w, false); w = __builtin_amdgcn_cvt_pk_fp8_f32(c, d, w, true); return (unsigned)w; }
struct P0In { const float *w_in, *w_out, *pw, *w13, *w2, *wg, *we, *ffn_g; const int* pos; };
struct P0Item { const float* src; unsigned char* dst; int N, Kb, n0, drow0, kind; float scale; };
__device__ __forceinline__ P0Item p0_decode(int it, const P0In& I, unsigned char* ws) {
    constexpr int IT_WIN = 32 * 144, IT_WOUT = 32 * 64, IT_PW = 8 * 16, IT_LAYER = IT_WIN + IT_WOUT + IT_PW;
    P0Item t; const int l = it / IT_LAYER; int r = it - l * IT_LAYER; t.scale = 1.0f;
    if (r < IT_WIN) { const int kb = r / 144, nb = r - kb * 144; t.src = I.w_in + (size_t)l * DM * INW + (size_t)(64 * kb) * INW + 32 * nb; t.N = INW; t.dst = ws + WS_WIN + ((size_t)l * INW * DM + 64 * kb) * 2; t.Kb = DM * 2; t.n0 = 32 * nb; t.drow0 = 0; t.kind = 1; return t; }
    r -= IT_WIN;
    if (r < IT_WOUT) { const int kb = r / 64, nb = r & 63; t.src = I.w_out + (size_t)l * DM * DM + (size_t)(64 * kb) * DM + 32 * nb; t.N = DM; t.dst = ws + WS_WOUT + ((size_t)l * DM * DM + 64 * kb) * 2; t.Kb = DM * 2; t.n0 = 32 * nb; t.drow0 = 32 * nb; t.kind = 0; return t; }
    r -= IT_WOUT;
    { const int kb = r / 16, nb = r & 15; t.src = I.pw + (size_t)l * 512 * 512 + (size_t)(64 * kb) * 512 + 32 * nb; t.N = 512; t.dst = ws + WS_PW + ((size_t)l * 512 * 512 + 64 * kb) * 2; t.Kb = 512 * 2; t.n0 = 32 * nb; t.drow0 = 32 * nb; t.kind = 0; return t; }
}
__device__ __forceinline__ void p0_load(const P0Item& t, float (&v)[32], int lane) {
    const float* p = t.src + (size_t)(lane >> 5) * t.N + (lane & 31);
#pragma unroll
    for (int i = 0; i < 32; ++i) v[i] = p[(size_t)(2 * i) * t.N];
}
__device__ __forceinline__ void p0_store(const P0Item& t, const float (&v)[32], LAS float* scr, int lane) {
#pragma unroll
    for (int i = 0; i < 32; ++i) scr[(2 * i + (lane >> 5)) * 33 + (lane & 31)] = v[i] * t.scale;
    LDS_WAIT(); asm volatile("" ::: "memory");
    const int c = lane & 7;
#pragma unroll
    for (int j = 0; j < 4; ++j) { const int n = (lane >> 3) + 8 * j; const LAS float* s = scr + (8 * c) * 33 + n;
        const int row = (t.kind == 1) ? win_drow(t.n0 + n) : t.drow0 + n;
        if (t.kind == 2) { v2u o; o.x = pk4_fp8m(s[0 * 33], s[1 * 33], s[2 * 33], s[3 * 33]); o.y = pk4_fp8m(s[4 * 33], s[5 * 33], s[6 * 33], s[7 * 33]); *(GAS v2u*)(t.dst + (size_t)row * t.Kb + 8 * c) = o; }
        else { v4u o; o.x = pk2(s[0 * 33], s[1 * 33]); o.y = pk2(s[2 * 33], s[3 * 33]); o.z = pk2(s[4 * 33], s[5 * 33]); o.w = pk2(s[6 * 33], s[7 * 33]); *(GAS v4u*)(t.dst + (size_t)row * t.Kb + 16 * c) = o; } }
    LDS_WAIT(); asm volatile("" ::: "memory");
}
struct P0Moe { const float* src; unsigned char* dst; int N, Kb, skip; float scale; };
__device__ __forceinline__ int pi256(int n) { return 128 * ((n >> 3) & 1) + 32 * (n >> 6) + 8 * ((n >> 4) & 3) + 4 * ((n >> 2) & 1) + (n & 3); }
constexpr int MOE_ITEMS_L = NEXP * 64 + NEXP * 32;
__device__ __forceinline__ P0Moe p0_moe_decode(int it, const P0In& I, unsigned char* ws) {
    P0Moe t; const int l = it / MOE_ITEMS_L; int r = it - l * MOE_ITEMS_L;
    if (r < NEXP * 64) { const int e = r >> 6, q = r & 63, kb = q >> 2, nb = q & 3, drow0 = 512 * (nb & 1) + 128 * (nb >> 1);
        t.src = I.w13 + (size_t)(l * NEXP + e) * DM * 1024 + (size_t)(128 * kb) * 1024 + 256 * nb; t.N = 1024; t.dst = ws + WS_W13 + (size_t)(l * NEXP + e) * 1024 * DM + (size_t)drow0 * DM + 128 * kb; t.Kb = DM; t.skip = 128; t.scale = SW1; return t; }
    r -= NEXP * 64;
    { const int e = r >> 5, q = r & 31, kb = q >> 3, nb = q & 7;
        t.src = I.w2 + (size_t)(l * NEXP + e) * FF * DM + (size_t)(128 * kb) * DM + 256 * nb; t.N = DM; t.dst = ws + WS_W2 + (size_t)(l * NEXP + e) * DM * FF + (size_t)(256 * nb) * FF + 128 * kb; t.Kb = FF; t.skip = -1; t.scale = SW2; return t; }
}
__device__ __forceinline__ void p0_moe_load(const P0Moe& t, f32x4 (&v)[16], int wave, int lane) {
    const float* p = t.src + (size_t)(16 * wave) * t.N + 4 * lane;
#pragma unroll
    for (int r = 0; r < 16; ++r) v[r] = *(const GAS f32x4*)(p + (size_t)r * t.N);
}
__device__ __forceinline__ void p0_moe_store(const P0Moe& t, const f32x4 (&v)[16], LAS unsigned* ob, int tid, int wave, int lane) {
#pragma unroll
    for (int g = 0; g < 4; ++g) { LAS unsigned* o = ob + (4 * lane) * 33 + 4 * wave + g;
        o[0] = pk4_fp8m(v[4 * g].x * t.scale, v[4 * g + 1].x * t.scale, v[4 * g + 2].x * t.scale, v[4 * g + 3].x * t.scale);
        o[33] = pk4_fp8m(v[4 * g].y * t.scale, v[4 * g + 1].y * t.scale, v[4 * g + 2].y * t.scale, v[4 * g + 3].y * t.scale);
        o[66] = pk4_fp8m(v[4 * g].z * t.scale, v[4 * g + 1].z * t.scale, v[4 * g + 2].z * t.scale, v[4 * g + 3].z * t.scale);
        o[99] = pk4_fp8m(v[4 * g].w * t.scale, v[4 * g + 1].w * t.scale, v[4 * g + 2].w * t.scale, v[4 * g + 3].w * t.scale); }
    __syncthreads();
    { const int row = tid >> 1, part = tid & 1; const LAS unsigned* sp = ob + row * 33 + 16 * part;
      v4u o0, o1, o2, o3; o0.x = sp[0]; o0.y = sp[1]; o0.z = sp[2]; o0.w = sp[3]; o1.x = sp[4]; o1.y = sp[5]; o1.z = sp[6]; o1.w = sp[7];
      o2.x = sp[8]; o2.y = sp[9]; o2.z = sp[10]; o2.w = sp[11]; o3.x = sp[12]; o3.y = sp[13]; o3.z = sp[14]; o3.w = sp[15];
      const int drow = t.skip < 0 ? pi256(row) : row + (row >= 128 ? t.skip : 0);
      GAS v4u* d = (GAS v4u*)(t.dst + (size_t)drow * t.Kb + 64 * part); d[0] = o0; d[1] = o1; d[2] = o2; d[3] = o3; }
    __syncthreads();
}
__device__ __forceinline__ void moe_convert(const Ctx& C, const P0In& I, unsigned char* ws, int lo, int hi, int idx, int stride) {
    LAS unsigned* ob = (LAS unsigned*)(C.lds + RING_OFF);
    __syncthreads();
    f32x4 va[16], vb[16]; int it = lo + idx;
#define MC_DEC(i) p0_moe_decode((i) < hi ? (i) : hi - 1, I, ws)
    P0Moe ta = MC_DEC(it), tb = ta;
    p0_moe_load(ta, va, C.wave, C.lane);
#pragma unroll 1
    while (it < hi) {
        tb = MC_DEC(it + stride); p0_moe_load(tb, vb, C.wave, C.lane); p0_moe_store(ta, va, ob, C.tid, C.wave, C.lane);
        if (it + stride >= hi) break;
        ta = MC_DEC(it + 2 * stride); p0_moe_load(ta, va, C.wave, C.lane); p0_moe_store(tb, vb, ob, C.tid, C.wave, C.lane);
        it += 2 * stride; }
#undef MC_DEC
    asm volatile("s_waitcnt vmcnt(0)" ::: "memory");
    __syncthreads();
}
constexpr int WCONV_L = 32 * 144 + 32 * 64 + 8 * 16;
__device__ __forceinline__ void wconv_bf16(const Ctx& C, const P0In& I, unsigned char* ws, int lo, int hi) {
    LAS float* scr = (LAS float*)(C.lds + RING_OFF + C.wave * 16384);
    __syncthreads();
    { float va[32], vb[32]; int it = lo + C.gw; P0Item ta = p0_decode(it < hi ? it : hi - 1, I, ws), tb = ta;
      p0_load(ta, va, C.lane);
#pragma unroll 1
      while (it < hi) {
          const int it1 = it + C.NGW, it2 = it1 + C.NGW;
          tb = p0_decode(it1 < hi ? it1 : hi - 1, I, ws); p0_load(tb, vb, C.lane);
          p0_store(ta, va, scr, C.lane);
          if (it1 >= hi) break;
          ta = p0_decode(it2 < hi ? it2 : hi - 1, I, ws); p0_load(ta, va, C.lane);
          p0_store(tb, vb, scr, C.lane);
          it = it2; } }
    asm volatile("s_waitcnt vmcnt(0)" ::: "memory");
    __syncthreads();
}
__device__ __forceinline__ void p0_prologue(const Ctx& C, const P0In& I, unsigned char* ws) {
    wconv_bf16(C, I, ws, 0, WCONV_L);
    for (int idx = C.gtid; idx < DEPTH * 80 * DM; idx += C.NT) {
        const int l = idx / (80 * DM), rem = idx - l * 80 * DM, k = rem / 80, o = rem - k * 80;
        float v = 0.f;
        if (o < 8) v = I.wg[((size_t)l * DM + k) * 8 + o]; else if (o < 72) v = I.we[((size_t)l * DM + k) * 64 + (o - 8)];
        v *= I.ffn_g[l * DM + k];
        const unsigned h = pk2(v, 0.f) & 0xffffu; const float hf = __uint_as_float(h << 16); const unsigned lo = pk2(v - hf, 0.f) & 0xffffu;
        bf16* rw = (bf16*)(ws + WS_RW) + (size_t)l * 2 * 80 * DM;
        rw[(size_t)o * DM + k] = (bf16)h; rw[(size_t)(80 + o) * DM + k] = (bf16)lo;
    }
    for (int idx = C.gtid; idx < T * 32; idx += C.NT) {
        const int tok = idx >> 5, i = idx & 31;
        const float inv = (float)exp2(-(double)i * (13.287712379549449 / 32.0));
        const float ang = (float)I.pos[tok] * inv;
        float sn, cs; sincos_d((double)ang, sn, cs);
        ((float*)(ws + WS_ROPEC))[idx] = cs; ((float*)(ws + WS_ROPES))[idx] = sn;
    }
}

template <int MODE>
__device__ __forceinline__ void norm_rows(const Ctx& C, const void* src, bf16* xdst, const unsigned char* YS8, const int* srow, const float* gate, const float* gain, bf16* XN, float* outf) {
    constexpr int NR = 2;
    for (int m0 = C.gw; m0 < T; m0 += NR * C.NGW) {
        f32x4 v[NR][8]; unsigned ya[NR][8], yb[NR][8]; float h0[NR], h1[NR];
#pragma unroll
        for (int q = 0; q < NR; ++q) { const int m = m0 + q * C.NGW;
            if (MODE == 0) { const GAS f32x4* xr = (const GAS f32x4*)((const float*)src + (size_t)m * DM) + C.lane;
#pragma unroll
                for (int j = 0; j < 8; ++j) v[q][j] = xr[64 * j]; }
            else { const GAS v2u* xr = (const GAS v2u*)((const bf16*)src + (size_t)m * DM) + C.lane;
#pragma unroll
                for (int j = 0; j < 8; ++j) { const v2u t_ = xr[64 * j]; v[q][j] = (f32x4){bflo(t_.x), bfhi(t_.x), bflo(t_.y), bfhi(t_.y)}; } }
            if (MODE >= 1) {
                h0[q] = gate[2 * m] * (1.0f / SY); h1[q] = gate[2 * m + 1] * (1.0f / SY);
                const GAS unsigned* y0 = (const GAS unsigned*)(YS8 + (size_t)srow[2 * m] * DM) + C.lane; const GAS unsigned* y1 = (const GAS unsigned*)(YS8 + (size_t)srow[2 * m + 1] * DM) + C.lane;
#pragma unroll
                for (int j = 0; j < 8; ++j) { ya[q][j] = y0[64 * j]; yb[q][j] = y1[64 * j]; } } }
#pragma unroll
        for (int q = 0; q < NR; ++q) { const int m = m0 + q * C.NGW;
            if (MODE >= 1) {
#pragma unroll
                for (int j = 0; j < 8; ++j) { const unsigned a = ya[q][j], b = yb[q][j];
                    const f32x2_m a01 = __builtin_amdgcn_cvt_pk_f32_fp8((int)a, false), a23 = __builtin_amdgcn_cvt_pk_f32_fp8((int)a, true), b01 = __builtin_amdgcn_cvt_pk_f32_fp8((int)b, false), b23 = __builtin_amdgcn_cvt_pk_f32_fp8((int)b, true);
                    v[q][j].x += h0[q] * a01.x + h1[q] * b01.x; v[q][j].y += h0[q] * a01.y + h1[q] * b01.y; v[q][j].z += h0[q] * a23.x + h1[q] * b23.x; v[q][j].w += h0[q] * a23.y + h1[q] * b23.y; } }
            float ss = 0.f;
#pragma unroll
            for (int j = 0; j < 8; ++j) ss += (v[q][j].x * v[q][j].x + v[q][j].y * v[q][j].y) + (v[q][j].z * v[q][j].z + v[q][j].w * v[q][j].w);
            const float rstd = 1.0f / sqrtf(wave_sum(ss) * (1.0f / DM) + RMS_EPS);
            if (MODE == 1) { GAS v2u* xo = (GAS v2u*)(xdst + (size_t)m * DM) + C.lane;
#pragma unroll
                for (int j = 0; j < 8; ++j) { v2u w; w.x = pk2(v[q][j].x, v[q][j].y); w.y = pk2(v[q][j].z, v[q][j].w); xo[64 * j] = w; } }
            const GAS f32x4* gg = (const GAS f32x4*)gain + C.lane;
            if (MODE <= 1) { GAS v2u* o = (GAS v2u*)(XN + (size_t)m * DM) + C.lane;
#pragma unroll
                for (int j = 0; j < 8; ++j) { const f32x4 g = gg[64 * j]; v2u w; w.x = pk2(v[q][j].x * rstd * g.x, v[q][j].y * rstd * g.y); w.y = pk2(v[q][j].z * rstd * g.z, v[q][j].w * rstd * g.w); o[64 * j] = w; } }
            else { GAS f32x4* o = (GAS f32x4*)(outf + (size_t)m * DM) + C.lane;
#pragma unroll
                for (int j = 0; j < 8; ++j) { const f32x4 g = gg[64 * j]; o[64 * j] = v[q][j] * rstd * g; } } }
    }
}

__device__ __forceinline__ void convpre_phase(const Ctx& C, const bf16* Z, const float* dw_w, const float* dw_b, const float* ln_g, const float* ln_b, bf16* ZC) {
    const __amdgpu_buffer_rsrc_t zrs = __builtin_amdgcn_make_buffer_rsrc((void*)ZC, (short)0, T * CONV_CH * 2, 0x00020000);
    LAS float* wl = (LAS float*)(C.lds + RING_OFF);
    LAS bf16* zs = (LAS bf16*)(C.lds + RING_OFF + 63488);
    __syncthreads();
    for (int i = C.tid; i < CONV_W * CONV_CH; i += 512) wl[i] = dw_w[i];
    const int c0 = 8 * C.lane;
    float bias[8], lg[8], lb[8];
#pragma unroll
    for (int i = 0; i < 8; ++i) { bias[i] = dw_b[c0 + i]; lg[i] = ln_g[c0 + i]; lb[i] = ln_b[c0 + i]; }
    for (int item = C.blk; item < T / 32; item += C.G) {
        const int t0 = item * 32, s0 = t0 & (SEQ - 1);
        __syncthreads();
#pragma unroll
        for (int i = 0; i < 8; ++i) { const int task = C.tid + 512 * i, rr = task >> 6, ch = task & 63;
            if (rr < 62) { v4u z = {0u, 0u, 0u, 0u};
                if (s0 - 30 + rr >= 0) z = *(const GAS v4u*)(Z + (size_t)(t0 - 30 + rr) * CONV_CH + 8 * ch);
                *(LAS v4u*)(zs + rr * 512 + 8 * ch) = z; } }
        __syncthreads();
        {
            const int tt = 4 * C.wave;
            float acc[4][8];
#pragma unroll
            for (int q = 0; q < 4; ++q)
#pragma unroll
                for (int i = 0; i < 8; ++i) acc[q][i] = bias[i];
#pragma unroll 2
            for (int j = 0; j < CONV_W; ++j) { const f32x4 w0 = *(const LAS f32x4*)(wl + j * 512 + c0), w1 = *(const LAS f32x4*)(wl + j * 512 + c0 + 4);
#pragma unroll
                for (int q = 0; q < 4; ++q) { const v4u z = *(const LAS v4u*)(zs + (tt + q + j) * 512 + c0);
                    acc[q][0] += w0.x * bflo(z.x); acc[q][1] += w0.y * bfhi(z.x); acc[q][2] += w0.z * bflo(z.y); acc[q][3] += w0.w * bfhi(z.y);
                    acc[q][4] += w1.x * bflo(z.z); acc[q][5] += w1.y * bfhi(z.z); acc[q][6] += w1.z * bflo(z.w); acc[q][7] += w1.w * bfhi(z.w); } }
#pragma unroll
            for (int q = 0; q < 4; ++q) {
                float s = 0.f;
#pragma unroll
                for (int i = 0; i < 8; ++i) s += acc[q][i];
                const float mean = wave_sum(s) * (1.0f / CONV_CH); float s2 = 0.f;
#pragma unroll
                for (int i = 0; i < 8; ++i) { acc[q][i] -= mean; s2 += acc[q][i] * acc[q][i]; }
                const float rstd = 1.0f / sqrtf(wave_sum(s2) * (1.0f / CONV_CH) + LN_EPS);
                float y[8];
#pragma unroll
                for (int i = 0; i < 8; ++i) { const float u = acc[q][i] * rstd * lg[i] + lb[i]; y[i] = u * sigmoid_f(u); }
                v4u o; o.x = pk2(y[0], y[1]); o.y = pk2(y[2], y[3]); o.z = pk2(y[4], y[5]); o.w = pk2(y[6], y[7]);
                __builtin_amdgcn_raw_buffer_store_b128(o, zrs, (int)(((size_t)(t0 + tt + q) * CONV_CH + c0) * 2), 0, 16); }
        }
    }
    __syncthreads();
}

#define MFMA16(a, b, c) __builtin_amdgcn_mfma_f32_16x16x32_bf16(a, b, c, 0, 0, 0)
__device__ __forceinline__ void swa_phase(const Ctx& C, const bf16* PROJ, const float* sinks, bf16* YSWA) {
    LAS bf16* vt = (LAS bf16*)(C.lds + RING_OFF);
    const int c16 = C.lane & 15, g4 = C.lane >> 4, w = C.wave;
    for (int u = C.vcu; u < 512; u += C.G) {
        const int n = u & 15, hk = (u >> 4) & 3, b = u >> 6, tb = b * SEQ + 128 * n;
        __syncthreads();
#pragma unroll
        for (int i = 0; i < 2; ++i) { const int task = C.tid + 512 * i, kk = 2 * (task >> 3), c8 = task & 7;
            v4u va = {0u, 0u, 0u, 0u}, vb = {0u, 0u, 0u, 0u};
            if (n > 0 || kk >= 128) { const bf16* vp = PROJ + (size_t)(tb - 128 + kk) * INW + C_VS + 64 * hk + 8 * c8; va = *(const GAS v4u*)vp; vb = *(const GAS v4u*)(vp + INW); }
            LAS unsigned* dst = (LAS unsigned*)(vt + (8 * c8) * 264 + kk);
            dst[0] = (va.x & 0xffffu) | (vb.x << 16); dst[132] = (va.x >> 16) | (vb.x & 0xffff0000u); dst[2 * 132] = (va.y & 0xffffu) | (vb.y << 16); dst[3 * 132] = (va.y >> 16) | (vb.y & 0xffff0000u);
            dst[4 * 132] = (va.z & 0xffffu) | (vb.z << 16); dst[5 * 132] = (va.z >> 16) | (vb.z & 0xffff0000u); dst[6 * 132] = (va.w & 0xffffu) | (vb.w << 16); dst[7 * 132] = (va.w >> 16) | (vb.w & 0xffff0000u); }
        bf16x8 kf[9][2], qf[3][2];
        { const int q0_ = tb + 16 * w;
#pragma unroll
          for (int j = 0; j < 9; ++j) { const int krow = 16 * w - 128 + 16 * j + c16; int ktok = tb + krow; if (128 * n + krow < 0) ktok = b * SEQ;
              const bf16* kp = PROJ + (size_t)ktok * INW + C_KS + 64 * hk + 8 * g4; kf[j][0] = *(const GAS bf16x8*)kp; kf[j][1] = *(const GAS bf16x8*)(kp + 32); }
#pragma unroll
          for (int g = 0; g < 3; ++g) { const bf16* qp = PROJ + (size_t)(q0_ + c16) * INW + C_QS + 64 * (3 * hk + g) + 8 * g4; qf[g][0] = *(const GAS bf16x8*)qp; qf[g][1] = *(const GAS bf16x8*)(qp + 32); } }
        __syncthreads();
#pragma unroll
        for (int g = 0; g < 3; ++g) {
            const int h = 3 * hk + g; const float sink2 = sinks[h] * LOG2E;
            const int q0 = tb + 16 * w;
            f32x4 s[9];
#pragma unroll
            for (int j = 0; j < 9; ++j) { f32x4 a = {0.f, 0.f, 0.f, 0.f}; a = MFMA16(kf[j][0], qf[g][0], a); a = MFMA16(kf[j][1], qf[g][1], a); s[j] = a; }
            const int qr = 16 * w + c16; float mx = -INFINITY;
#pragma unroll
            for (int j = 0; j < 9; ++j)
#pragma unroll
                for (int r = 0; r < 4; ++r) { const int kr = 16 * w - 128 + 16 * j + 4 * g4 + r, diff = qr - kr; const bool ok = diff >= 0 && diff < 128 && (128 * n + kr) >= 0;
                    s[j][r] = ok ? s[j][r] : -INFINITY; mx = fmaxf(mx, s[j][r]); }
            mx = fmaxf(mx, __shfl_xor(mx, 16)); mx = fmaxf(mx, __shfl_xor(mx, 32)); mx = fmaxf(mx, sink2);
            float sum = 0.f;
#pragma unroll
            for (int j = 0; j < 9; ++j)
#pragma unroll
                for (int r = 0; r < 4; ++r) { const float e = __builtin_amdgcn_exp2f(s[j][r] - mx); s[j][r] = e; sum += e; }
            sum += __shfl_xor(sum, 16); sum += __shfl_xor(sum, 32); sum += __builtin_amdgcn_exp2f(sink2 - mx);
            const float inv = 1.0f / sum;
            unsigned pw[10][2];
#pragma unroll
            for (int j = 0; j < 9; ++j) { pw[j][0] = pk2(s[j][0] * inv, s[j][1] * inv); pw[j][1] = pk2(s[j][2] * inv, s[j][3] * inv); }
            pw[9][0] = 0u; pw[9][1] = 0u;
            f32x4 o[4];
#pragma unroll
            for (int dt = 0; dt < 4; ++dt) o[dt] = (f32x4){0.f, 0.f, 0.f, 0.f};
#pragma unroll
            for (int sI = 0; sI < 5; ++sI) {
                const v4u pb = {pw[2 * sI][0], pw[2 * sI][1], pw[2 * sI + 1][0], pw[2 * sI + 1][1]};
                const int kkA = 16 * w + 32 * sI + 4 * g4; int kkB = kkA + 16; if (kkB > 252) kkB = 252;
#pragma unroll
                for (int dt = 0; dt < 4; ++dt) { const LAS bf16* vp = vt + (16 * dt + c16) * 264;
                    const v2u va = *(const LAS v2u*)(vp + kkA), vb = *(const LAS v2u*)(vp + kkB);
                    const v4u av = {va.x, va.y, vb.x, vb.y};
                    o[dt] = MFMA16(__builtin_bit_cast(bf16x8, av), __builtin_bit_cast(bf16x8, pb), o[dt]); }
            }
            bf16* op = YSWA + (size_t)(q0 + c16) * 768 + 64 * h + 4 * g4;
#pragma unroll
            for (int dt = 0; dt < 4; ++dt) { v2u wv; wv.x = pk2(o[dt][0], o[dt][1]); wv.y = pk2(o[dt][2], o[dt][3]); *(GAS v2u*)(op + 16 * dt) = wv; }
        }
    }
    __syncthreads();
}

__device__ __forceinline__ void mix_phase(const Ctx& C, const bf16* YCONV, const bf16* YSWA, const bf16* ODIFF, const float* conv_g, const float* swa_g, const float* lq1, const float* lk1, const float* lq2, const float* lk2,
                                          const float* sub_g, float lambda_init, bf16* MIX) {
    const float lam = __expf(wave_sum(lq1[C.lane] * lk1[C.lane])) - __expf(wave_sum(lq2[C.lane] * lk2[C.lane])) + lambda_init;
    const float osc = 1.0f - lambda_init;
    const int l = C.lane;
    const int vh = l >> 5, dd = 2 * (l & 31); const float gA = sub_g[2 * l] * osc, gB = sub_g[2 * l + 1] * osc;
    const f32x4 cg0 = *(const GAS f32x4*)(conv_g + 8 * l), cg1 = *(const GAS f32x4*)(conv_g + 8 * l + 4);
    const f32x4 sg0 = *(const GAS f32x4*)(swa_g + 8 * l), sg1 = *(const GAS f32x4*)(swa_g + 8 * l + 4), sg2 = *(const GAS f32x4*)(swa_g + 512 + 4 * l);
    constexpr int NR = 2;
    for (int m0 = C.gw; m0 < T; m0 += NR * C.NGW) {
        v4u yc[NR], ys[NR]; v2u ys2[NR]; unsigned oa[NR][6], ob[NR][6];
#pragma unroll
        for (int q = 0; q < NR; ++q) { const int m = m0 + q * C.NGW;
            yc[q] = *(const GAS v4u*)(YCONV + (size_t)m * 512 + 8 * l); ys[q] = *(const GAS v4u*)(YSWA + (size_t)m * 768 + 8 * l); ys2[q] = *(const GAS v2u*)(YSWA + (size_t)m * 768 + 512 + 4 * l);
#pragma unroll
            for (int h = 0; h < 6; ++h) { const bf16* op = ODIFF + (size_t)m * 1536 + 64 * (4 * h + vh) + dd; oa[q][h] = *(const GAS unsigned*)op; ob[q][h] = *(const GAS unsigned*)(op + 128); } }
#pragma unroll
        for (int q = 0; q < NR; ++q) { const int m = m0 + q * C.NGW;
            { const v4u y = yc[q];
              float f[8] = {bflo(y.x), bfhi(y.x), bflo(y.y), bfhi(y.y), bflo(y.z), bfhi(y.z), bflo(y.w), bfhi(y.w)}; float ss = 0.f;
#pragma unroll
              for (int i = 0; i < 8; ++i) ss += f[i] * f[i];
              const float r = 1.0f / sqrtf(wave_sum(ss) * (1.0f / 512.0f) + RMS_EPS);
              v4u o; o.x = pk2(f[0] * r * cg0.x, f[1] * r * cg0.y); o.y = pk2(f[2] * r * cg0.z, f[3] * r * cg0.w); o.z = pk2(f[4] * r * cg1.x, f[5] * r * cg1.y); o.w = pk2(f[6] * r * cg1.z, f[7] * r * cg1.w);
              *(GAS v4u*)(MIX + (size_t)m * DM + 8 * l) = o; }
            { const v4u y = ys[q]; const v2u y2 = ys2[q];
              float f[12] = {bflo(y.x), bfhi(y.x), bflo(y.y), bfhi(y.y), bflo(y.z), bfhi(y.z), bflo(y.w), bfhi(y.w), bflo(y2.x), bfhi(y2.x), bflo(y2.y), bfhi(y2.y)}; float ss = 0.f;
#pragma unroll
              for (int i = 0; i < 12; ++i) ss += f[i] * f[i];
              const float r = 1.0f / sqrtf(wave_sum(ss) * (1.0f / 768.0f) + RMS_EPS);
              v4u o; o.x = pk2(f[0] * r * sg0.x, f[1] * r * sg0.y); o.y = pk2(f[2] * r * sg0.z, f[3] * r * sg0.w); o.z = pk2(f[4] * r * sg1.x, f[5] * r * sg1.y); o.w = pk2(f[6] * r * sg1.z, f[7] * r * sg1.w);
              v2u o2; o2.x = pk2(f[8] * r * sg2.x, f[9] * r * sg2.y); o2.y = pk2(f[10] * r * sg2.z, f[11] * r * sg2.w);
              *(GAS v4u*)(MIX + (size_t)m * DM + 512 + 8 * l) = o; *(GAS v2u*)(MIX + (size_t)m * DM + 1024 + 4 * l) = o2; }
#pragma unroll
            for (int h = 0; h < 6; ++h) { const unsigned a = oa[q][h], bq = ob[q][h];
                const float v0 = bflo(a) - lam * bflo(bq), v1 = bfhi(a) - lam * bfhi(bq);
                const float r = 1.0f / sqrtf(wave_sum(v0 * v0 + v1 * v1) * (1.0f / 128.0f) + LN_EPS);
                *(GAS unsigned*)(MIX + (size_t)m * DM + 1280 + 128 * h + 2 * l) = pk2(v0 * r * gA, v1 * r * gB); } }
    }
}

__device__ __forceinline__ void router_phase(const Ctx& C, const bf16* X, const float* rowss, const bf16* RW, const float* gain, const float* bg, const float* be, unsigned char* XN8, unsigned char* rt) {
    int* tok_e = (int*)(rt + RT_TOKE); int* tok_p = (int*)(rt + RT_TOKP); float* tok_g = (float*)(rt + RT_GATE); int* row_slot = (int*)(rt + RT_SLOT); int* hist = (int*)(rt + RT_HIST);
    LAS int* lh = (LAS int*)(C.lds + RING_OFF);
    LAS float* lg = (LAS float*)(C.lds + RING_OFF + 1024) + C.wave * 640;
    for (int i = C.gtid; i < PROWS; i += C.NT) row_slot[i] = -1;
    __syncthreads();
    if (C.tid < 64) lh[C.tid] = 0;
    __syncthreads();
    const int r0 = C.blk * 64 + C.wave * 8, c16 = C.lane & 15, g4 = C.lane >> 4;
    float rstd_l;
    { const GAS f32x4* pp = (const GAS f32x4*)(rowss + (size_t)(r0 + (C.lane >> 3)) * 32) + (C.lane & 7); const f32x4 q = pp[0]; float ssr = (q.x + q.y) + (q.z + q.w);
      ssr += __shfl_xor(ssr, 1); ssr += __shfl_xor(ssr, 2); ssr += __shfl_xor(ssr, 4); rstd_l = 1.0f / sqrtf(ssr * (1.0f / DM) + RMS_EPS); }
    const float rstd = __shfl(rstd_l, (c16 & 7) * 8);
    const float hsc = rstd * SA1;
    const bf16* xrow = X + (size_t)(r0 + (c16 & 7)) * DM + 8 * g4;
    LAS float* gl = (LAS float*)(C.lds + RING_OFF + 114688);
    for (int i = C.tid; i < DM; i += 512) gl[i] = gain[i];
    const LAS float* grow = gl + 8 * g4;
    unsigned char* hrow = XN8 + (size_t)(r0 + (c16 & 7)) * DM + 8 * g4;
    LAS bf16* wb = (LAS bf16*)(C.lds + RING_OFF + 24576);
    constexpr int WROW = 136, WBUF = 160 * WROW;
    f32x4 acc[5];
#pragma unroll
    for (int i = 0; i < 5; ++i) acc[i] = (f32x4){0.f, 0.f, 0.f, 0.f};
    v4u wreg[5]; v4u x0[4], x1[4], x2[4];
#define RT_WLOAD(c) do { _Pragma("unroll") for (int i = 0; i < 5; ++i) { const int task = C.tid + 512 * i, row = task >> 4, seg = task & 15; wreg[i] = *(const GAS v4u*)(RW + (size_t)row * DM + (c) * 128 + seg * 8); } } while (0)
#define RT_WSTORE(c) do { _Pragma("unroll") for (int i = 0; i < 5; ++i) { const int task = C.tid + 512 * i, row = task >> 4, seg = task & 15; *(LAS v4u*)(wb + ((c) & 1) * WBUF + row * WROW + seg * 8) = wreg[i]; } } while (0)
#define RT_XLOAD(XB, c) do { const int cc_ = (c) < 16 ? (c) : 15; _Pragma("unroll") for (int ks = 0; ks < 4; ++ks) XB[ks] = *(const GAS v4u*)(xrow + cc_ * 128 + 32 * ks); } while (0)
#define RT_HLOAD(BF, ks) do { _Pragma("unroll") for (int nt = 0; nt < 5; ++nt) BF[nt] = *(const LAS bf16x8*)(cur + nt * 16 * WROW + 32 * (ks)); } while (0)
#define RT_LLOAD(BF, ks) do { _Pragma("unroll") for (int nt = 0; nt < 5; ++nt) BF[nt] = *(const LAS bf16x8*)(cur + (80 + nt * 16) * WROW + 32 * (ks)); } while (0)
#define RT_KSTEP(c, XB, ks, BH, BL) do { const v4u xq = XB[ks]; const bf16x8 ax = __builtin_bit_cast(bf16x8, xq); \
            _Pragma("unroll") for (int nt = 0; nt < 5; ++nt) acc[nt] = MFMA16(ax, BH[nt], acc[nt]); \
            _Pragma("unroll") for (int nt = 0; nt < 5; ++nt) acc[nt] = MFMA16(ax, BL[nt], acc[nt]); \
            { const f32x4 ga = *(const LAS f32x4*)(grow + (c) * 128 + 32 * (ks)), gb = *(const LAS f32x4*)(grow + (c) * 128 + 32 * (ks) + 4); v2u hw;     \
                hw.x = pk4_fp8m(bflo(xq.x) * hsc * ga.x, bfhi(xq.x) * hsc * ga.y, bflo(xq.y) * hsc * ga.z, bfhi(xq.y) * hsc * ga.w); hw.y = pk4_fp8m(bflo(xq.z) * hsc * gb.x, bfhi(xq.z) * hsc * gb.y, bflo(xq.w) * hsc * gb.z, bfhi(xq.w) * hsc * gb.w); \
                *(GAS v2u*)(hrow + (c) * 128 + 32 * (ks)) = hw; }     } while (0)
#define RT_CHUNK(c, XB) do { const LAS bf16* cur = wb + ((c) & 1) * WBUF + c16 * WROW + 8 * g4; bf16x8 hA[5], hB[5], lF[5]; RT_HLOAD(hA, 0); \
        RT_LLOAD(lF, 0); RT_HLOAD(hB, 1); RT_KSTEP(c, XB, 0, hA, lF); RT_LLOAD(lF, 1); RT_HLOAD(hA, 2); RT_KSTEP(c, XB, 1, hB, lF); \
        RT_LLOAD(lF, 2); RT_HLOAD(hB, 3); RT_KSTEP(c, XB, 2, hA, lF); RT_LLOAD(lF, 3); RT_KSTEP(c, XB, 3, hB, lF); } while (0)
    RT_WLOAD(0); RT_XLOAD(x0, 0); RT_XLOAD(x1, 1); RT_WSTORE(0);
    __syncthreads();
#pragma unroll 1
    for (int c = 0; c < 15; c += 3) {
        RT_WLOAD(c + 1); RT_XLOAD(x2, c + 2); RT_CHUNK(c, x0); RT_WSTORE(c + 1); __syncthreads();
        RT_WLOAD(c + 2); RT_XLOAD(x0, c + 3); RT_CHUNK(c + 1, x1); RT_WSTORE(c + 2); __syncthreads();
        RT_WLOAD(c + 3); RT_XLOAD(x1, c + 4); RT_CHUNK(c + 2, x2); RT_WSTORE(c + 3); __syncthreads();
    }
    RT_CHUNK(15, x0);
#undef RT_WLOAD
#undef RT_WSTORE
#undef RT_XLOAD
#undef RT_CHUNK
#undef RT_KSTEP
#undef RT_HLOAD
#undef RT_LLOAD
    float rs4[4];
#pragma unroll
    for (int r = 0; r < 4; ++r) rs4[r] = __shfl(rstd_l, ((4 * g4 + r) & 7) * 8);
    if (g4 < 2) {
#pragma unroll
        for (int r = 0; r < 4; ++r) { const int row = 4 * g4 + r;
#pragma unroll
            for (int nt = 0; nt < 5; ++nt) { const int o = 16 * nt + c16; if (o < 72) lg[row * 80 + o] = acc[nt][r] * rs4[r] + (o < 8 ? bg[o] : be[o - 8]); } }
    }
    LDS_WAIT(); asm volatile("" ::: "memory");
    if (C.lane < 8) { const LAS float* L = lg + C.lane * 80;
        int gi = 0; float gm = L[0];
#pragma unroll
        for (int j = 1; j < 8; ++j) { const float v = L[j]; if (v > gm) { gm = v; gi = j; } }
        float gs = 0.f;
#pragma unroll
        for (int j = 0; j < 8; ++j) gs += __expf(L[j] - gm);
        const float gw_ = 1.0f / gs;
        const LAS float* E = L + 8 + 8 * gi;
        int j1 = 0; float m1 = E[0];
#pragma unroll
        for (int j = 1; j < 8; ++j) { const float v = E[j]; if (v > m1) { m1 = v; j1 = j; } }
        int j2 = (j1 == 0) ? 1 : 0; float m2 = E[j2];
#pragma unroll
        for (int j = 0; j < 8; ++j) { const float v = E[j]; if (j != j1 && v > m2) { m2 = v; j2 = j; } }
        const float ex = __expf(m2 - m1), w1 = 1.0f / (1.0f + ex), w2 = ex * w1;
        const int e0 = 8 * gi + j1, e1 = 8 * gi + j2, tok = r0 + C.lane;
        const int p0 = atomicAdd((int*)&lh[e0], 1), p1 = atomicAdd((int*)&lh[e1], 1);
        tok_e[2 * tok] = e0; tok_e[2 * tok + 1] = e1; tok_p[2 * tok] = p0; tok_p[2 * tok + 1] = p1; tok_g[2 * tok] = gw_ * w1; tok_g[2 * tok + 1] = gw_ * w2;
    }
    __syncthreads();
    if (C.tid < 64) hist[C.blk * 64 + C.tid] = lh[C.tid];
    __syncthreads();
}

__device__ __forceinline__ void moe_table(const Ctx& C, const int* hist) {
    LAS int* padstart = (LAS int*)(C.lds + TAB_OFF); LAS int* base = padstart + 64; LAS int* tab = padstart + 128; LAS int* ntl = padstart + 320; LAS unsigned short* tval = (LAS unsigned short*)(padstart + 324);
    LAS int* part = (LAS int*)(C.lds + TAB_PART);
    __syncthreads();
    { const int e = C.tid & 63, p = C.tid >> 6; int tot = 0, pre = 0;
      int hv[32];
#pragma unroll
      for (int i = 0; i < 32; ++i) hv[i] = hist[(32 * p + i) * 64 + e];
#pragma unroll
      for (int i = 0; i < 32; ++i) { tot += hv[i]; pre += (32 * p + i < C.blk) ? hv[i] : 0; }
      part[(p * 64 + e) * 2] = tot; part[(p * 64 + e) * 2 + 1] = pre; }
    __syncthreads();
    if (C.tid < 64) { const int e = C.tid; int cnt = 0, pre = 0;
#pragma unroll
        for (int p = 0; p < 8; ++p) { cnt += part[(p * 64 + e) * 2]; pre += part[(p * 64 + e) * 2 + 1]; }
        const int nt = (cnt + 255) >> 8; int inc = nt;
#pragma unroll
        for (int off = 1; off < 64; off <<= 1) { const int t = __shfl_up(inc, off); if (e >= off) inc += t; }
        const int ts = inc - nt; padstart[e] = 256 * ts; base[e] = pre;
        for (int i = 0; i < nt; ++i) { tab[ts + i] = e; tval[ts + i] = (unsigned short)((cnt - 256 * i) < 256 ? (cnt - 256 * i) : 256); }
        if (e == 63) ntl[0] = inc; }
    __syncthreads();
}
__device__ __forceinline__ void slot_phase(const Ctx& C, unsigned char* rt) {
    const int* tok_e = (const int*)(rt + RT_TOKE); int* tok_p = (int*)(rt + RT_TOKP); int* row_slot = (int*)(rt + RT_SLOT);
    const LAS int* padstart = (const LAS int*)(C.lds + TAB_OFF); const LAS int* base = padstart + 64;
    if (C.tid < 128) { const int slot = 2 * (C.blk * 64) + C.tid; const int e = tok_e[slot]; const int dest = padstart[e] + base[e] + tok_p[slot]; row_slot[dest] = slot; tok_p[slot] = dest; }
}
__device__ __forceinline__ int att_unit_tab(int i) {
    static constexpr unsigned char T_[96] = {7, 2, 10, 15, 18, 26, 23, 34, 42, 31, 50, 58, 39, 66, 74, 47, 82, 90, 55, 4, 0, 63, 12, 8, 71, 20, 16, 79, 28, 24, 87, 36, 32, 95, 44, 40, 6, 5, 48, 14, 13, 56, 22, 21, 64, 30, 29, 72, 38, 37, 80, 46, 45, 88, 54, 3, 1, 62, 11, 9, 70, 19, 17, 78, 27, 25, 86, 35, 33, 94, 43, 41, 53, 52, 49, 61, 60, 57, 69, 68, 65, 77, 76, 73, 85, 84, 81, 93, 92, 89, 51, 59, 67, 75, 83, 91};
    return T_[i];
}
typedef const void* const __attribute__((address_space(4)))* KARGP;
struct Args { const void* in[26]; float* out; unsigned char* ws; int ph_lo, ph_hi, use_bar, pad; };
__global__ void __launch_bounds__(512, 2) mega_fwd(Args args) {
    extern __shared__ __attribute__((aligned(16))) unsigned char lds_raw[];
    const int wave0 = __builtin_amdgcn_readfirstlane((int)threadIdx.x >> 6), blk0 = blockIdx.x;
    LAS unsigned char* const ldsb = (LAS unsigned char*)lds_raw;
#define MKCTX Ctx C; C.lds = ldsb; C.wave = wave0; asm volatile("v_mbcnt_lo_u32_b32 %0, -1, 0\n\tv_mbcnt_hi_u32_b32 %0, -1, %0" : "=v"(C.lane)); C.tid = wave0 * 64 + C.lane; C.blk = blk0; \
    C.vcu = (blk0 % 8) * (GRID / 8) + blk0 / 8; C.gw = blk0 * 8 + wave0; C.gtid = blk0 * 512 + C.tid
    unsigned char* ws0 = args.ws;
    for (int u = threadIdx.x; u < 128; u += 512) ((LAS unsigned*)(ldsb + LCTL_OFF))[u] = 0u;
    __syncthreads();
    XcdBarrier bar; bar.bar = (unsigned*)(ws0 + WS_CTL) + CW_BAR; bar.x = 0; bar.st = (volatile LAS unsigned*)(ldsb + LCTL_OFF + 64);
    if (args.use_bar) bar = xcd_barrier_post((unsigned*)(ws0 + WS_CTL) + CW_BAR, (volatile LAS unsigned*)(ldsb + LCTL_OFF + 64));
    const int lo = args.ph_lo, hi = args.ph_hi;
#ifndef PH_DIS
#define PH_DIS 0
#endif
#define INR(k) (lo <= (k) && (k) < hi)
#define IN0 (INR(0) && !(PH_DIS & 1))
#define INL(off) (INR(pb + (off)) && !((PH_DIS >> (1 + (off))) & 1) && (!probe_ || ((PROBE_COLD >> (off)) & 1)))
#ifndef PROBE_DUP
#define PROBE_DUP 0
#endif
#define NREP(bit) (((PROBE_DUP >> (bit)) & 1) ? 2 : 1)
#define LAUNDER MKCTX; asm volatile("" : "+v"(C.tid), "+v"(C.lane), "+v"(C.gtid)); PTRS
#ifndef PROBE_BAR2
#define PROBE_BAR2 0
#endif
#define SEAM(k) do { if (INR(k) && INR((k) + 1)) { xcd_barrier(bar); if (PROBE_BAR2) xcd_barrier(bar); } } while (0)
#define GIN(i) ((const float*)(const GAS float*)ain[i])
#define PTRS GAS unsigned char* wsg_ = (GAS unsigned char*)ws0; asm volatile("" : "+s"(wsg_)); unsigned char* ws = (unsigned char*)wsg_;     \
    KARGP ain = (KARGP)__builtin_amdgcn_kernarg_segment_ptr(); asm volatile("" : "+s"(ain));     \
    const float* x_in = GIN(0); \
    bf16* XN = (bf16*)(ws + WS_XN); bf16* PROJ = (bf16*)(ws + WS_PROJ); bf16* ZC = (bf16*)(ws + WS_ZC); bf16* YCONV = (bf16*)(ws + WS_YCONV); bf16* YSWA = (bf16*)(ws + WS_YSWA); \
    bf16* ODIFF = (bf16*)(ws + WS_ODIFF); bf16* MIX = (bf16*)(ws + WS_MIX); bf16* X = (bf16*)(ws + WS_X); bf16* Zb = (bf16*)(ws + WS_Z); bf16* ACT = (bf16*)(ws + WS_ACT); bf16* YS = (bf16*)(ws + WS_YS); \
    unsigned char* rt = ws + WS_ROUTE; (void)x_in; (void)XN; (void)PROJ; (void)ZC; (void)YCONV; (void)YSWA; (void)ODIFF; (void)MIX; (void)X; (void)Zb; (void)ACT; (void)YS; (void)rt
    if (IN0) for (int rep_ = 0; rep_ < NREP(0); ++rep_) { LAUNDER;
        P0In I{GIN(3), GIN(17), GIN(8), GIN(23), GIN(24), GIN(19), GIN(21), GIN(18), ((const int*)GIN(1))};
        p0_prologue(C, I, ws);
        norm_rows<0>(C, x_in, nullptr, nullptr, nullptr, nullptr, GIN(2), XN, nullptr);
    }
    SEAM(0);
#ifndef PROBE_COLD
#define PROBE_COLD 0
#endif
#pragma unroll 1
    for (int li = 0; li < DEPTH + (PROBE_COLD ? 1 : 0); ++li) {
        const int l = li < DEPTH ? li : DEPTH - 1; const bool probe_ = li >= DEPTH;
        const int pb = 1 + 10 * li;
        const float lambda_init = (l == 0) ? 0.2f : 0.35550906759096927f;
        if (INL(0)) for (int rep_ = 0; rep_ < NREP(1); ++rep_) { LAUNDER;
            pg8::Gemm g{XN, (const bf16*)(ws + WS_WIN) + (size_t)l * INW * DM, T, INW, DM}; pg8::StaticOrder S; S.init(T, INW, C.G, C.blk);
            pg8::EpiProj E{PROJ, INW, Zb, (const float*)(ws + WS_ROPEC), (const float*)(ws + WS_ROPES), QSCALE};
            pg8::gemm_phase<pg8::EpiProj, pg8::StaticOrder, true, true>(C.lds + RING_OFF, g, S, E, C.tid);
            if (C.blk >= 128) { P0In I{nullptr, nullptr, nullptr, GIN(23), GIN(24), nullptr, nullptr, nullptr, nullptr};
                constexpr int PER_L = MOE_ITEMS_L;
                moe_convert(C, I, ws, l * PER_L, l * PER_L + CONV_TAIL, C.blk - 128, 128); }
        }
        SEAM(pb + 0);
        if (INL(2)) for (int rep_ = 0; rep_ < NREP(3); ++rep_) { LAUNDER;
            unsigned* zc_cnt = (unsigned*)(ws + WS_CTL) + CW_ZC + 64 * l + 2048 * rep_ + (probe_ ? 4096 : 0);
            convpre_phase(C, Zb, GIN(4) + l * CONV_W * CONV_CH, GIN(5) + l * CONV_CH, GIN(6) + l * CONV_CH, GIN(7) + l * CONV_CH, ZC);
            asm volatile("s_waitcnt vmcnt(0)" ::: "memory");
            __syncthreads();
            if (C.tid == 0) __hip_atomic_fetch_add(zc_cnt, 1u, __ATOMIC_RELAXED, __HIP_MEMORY_SCOPE_AGENT);
#ifndef NO_ATT
            for (int rep2_ = 0; rep2_ < NREP(11); ++rep2_)
#pragma unroll 1
            for (int step = 0; step < 6; ++step) {
                const int third = step >> 1;
                if ((step & 1) == (C.vcu & 1)) {
                    P0In I{nullptr, nullptr, nullptr, GIN(23), GIN(24), nullptr, nullptr, nullptr, nullptr};
                    constexpr int PER_L = MOE_ITEMS_L, NIT = PER_L - CONV_TAIL - CONV_OUT, T3 = (NIT / 3 + C.G - 1) / C.G * C.G;
                    const int lo = l * PER_L + CONV_TAIL + third * T3, hi = (third == 2) ? (l + 1) * PER_L - CONV_OUT : lo + T3;
                    moe_convert(C, I, ws, lo, hi, C.blk, C.G);
                } else {
                    { const int xcd = C.vcu >> 5, ci = C.vcu & 31, tv = att_unit_tab(ci * 3 + third), qb = tv & 7, gi = xcd * 12 + (tv >> 3), b = gi / 12, hc = gi - b * 12, h = hc >> 1, c = hc & 1;
                        const attn_body::bf16* Q = (const attn_body::bf16*)PROJ + C_QD + (2 * h + c) * 64; const attn_body::bf16* K = (const attn_body::bf16*)PROJ + C_KD + (2 * h + c) * 64;
                        const attn_body::bf16* V = (const attn_body::bf16*)PROJ + C_VD + 128 * h; attn_body::bf16* O = (attn_body::bf16*)ODIFF + 64 * (4 * h + 2 * c);
                        attn_body::attn_unit2<8>(b, qb, Q, K, V, O, (char*)lds_raw + RING_OFF, C.tid); }
                }
            }
#endif
            __syncthreads();
#ifndef NO_SWA
            for (int rep2_ = 0; rep2_ < NREP(12); ++rep2_)
            swa_phase(C, PROJ, GIN(10) + l * 12, YSWA);
#endif
#ifndef NO_PW
            if (C.tid == 0) { unsigned sp_ = 0;
                while (__hip_atomic_load(zc_cnt, __ATOMIC_RELAXED, __HIP_MEMORY_SCOPE_AGENT) < (unsigned)C.G) { __builtin_amdgcn_s_sleep(2); if (++sp_ > (1u << 22)) break; }
                __builtin_amdgcn_fence(__ATOMIC_ACQUIRE, "agent"); asm volatile("s_waitcnt vmcnt(0)" ::: "memory"); }
            __syncthreads();
            for (int rep2_ = 0; rep2_ < NREP(13); ++rep2_)
            { pg8::Gemm g{ZC, (const bf16*)(ws + WS_PW) + (size_t)l * 512 * 512, T, 512, 512}; pg8::StaticOrder S; S.init(T, 512, C.G, C.blk);
              pg8::EpiBf16<0> E{YCONV, 512, nullptr, 0, 0, 1.f};
              pg8::gemm_phase<pg8::EpiBf16<0>, pg8::StaticOrder, true, true>(C.lds + RING_OFF, g, S, E, C.tid); }
#endif
        }
        SEAM(pb + 2);
        if (INL(3)) for (int rep_ = 0; rep_ < NREP(4); ++rep_) { LAUNDER;
            mix_phase(C, YCONV, YSWA, ODIFF, GIN(9) + l * 512, GIN(11) + l * 768, GIN(12) + l * 64, GIN(13) + l * 64,
                      GIN(14) + l * 64, GIN(15) + l * 64, GIN(16) + l * 128, lambda_init, MIX);
        }
        SEAM(pb + 3);
        if (INL(4)) for (int rep_ = 0; rep_ < ((l == 0) ? NREP(5) : 1); ++rep_) { LAUNDER;
            pg8::Gemm g{MIX, (const bf16*)(ws + WS_WOUT) + (size_t)l * DM * DM, T, DM, DM}; pg8::StaticOrder S; S.init(T, DM, C.G, C.blk);
            P0In Ic{nullptr, nullptr, nullptr, GIN(23), GIN(24), nullptr, nullptr, nullptr, nullptr};
            constexpr int PER_Lc = MOE_ITEMS_L;
            P0In Iw{GIN(3), GIN(17), GIN(8), nullptr, nullptr, nullptr, nullptr, nullptr, nullptr};
            if ((C.vcu & 1) == 0) { moe_convert(C, Ic, ws, (l + 1) * PER_Lc - CONV_OUT, (l + 1) * PER_Lc, C.blk, C.G); if (l + 1 < DEPTH) wconv_bf16(C, Iw, ws, (l + 1) * WCONV_L, (l + 2) * WCONV_L); }
            if (l == 0) { pg8::EpiResBf16<true> E{x_in, X, DM, (float*)(ws + WS_ROWSS)}; pg8::gemm_phase<pg8::EpiResBf16<true>, pg8::StaticOrder, true, true>(C.lds + RING_OFF, g, S, E, C.tid); }
            else { pg8::EpiResBf16<false> E{X, X, DM, (float*)(ws + WS_ROWSS)}; pg8::gemm_phase<pg8::EpiResBf16<false>, pg8::StaticOrder, true, true>(C.lds + RING_OFF, g, S, E, C.tid); }
            if ((C.vcu & 1) != 0) { moe_convert(C, Ic, ws, (l + 1) * PER_Lc - CONV_OUT, (l + 1) * PER_Lc, C.blk, C.G); if (l + 1 < DEPTH) wconv_bf16(C, Iw, ws, (l + 1) * WCONV_L, (l + 2) * WCONV_L); }
        }
        SEAM(pb + 4);
        if (INL(5)) for (int rep_ = 0; rep_ < NREP(6); ++rep_) { LAUNDER;
            router_phase(C, X, (const float*)(ws + WS_ROWSS), (const bf16*)(ws + WS_RW) + (size_t)l * 2 * 80 * DM, GIN(18) + l * DM, GIN(20) + l * 8, GIN(22) + l * 64, (unsigned char*)XN, rt);
        }
        SEAM(pb + 5);
        if (INL(6)) for (int rep_ = 0; rep_ < NREP(7); ++rep_) { LAUNDER; moe_table(C, (const int*)(rt + RT_HIST)); slot_phase(C, rt); }
        SEAM(pb + 6);
        if (INL(7)) for (int rep_ = 0; rep_ < NREP(8); ++rep_) { LAUNDER;
            if (!args.use_bar) moe_table(C, (const int*)(rt + RT_HIST));
            const LAS int* tb = (const LAS int*)(C.lds + TAB_OFF);
            pg8::Gemm g{XN, (const bf16*)(ws + WS_W13 + (size_t)l * NEXP * 1024 * DM), PROWS, NEXP * 1024, DM / 2};
            pg8::GroupedOrder S{tb + 128, tb[320], 4, C.G, C.vcu};
            LAS unsigned* gofs = (LAS unsigned*)(C.lds + GOFS_OFF); const int* row_slot = (const int*)(rt + RT_SLOT);
            { int slv[3] = {-1, -1, -1};
#pragma unroll
              for (int i = 0; i < 3; ++i) { pg8::Unit u; if (S.next(i, u) && C.tid < 256) slv[i] = row_slot[u.pm * 256 + C.tid]; }
#pragma unroll
              for (int i = 0; i < 3; ++i) if (C.tid < 256) gofs[i * 256 + C.tid] = (unsigned)(slv[i] < 0 ? 0 : slv[i] >> 1) * (unsigned)DM; }
            __syncthreads();
#if defined(PROBE_VAR) && PROBE_VAR == 2
            if (probe_) { pg8::EpiNull En; pg8::gemm_phase<pg8::EpiNull, pg8::GroupedOrder, true, true, true, true>(C.lds + RING_OFF, g, S, En, C.tid, gofs); } else
#endif
            { pg8::EpiSiluMul8 E{(unsigned char*)ACT, FF, 1.0f / (SA1 * SW1), SA2};
            pg8::gemm_phase<pg8::EpiSiluMul8, pg8::GroupedOrder, true, true, true, true>(C.lds + RING_OFF, g, S, E, C.tid, gofs); }
        }
        SEAM(pb + 7);
        if (INL(8)) for (int rep_ = 0; rep_ < NREP(9); ++rep_) { LAUNDER;
            if (!args.use_bar) moe_table(C, (const int*)(rt + RT_HIST));
            const LAS int* tb = (const LAS int*)(C.lds + TAB_OFF);
            pg8::Gemm g{ACT, (const bf16*)(ws + WS_W2 + (size_t)l * NEXP * DM * FF), PROWS, NEXP * DM, FF / 2};
            pg8::GroupedOrder S{tb + 128, tb[320], 8, C.G, C.vcu};
#if defined(PROBE_VAR) && PROBE_VAR == 1
            if (probe_) { pg8::EpiNull En; pg8::gemm_phase<pg8::EpiNull, pg8::GroupedOrder, true, true, false, true>(C.lds + RING_OFF, g, S, En, C.tid); } else
#endif
            { pg8::EpiScatter E{(unsigned char*)YS, DM, (const LAS unsigned short*)(tb + 324), SY / (SA2 * SW2)};
            pg8::gemm_phase<pg8::EpiScatter, pg8::GroupedOrder, true, true, false, true>(C.lds + RING_OFF, g, S, E, C.tid); }
        }
        SEAM(pb + 8);
        if (INL(9)) for (int rep_ = 0; rep_ < ((l + 1 == DEPTH) ? NREP(10) : 1); ++rep_) { LAUNDER;
            if (l + 1 < DEPTH) norm_rows<1>(C, X, X, (const unsigned char*)YS, (const int*)(rt + RT_TOKP), (const float*)(rt + RT_GATE), GIN(2) + (l + 1) * DM, XN, nullptr);
            else norm_rows<2>(C, X, nullptr, (const unsigned char*)YS, (const int*)(rt + RT_TOKP), (const float*)(rt + RT_GATE), GIN(25), nullptr, args.out);
        }
        SEAM(pb + 9);
    }
#undef LAUNDER
#undef MKCTX
#undef PTRS
#undef GIN
#undef INR
#undef IN0
#undef INL
#undef SEAM
}

extern "C" void kernel_launch(void* const* d_in, const int* in_sizes, int n_in, void* d_out, int out_size, void* d_ws, size_t ws_size, hipStream_t stream) {
    static int grid = 0;
    if (grid == 0) {
        if (n_in != 26 || in_sizes[0] != T * DM || out_size != T * DM || ws_size < WS_END) { fprintf(stderr, "kernel_launch: unexpected shapes (n_in %d, in0 %d, out %d, ws %zu < %zu); nothing launched\n", n_in, n_in > 0 ? in_sizes[0] : -1, out_size, ws_size, (size_t)WS_END); grid = -1; return; }
        int dev = 0, cus = 0, per_cu = 0;
        if (hipGetDevice(&dev) != hipSuccess || hipDeviceGetAttribute(&cus, hipDeviceAttributeMultiprocessorCount, dev) != hipSuccess) { fprintf(stderr, "kernel_launch: device query failed\n"); grid = -1; return; }
        if (hipFuncSetAttribute((const void*)mega_fwd, hipFuncAttributeMaxDynamicSharedMemorySize, LDS_BYTES) != hipSuccess) { fprintf(stderr, "kernel_launch: hipFuncSetAttribute failed\n"); grid = -1; return; }
        if (hipOccupancyMaxActiveBlocksPerMultiprocessor(&per_cu, (const void*)mega_fwd, 512, LDS_BYTES) != hipSuccess || per_cu < 1) fprintf(stderr, "kernel_launch: note: occupancy query reports %d workgroups per CU\n", per_cu);
        (void)hipGetLastError();
        if (cus != 256) { fprintf(stderr, "kernel_launch: built for a 256-CU device (got %d); nothing launched\n", cus); grid = -1; return; }
        grid = cus;
    }
    if (grid < 0) return;
    if (hipMemsetAsync((char*)d_ws + WS_CTL, 0, CTL_ZERO_BYTES, stream) != hipSuccess) { fprintf(stderr, "kernel_launch: memset failed\n"); return; }
    if (grid != GRID) return;
    Args a{};
    for (int i = 0; i < 26; ++i) a.in[i] = d_in[i];
    a.out = (float*)d_out; a.ws = (unsigned char*)d_ws; a.pad = 0;
#if MK_MULTI
    for (int k = 0; k < NPHASE; ++k) { a.ph_lo = k; a.ph_hi = k + 1; a.use_bar = 0; hipLaunchKernelGGL(mega_fwd, dim3(grid), dim3(512), LDS_BYTES, stream, a); }
#else
    a.ph_lo = 0; a.ph_hi = NPHASE + (PROBE_COLD ? 10 : 0); a.use_bar = 1;
    hipLaunchKernelGGL(mega_fwd, dim3(grid), dim3(512), LDS_BYTES, stream, a);
#endif
    const hipError_t le = hipPeekAtLastError();
    if (le != hipSuccess) fprintf(stderr, "kernel_launch: launch failed: %s\n", hipGetErrorName(le));
}
```
